# Optimizing an MI355X kernel written in HIP

```python
import math
import jax, jax.numpy as jnp
from jax import lax
import numpy as np

D_MODEL = 1024
BATCH = 8
SEQ = 8192
DEPTH = 1

ATTN_HEADS = D_MODEL // 256
ATTN_HEAD_DIM = 64
ATTN_V_DIM = 2 * ATTN_HEAD_DIM
ATTN_QK_WIDTH = ATTN_HEADS * 2 * ATTN_HEAD_DIM
ATTN_WIDTH = ATTN_HEADS * ATTN_V_DIM
Q_BLOCK = 128
REC_HEADS = D_MODEL // 256
REC_KEY_DIM = 128
REC_VAL_DIM = 128
REC_KEY_WIDTH = REC_HEADS * REC_KEY_DIM
REC_WIDTH = REC_HEADS * REC_VAL_DIM
REC_CHUNK = 64
IN_SPLITS = (ATTN_QK_WIDTH, ATTN_QK_WIDTH, ATTN_WIDTH, REC_KEY_WIDTH, REC_KEY_WIDTH, REC_WIDTH, REC_WIDTH)
IN_WIDTH = sum(IN_SPLITS)
MIX_WIDTH = ATTN_WIDTH + REC_WIDTH
NUM_BUCKETS = 32
MAX_DISTANCE = 128
N_GROUPS = 4
EXPERTS_PER_GROUP = 8
N_EXPERTS = N_GROUPS * EXPERTS_PER_GROUP
EXPERT_FF = D_MODEL // 2
TOP_K = 2
EXPERT_BLOCK = 128
EPS = 1e-6

kernel_name = 'hybrid_diffattn_hgrn2_hier_moe'


def rmsnorm(x, g):
    xf = x.astype(jnp.float32)
    y = xf * lax.rsqrt(jnp.mean(xf * xf, axis=-1, keepdims=True) + EPS)
    return (y * g.astype(jnp.float32)).astype(x.dtype)


def t5_bucket(rel):
    n = jnp.maximum(rel, 0)
    max_exact = NUM_BUCKETS // 2
    nf = jnp.maximum(n, 1).astype(jnp.float32)
    large = max_exact + (jnp.log(nf / max_exact) / math.log(MAX_DISTANCE / max_exact)
                         * (NUM_BUCKETS - max_exact)).astype(jnp.int32)
    large = jnp.minimum(large, NUM_BUCKETS - 1)
    return jnp.where(n < max_exact, n, large)


def lambda_init(layer):
    return 0.8 - 0.6 * math.exp(-0.3 * layer)


def diff_attention(q, k, v, lq1, lk1, lq2, lk2, subln_g, rel_table, layer):
    B, S, _ = q.shape
    nblk = S // Q_BLOCK
    q = q.reshape(B, S, ATTN_HEADS, 2, ATTN_HEAD_DIM).transpose(0, 2, 3, 1, 4)
    k = k.reshape(B, S, ATTN_HEADS, 2, ATTN_HEAD_DIM).transpose(0, 2, 3, 1, 4)
    v = v.reshape(B, S, ATTN_HEADS, ATTN_V_DIM).transpose(0, 2, 1, 3)
    lam_init = lambda_init(layer)
    f32 = jnp.float32
    lam = (jnp.exp(jnp.sum(lq1.astype(f32) * lk1.astype(f32)))
           - jnp.exp(jnp.sum(lq2.astype(f32) * lk2.astype(f32))) + lam_init)
    scale = ATTN_HEAD_DIM ** -0.5
    q_blocks = jnp.moveaxis(q.reshape(B, ATTN_HEADS, 2, nblk, Q_BLOCK, ATTN_HEAD_DIM), 3, 0)
    k_pos = jnp.arange(S)

    def block(args):
        qb, start = args
        q_pos = start + jnp.arange(Q_BLOCK)
        rel = q_pos[:, None] - k_pos[None, :]
        bias = jnp.transpose(rel_table[t5_bucket(rel)], (2, 0, 1)).astype(f32)
        logits = jnp.einsum('bhcqd,bhckd->bhcqk', qb, k).astype(f32) * scale + bias[None, :, None]
        logits = jnp.where(rel >= 0, logits, -jnp.inf)
        p = jax.nn.softmax(logits, axis=-1)
        a = p[:, :, 0] - lam * p[:, :, 1]
        return jnp.einsum('bhqk,bhkv->bhqv', a.astype(v.dtype), v)

    o = lax.map(block, (q_blocks, jnp.arange(nblk) * Q_BLOCK))
    o = jnp.moveaxis(o, 0, 2).reshape(B, ATTN_HEADS, S, ATTN_V_DIM).transpose(0, 2, 1, 3)
    o = rmsnorm(o, subln_g) * (1.0 - lam_init)
    return o.reshape(B, S, ATTN_WIDTH)


def hgrn2(q, f, i, g, lb, norm_g):
    B, S, _ = q.shape
    f32 = jnp.float32
    n = S // REC_CHUNK
    qf = jax.nn.silu(q.astype(f32))
    fr = f.astype(f32)
    lb = lb.astype(f32)
    log_f = jnp.log(lb + (1.0 - lb) * jax.nn.sigmoid(fr))
    kf = (1.0 - lb) * jax.nn.sigmoid(-fr)
    vf = i.astype(f32)

    def to_chunks(t, d):
        return t.reshape(B, n, REC_CHUNK, REC_HEADS, d).transpose(1, 0, 3, 2, 4)

    qc = to_chunks(qf, REC_KEY_DIM)
    kc = to_chunks(kf, REC_KEY_DIM)
    fc = to_chunks(log_f, REC_KEY_DIM)
    vc = to_chunks(vf, REC_VAL_DIM)
    tri = jnp.tril(jnp.ones((REC_CHUNK, REC_CHUNK), bool))

    def step(state, inp):
        qt, kt, lft, vt = inp
        b = jnp.cumsum(lft, axis=2)
        o_inter = jnp.einsum('bhtk,bhkv->bhtv', qt * jnp.exp(b), state)
        rel_decay = jnp.exp(jnp.where(tri[:, :, None],
                                      b[:, :, :, None, :] - b[:, :, None, :, :], -jnp.inf))
        scores = jnp.einsum('bhtk,bhsk,bhtsk->bhts', qt, kt, rel_decay)
        o = o_inter + jnp.einsum('bhts,bhsv->bhtv', scores, vt)
        b_last = b[:, :, -1:, :]
        state = (jnp.exp(b_last[:, :, 0, :])[..., None] * state
                 + jnp.einsum('bhsk,bhsv->bhkv', kt * jnp.exp(b_last - b), vt))
        return state, o

    s0 = jnp.zeros((B, REC_HEADS, REC_KEY_DIM, REC_VAL_DIM), f32)
    _, o = lax.scan(step, s0, (qc, kc, fc, vc))
    o = o.transpose(1, 0, 3, 2, 4).reshape(B, S, REC_HEADS, REC_VAL_DIM)
    o = rmsnorm(o, norm_g.reshape(REC_HEADS, REC_VAL_DIM))
    o = o * jax.nn.silu(g.astype(f32)).reshape(B, S, REC_HEADS, REC_VAL_DIM)
    return o.reshape(B, S, REC_WIDTH).astype(g.dtype)


def hier_moe(h, w_group, b_group, w_expert, b_expert, w1, w3, w2):
    B, S, D = h.shape
    N = B * S
    A = N * TOP_K
    f32 = jnp.float32
    hf = h.reshape(N, D)
    g_prob = jax.nn.softmax((hf @ w_group + b_group).astype(f32), axis=-1)
    g_gate, g_idx = lax.top_k(g_prob, 1)
    e_logits = (hf @ w_expert + b_expert).astype(f32).reshape(N, N_GROUPS, EXPERTS_PER_GROUP)
    e_logits = jnp.take_along_axis(e_logits, g_idx[:, :, None], axis=1)[:, 0]
    e_top, e_idx = lax.top_k(jax.nn.softmax(e_logits, axis=-1), TOP_K)
    weights = g_gate * e_top / jnp.sum(e_top, axis=-1, keepdims=True)
    expert_id = (g_idx * EXPERTS_PER_GROUP + e_idx).reshape(A)
    order = jnp.argsort(expert_id)
    sorted_e = expert_id[order]
    tok = order // TOP_K
    w_sorted = weights.reshape(A)[order]
    counts = jnp.bincount(expert_id, length=N_EXPERTS)
    start = jnp.cumsum(counts) - counts
    padded = (counts + EXPERT_BLOCK - 1) // EXPERT_BLOCK * EXPERT_BLOCK
    padded_end = jnp.cumsum(padded)
    padded_start = padded_end - padded
    dest = padded_start[sorted_e] + jnp.arange(A) - start[sorted_e]
    n_blocks = -(-A // EXPERT_BLOCK) + N_EXPERTS
    rows = jnp.zeros((n_blocks * EXPERT_BLOCK, D), h.dtype).at[dest].set(hf[tok])
    block_e = jnp.minimum(jnp.searchsorted(padded_end, jnp.arange(n_blocks) * EXPERT_BLOCK, side='right'),
                          N_EXPERTS - 1)

    def expert_block(args):
        xb, e = args
        return (jax.nn.silu(xb @ w1[e]) * (xb @ w3[e])) @ w2[e]

    ys = lax.map(expert_block, (rows.reshape(n_blocks, EXPERT_BLOCK, D), block_e)).reshape(-1, D)
    y = ys[dest] * w_sorted[:, None].astype(h.dtype)
    out = jnp.zeros((N, D), h.dtype).at[tok].add(y)
    return out.reshape(B, S, D)


def _normal(k, shape, s):
    return jax.random.normal(k, shape, jnp.float32) * s


def setup_inputs(seed: int = 0) -> dict:
    key = jax.random.key(seed)
    ks = jax.random.split(key, 24)
    D = D_MODEL
    return {
        'x': _normal(ks[0], (BATCH, SEQ, D), 1.0),
        'c': _normal(ks[1], (BATCH, D), 1.0),
        'w_ada': _normal(ks[2], (DEPTH, D, 6 * D), D ** -0.5),
        'b_ada': _normal(ks[3], (DEPTH, 6 * D), 0.02),
        'norm1_g': 1.0 + _normal(ks[4], (DEPTH, D), 0.02),
        'norm2_g': 1.0 + _normal(ks[5], (DEPTH, D), 0.02),
        'w_in': _normal(ks[6], (DEPTH, D, IN_WIDTH), D ** -0.5),
        'attn_lambda_q1': _normal(ks[7], (DEPTH, ATTN_HEAD_DIM), 0.1),
        'attn_lambda_k1': _normal(ks[8], (DEPTH, ATTN_HEAD_DIM), 0.1),
        'attn_lambda_q2': _normal(ks[9], (DEPTH, ATTN_HEAD_DIM), 0.1),
        'attn_lambda_k2': _normal(ks[10], (DEPTH, ATTN_HEAD_DIM), 0.1),
        'attn_subln_g': 1.0 + _normal(ks[11], (DEPTH, ATTN_V_DIM), 0.02),
        'rel_bias_table': _normal(ks[12], (NUM_BUCKETS, ATTN_HEADS), 0.5),
        'rec_lower_bound': _normal(ks[13], (DEPTH + 1, REC_KEY_WIDTH), 0.1),
        'rec_norm_g': 1.0 + _normal(ks[14], (DEPTH, REC_WIDTH), 0.02),
        'w_out': _normal(ks[15], (DEPTH, MIX_WIDTH, D), MIX_WIDTH ** -0.5),
        'w_group': _normal(ks[16], (DEPTH, D, N_GROUPS), D ** -0.5),
        'b_group': _normal(ks[17], (DEPTH, N_GROUPS), 0.01),
        'w_expert': _normal(ks[18], (DEPTH, D, N_EXPERTS), D ** -0.5),
        'b_expert': _normal(ks[19], (DEPTH, N_EXPERTS), 0.01),
        'w1': _normal(ks[20], (DEPTH, N_EXPERTS, D, EXPERT_FF), D ** -0.5),
        'w3': _normal(ks[21], (DEPTH, N_EXPERTS, D, EXPERT_FF), D ** -0.5),
        'w2': _normal(ks[22], (DEPTH, N_EXPERTS, EXPERT_FF, D), EXPERT_FF ** -0.5),
        'final_norm_g': 1.0 + _normal(ks[23], (D,), 0.02),
    }


def reference(x, c, w_ada, b_ada, norm1_g, norm2_g, w_in, attn_lambda_q1, attn_lambda_k1,
              attn_lambda_q2, attn_lambda_k2, attn_subln_g, rel_bias_table, rec_lower_bound,
              rec_norm_g, w_out, w_group, b_group, w_expert, b_expert, w1, w3, w2, final_norm_g):
    lb_all = jnp.cumsum(jax.nn.softmax(rec_lower_bound.astype(jnp.float32), axis=0), axis=0)
    c_act = jax.nn.silu(c)
    split_points = []
    acc = 0
    for w in IN_SPLITS[:-1]:
        acc += w
        split_points.append(acc)
    for l in range(DEPTH):
        mod = c_act @ w_ada[l] + b_ada[l]
        sh1, sc1, g1, sh2, sc2, g2 = jnp.split(mod, 6, axis=-1)
        h = rmsnorm(x, norm1_g[l]) * (1.0 + sc1[:, None]) + sh1[:, None]
        proj = h @ w_in[l]
        qa, ka, va, qr, fr, ir, gr = jnp.split(proj, split_points, axis=-1)
        ya = diff_attention(qa, ka, va, attn_lambda_q1[l], attn_lambda_k1[l], attn_lambda_q2[l],
                            attn_lambda_k2[l], attn_subln_g[l], rel_bias_table, l)
        yr = hgrn2(qr, fr, ir, gr, lb_all[l], rec_norm_g[l])
        mix = jnp.concatenate([ya, yr], axis=-1) @ w_out[l]
        x = x + g1[:, None] * mix
        h = rmsnorm(x, norm2_g[l]) * (1.0 + sc2[:, None]) + sh2[:, None]
        x = x + g2[:, None] * hier_moe(h, w_group[l], b_group[l], w_expert[l], b_expert[l],
                                       w1[l], w3[l], w2[l])
    return rmsnorm(x, final_norm_g)
```

```cpp
#include <hip/hip_runtime.h>
#include <hip/hip_cooperative_groups.h>
#include <cstdint>
#include <cstdio>
namespace cg = cooperative_groups;

#define LAS __attribute__((address_space(3)))
#define GAS __attribute__((address_space(1)))
typedef unsigned short bf16;
typedef short bf16x8 __attribute__((ext_vector_type(8)));
typedef short s16x4 __attribute__((ext_vector_type(4)));
typedef float f32x2 __attribute__((ext_vector_type(2)));
typedef float f32x4 __attribute__((ext_vector_type(4)));
typedef float f32x16 __attribute__((ext_vector_type(16)));
typedef unsigned u32x2 __attribute__((ext_vector_type(2)));
typedef unsigned u32x4 __attribute__((ext_vector_type(4)));
typedef __bf16 bf16x2_t __attribute__((ext_vector_type(2)));

constexpr int D = 1024, BATCH = 8, SEQ = 8192, NTOK = BATCH * SEQ;
constexpr int INW = 3584;
constexpr int COL_QA = 0, COL_KA = 512, COL_VA = 1024, COL_QR = 1536, COL_FR = 2048, COL_IR = 2560, COL_GR = 3072;
constexpr int NEXP = 32, FF = 512;
constexpr float EPS = 1e-6f;
constexpr float LOG2E = 1.4426950408889634f;
constexpr float QSCALE = 0.125f * LOG2E;
constexpr int NWAVES = 8, NTHREADS = 512;

constexpr size_t MiB = 1u << 20;
constexpr size_t WS_CTL = 0, CTL_ZERO_BYTES = 64 * 1024;
constexpr size_t WS_MOD = 1 * MiB;
constexpr size_t WS_WIN = 2 * MiB;
constexpr size_t WS_WOUT = 9 * MiB;
constexpr size_t WS_W13 = 11 * MiB;
constexpr size_t WS_W2 = 75 * MiB;
constexpr size_t WS_LIST = 107 * MiB;
constexpr size_t WS_TOKW = 115 * MiB;
constexpr size_t WS_TOKS = 115 * MiB + 512 * 1024;
constexpr size_t WS_H = 116 * MiB;
constexpr size_t WS_Y = 244 * MiB;
constexpr size_t WS_PROJ = 372 * MiB;
constexpr size_t WS_ACT = 372 * MiB;
constexpr size_t WS_YBUF = 508 * MiB;
constexpr size_t WS_QC = 820 * MiB;
constexpr size_t WS_KV = 884 * MiB;
constexpr size_t WS_X1B = 884 * MiB;
constexpr size_t WS_END = 1012 * MiB;
constexpr int CW_CNT = 0;
constexpr int CW_Q = 64;
constexpr int CW_BAR = 8192;

constexpr int RING_BYTES = 131072;
constexpr int MISC_OFF = RING_BYTES;
constexpr int EPI_SCR = MISC_OFF + 16384;
constexpr int LDS_BYTES = 163840;

__device__ __forceinline__ unsigned cvtpk(float lo, float hi) { f32x2 v = {lo, hi}; bf16x2_t b = __builtin_convertvector(v, bf16x2_t); return __builtin_bit_cast(unsigned, b); }
__device__ __forceinline__ float dot2bf(unsigned a, unsigned b, float acc) {
    asm("" : "+v"(a));
    return __builtin_amdgcn_fdot2_f32_bf16(__builtin_bit_cast(bf16x2_t, a), __builtin_bit_cast(bf16x2_t, b), acc, false); }
__device__ __forceinline__ float bf2f(unsigned short x) { return __uint_as_float(((unsigned)x) << 16); }
__device__ __forceinline__ float bflo(unsigned x) { return __uint_as_float(x << 16); }
__device__ __forceinline__ float bfhi(unsigned x) { return __uint_as_float(x & 0xffff0000u); }
template <int CTRL> __device__ __forceinline__ float dppf(float x) { return __builtin_bit_cast(float, __builtin_amdgcn_update_dpp(0, __builtin_bit_cast(int, x), CTRL, 0xf, 0xf, false)); }
__device__ __forceinline__ void swap32(float a, float b, float& r0, float& r1) { auto r = __builtin_amdgcn_permlane32_swap(__builtin_bit_cast(unsigned, a), __builtin_bit_cast(unsigned, b), false, false);
    unsigned u0 = r[0], u1 = r[1]; asm("" : "+v"(u0), "+v"(u1)); r0 = __builtin_bit_cast(float, u0); r1 = __builtin_bit_cast(float, u1); }
__device__ __forceinline__ void swap16(float a, float b, float& r0, float& r1) { auto r = __builtin_amdgcn_permlane16_swap(__builtin_bit_cast(unsigned, a), __builtin_bit_cast(unsigned, b), false, false);
    unsigned u0 = r[0], u1 = r[1]; asm("" : "+v"(u0), "+v"(u1)); r0 = __builtin_bit_cast(float, u0); r1 = __builtin_bit_cast(float, u1); }
__device__ __forceinline__ float sum_x32(float a, float b) { float r0, r1; swap32(a, b, r0, r1); return r0 + r1; }
__device__ __forceinline__ float sum_x16(float a, float b) { float r0, r1; swap16(a, b, r0, r1); return r0 + r1; }
__device__ __forceinline__ float row_sum(float v) { v += dppf<0xB1>(v); v += dppf<0x4E>(v); v += dppf<0x141>(v); v += dppf<0x140>(v); return v; }
__device__ __forceinline__ float wave_sum(float v) { v = row_sum(v); v = sum_x16(v, v); return sum_x32(v, v); }
__device__ __forceinline__ float fast_exp2(float x) { return __builtin_amdgcn_exp2f(x); }
__device__ __forceinline__ float fast_rcp(float x) { return __builtin_amdgcn_rcpf(x); }
__device__ __forceinline__ float sigmoidf_(float x) { return fast_rcp(1.f + fast_exp2(-x * LOG2E)); }
__device__ __forceinline__ float siluf_(float x) { return x * sigmoidf_(x); }

namespace pg8 {
constexpr int BM = 256, BK = 64, HALF = 128, HTB = HALF * BK * 2, STAGE_BYTES = 8 * HTB;
__host__ __device__ __forceinline__ int lds_byte(int r, int c) { const int st = (r >> 4) * 2 + (c >> 5), rr = r & 15, cc = c & 31, ob = rr * 64 + cc * 2; return st * 1024 + (ob ^ (((ob >> 9) & 1) << 5)); }
__host__ __device__ __forceinline__ void stage_rc(int b, int& R, int& C) { const int st = b / 1024, sb = b % 1024, swz = sb ^ (((sb >> 9) & 1) << 5); R = (st >> 1) * 16 + swz / 64; C = (st & 1) * 32 + (swz % 64) / 2; }
__host__ __device__ __forceinline__ int perm32(int rho) { const int n = rho >> 4, i = rho & 15; return 8 * (i >> 2) + 4 * n + (i & 3); }

template <int STRICT, int LAX> __device__ __forceinline__ void wait_v_sel(int sel) {
    asm volatile("s_cmp_lg_u32 %0, 0\n\ts_cbranch_scc1 1f\n\ts_waitcnt vmcnt(%1)\n1:\n\ts_waitcnt vmcnt(%2)" :: "s"(sel), "n"(STRICT), "n"(LAX) : "scc", "memory"); }
template <int N> __device__ __forceinline__ void wait_v() { asm volatile("s_waitcnt vmcnt(%0)" :: "n"(N) : "memory"); }
struct Unit { int pm, pn, e, r0, nrows, slot; };
struct Gemm { const bf16* A; const bf16* Bt; int K; };

template <class Epi, class Sched>
__device__ __forceinline__ void gemm_phase(LAS unsigned char* lds, const Gemm g, const Sched& S, const Epi& E, const int tid) {
    const int  wid = __builtin_amdgcn_readfirstlane(tid >> 6), lane = tid & 63, wr = wid >> 2, wc = wid & 3, fr = lane & 15, fq = lane >> 4;
    const int K = g.K, nt = K / BK;
    int RA[2], CA[2]; unsigned voffB[2];
#pragma unroll
    for (int i = 0; i < 2; ++i) { int R, C; stage_rc(tid * 16 + i * 8192, R, C); const int Rb = Epi::PERM ? (64 * (R >> 5) + perm32(R & 31)) : R;
        RA[i] = R; CA[i] = C; voffB[i] = (unsigned)(Rb * K + C) * 2u; }
    const size_t kstep = (size_t)(BK * 2);
    const size_t hstep = (size_t)(Epi::PERM ? 32 : HALF) * K * 2;
    const size_t tstep = (size_t)BM * K * 2;
    const unsigned ldsw = (unsigned)wid * 1024u;
    const int aoff = lds_byte(wr * 64 + fr, fq * 8), boff = lds_byte(wc * 32 + fr, fq * 8);
#define PG8_SA(b, h) (((b) * 2 + (h)) * HTB)
#define PG8_SB(b, h) ((4 + (b) * 2 + (h)) * HTB)
    const __amdgpu_buffer_rsrc_t rsA = __builtin_amdgcn_make_buffer_rsrc((void*)g.A, (short)0, 0x7fffffff, 0x00020000);
    const __amdgpu_buffer_rsrc_t rsB = __builtin_amdgcn_make_buffer_rsrc((void*)g.Bt, (short)0, 0x7fffffff, 0x00020000);
#define PG8_STAGE_X(rs, base0, bufoff, gbase, voff) do { const unsigned so_ = (unsigned)((const char*)(gbase) - (const char*)(base0)); _Pragma("unroll") for (int _i = 0; _i < 2; ++_i) \
        __builtin_amdgcn_raw_ptr_buffer_load_lds(rs, (LAS unsigned*)(lds + (bufoff) + ldsw + _i * 8192), 16, (int)(voff)[_i], (int)so_, 0, 0); } while (0)
#define PG8_STAGE_A(bufoff, gbase, voff) PG8_STAGE_X(rsA, g.A, bufoff, gbase, voff)
#define PG8_STAGE_B(bufoff, gbase, voff) PG8_STAGE_X(rsB, g.Bt, bufoff, gbase, voff)
#define PG8_LDA(dst, b, h) do { _Pragma("unroll") for (int m = 0; m < 4; ++m) _Pragma("unroll") for (int k = 0; k < 2; ++k) dst[m][k] = *(const LAS bf16x8*)(lds + PG8_SA(b, h) + aoff + m * 2048 + k * 1024); } while (0)
#define PG8_LDB(dst, b, h) do { _Pragma("unroll") for (int n = 0; n < 2; ++n) _Pragma("unroll") for (int k = 0; k < 2; ++k) dst[n][k] = *(const LAS bf16x8*)(lds + PG8_SB(b, h) + boff + n * 2048 + k * 1024); } while (0)
#define PG8_MMA(ai, bj, At, Bt) do { __builtin_amdgcn_s_setprio(1); _Pragma("unroll") for (int m = 0; m < 4; ++m) _Pragma("unroll") for (int n = 0; n < 2; ++n) _Pragma("unroll") for (int k = 0; k < 2; ++k) \
        acc[ai][bj][m][n] = __builtin_amdgcn_mfma_f32_16x16x32_bf16(Bt[n][k], At[m][k], acc[ai][bj][m][n], 0, 0, 0); __builtin_amdgcn_s_setprio(0); } while (0)
#define PG8_WAIT_V(n) asm volatile("s_waitcnt vmcnt(" #n ")" ::: "memory")
#define PG8_WAIT_L(n) asm volatile("s_waitcnt lgkmcnt(" #n ")" ::: "memory")
#define PG8_BAR __builtin_amdgcn_s_barrier()
#define PG8_SCHED __builtin_amdgcn_sched_barrier(0)
#define PG8_AOFF(dst, u) do { _Pragma("unroll") for (int _h = 0; _h < 2; ++_h) _Pragma("unroll") for (int _i = 0; _i < 2; ++_i) \
        dst[_h][_i] = ((unsigned)S.arow(u, _h * HALF + RA[_i]) * (unsigned)K + (unsigned)CA[_i]) * 2u; } while (0)
    Unit cur, nxt; int ui = 0;
    if (!S.next(0, cur)) return;
    f32x4 acc[2][2][4][2];
#pragma unroll
    for (int a = 0; a < 2; ++a)
#pragma unroll
        for (int b = 0; b < 2; ++b)
#pragma unroll
            for (int m = 0; m < 4; ++m)
#pragma unroll
                for (int n = 0; n < 2; ++n) acc[a][b][m][n] = (f32x4){0.f, 0.f, 0.f, 0.f};
    bf16x8 At[4][2], B0[2][2], B1[2][2];
    unsigned cv[2][2], nv[2][2];
    PG8_AOFF(cv, cur);
    const char* Ab = (const char*)g.A;
    const char* cB = (const char*)g.Bt + (size_t)cur.pn * tstep;
    {
        PG8_STAGE_B(PG8_SB(0, 0), cB, voffB); PG8_STAGE_B(PG8_SB(0, 1), cB + hstep, voffB); PG8_STAGE_A(PG8_SA(0, 0), Ab, cv[0]); PG8_STAGE_A(PG8_SA(0, 1), Ab, cv[1]);
        if (wr == 1) PG8_BAR;
        PG8_WAIT_V(2); PG8_BAR;
        PG8_STAGE_B(PG8_SB(1, 0), cB + kstep, voffB); PG8_STAGE_A(PG8_SA(1, 0), Ab + kstep, cv[0]); PG8_STAGE_B(PG8_SB(1, 1), cB + hstep + kstep, voffB);
        PG8_WAIT_V(6); PG8_BAR;
    }
    for (;;) {
        const bool has_next = S.next(ui + 1, nxt);
        if (has_next) { PG8_AOFF(nv, nxt); } else {
#pragma unroll
            for (int _h = 0; _h < 2; ++_h)
#pragma unroll
                for (int _i = 0; _i < 2; ++_i) nv[_h][_i] = cv[_h][_i]; }
        const char* nB = has_next ? (const char*)g.Bt + (size_t)nxt.pn * tstep : cB;
        for (int t = 0; t < nt; t += 2) {
            const bool last = (t == nt - 2);
            const int relax = __builtin_amdgcn_readfirstlane(((t == 0) && (ui > 0)) ? 1 : 0);
            const char* a1 = Ab + (size_t)(t + 1) * kstep;
            const char* a2 = last ? Ab : Ab + (size_t)(t + 2) * kstep; const char* b2 = last ? nB : cB + (size_t)(t + 2) * kstep;
            const char* a3 = a2 + kstep; const char* b3 = b2 + kstep;
            unsigned o2[2][2];
#pragma unroll
            for (int _h = 0; _h < 2; ++_h)
#pragma unroll
                for (int _i = 0; _i < 2; ++_i) o2[_h][_i] = last ? nv[_h][_i] : cv[_h][_i];
            PG8_LDB(B0, 0, 0); PG8_LDB(B1, 0, 1); PG8_SCHED; PG8_LDA(At, 0, 0); PG8_STAGE_A(PG8_SA(1, 1), a1, cv[1]);
            wait_v_sel<8, 8 + Epi::NST>(relax);
            PG8_WAIT_L(0); PG8_BAR; PG8_MMA(0, 0, At, B0); PG8_MMA(0, 1, At, B1); PG8_BAR; PG8_SCHED;
            PG8_LDA(At, 0, 1); PG8_STAGE_B(PG8_SB(0, 0), b2, voffB); PG8_STAGE_B(PG8_SB(0, 1), b2 + hstep, voffB); PG8_STAGE_A(PG8_SA(0, 0), a2, o2[0]);
            wait_v_sel<8, 8 + Epi::NST>(relax);
            PG8_WAIT_L(0); PG8_BAR; PG8_MMA(1, 0, At, B0); PG8_MMA(1, 1, At, B1); PG8_BAR; PG8_SCHED;
            PG8_LDB(B0, 1, 0); PG8_LDB(B1, 1, 1); PG8_SCHED; PG8_LDA(At, 1, 0); PG8_STAGE_A(PG8_SA(0, 1), a2, o2[1]);
            PG8_WAIT_V(8); PG8_WAIT_L(0); PG8_BAR; PG8_MMA(0, 0, At, B0); PG8_MMA(0, 1, At, B1); PG8_BAR; PG8_SCHED;
            PG8_LDA(At, 1, 1); PG8_STAGE_B(PG8_SB(1, 0), b3, voffB); PG8_STAGE_B(PG8_SB(1, 1), b3 + hstep, voffB); PG8_STAGE_A(PG8_SA(1, 0), a3, o2[0]);
            PG8_WAIT_V(8); PG8_WAIT_L(0); PG8_BAR; PG8_MMA(1, 0, At, B0); PG8_MMA(1, 1, At, B1); PG8_BAR; PG8_SCHED;
        }
        if (wr == 0) PG8_BAR;
        { int le; asm volatile("v_mbcnt_lo_u32_b32 %0, -1, 0\n\tv_mbcnt_hi_u32_b32 %0, -1, %0" : "=v"(le));
          E(acc, cur, wr, wc, le & 15, le >> 4); }
        if (!has_next) break;
#pragma unroll
        for (int a = 0; a < 2; ++a)
#pragma unroll
            for (int b = 0; b < 2; ++b)
#pragma unroll
                for (int m = 0; m < 4; ++m)
#pragma unroll
                    for (int n = 0; n < 2; ++n) acc[a][b][m][n] = (f32x4){0.f, 0.f, 0.f, 0.f};
        cur = nxt; cB = nB; ++ui;
#pragma unroll
        for (int _h = 0; _h < 2; ++_h)
#pragma unroll
            for (int _i = 0; _i < 2; ++_i) cv[_h][_i] = nv[_h][_i];
        if (wr == 1) PG8_BAR;
    }
    PG8_WAIT_V(0);
    PG8_BAR;
#undef PG8_SA
#undef PG8_SB
#undef PG8_STAGE_X
#undef PG8_STAGE_A
#undef PG8_STAGE_B
#undef PG8_LDA
#undef PG8_LDB
#undef PG8_MMA
#undef PG8_WAIT_V
#undef PG8_WAIT_L
#undef PG8_BAR
#undef PG8_SCHED
#undef PG8_AOFF
}

struct DenseOrder {
    int nM, nN, nwg, G, c; unsigned long long cperm;
    __device__ void init(int M, int N, int G_, int c_, unsigned long long cperm_ = 0ull) { nM = M / BM; nN = N / BM; nwg = nM * nN; G = G_; c = c_; cperm = cperm_; }
    __device__ __forceinline__ bool next(int i, Unit& u) const {
        const long L = (long)i * G + c; if (L >= nwg) return false;
        int wgid = (int)L; { const int q = nwg / 8, r = nwg % 8, xcd = wgid % 8, off = wgid / 8; wgid = (xcd < r ? xcd * (q + 1) : r * (q + 1) + (xcd - r) * q) + off; }
        const int nig = 8 * nN, gid = wgid / nig, fm = gid * 8, gsz = (nM - fm) < 8 ? (nM - fm) : 8;
        u.pm = fm + ((wgid % nig) % gsz); u.pn = (wgid % nig) / gsz; if (cperm) u.pn = (int)((cperm >> (4 * u.pn)) & 15ull);
        u.e = 0; u.r0 = 0; u.nrows = BM; u.slot = 0; return true;
    }
    __device__ __forceinline__ int arow(const Unit& u, int r) const { return u.pm * BM + r; }
};
__device__ __forceinline__ void xpose128(LAS unsigned char* scr, int fr, int fq, const u32x4& w0, const u32x4& w1, u32x4& rA, u32x4& rB) {
    const int sw = fr & 7;
    *(LAS u32x4*)(scr + fr * 128 + ((fq ^ sw) << 4)) = w0;
    *(LAS u32x4*)(scr + fr * 128 + (((4 + fq) ^ sw) << 4)) = w1;
    asm volatile("" ::: "memory");
    const int l = fr + 16 * fq, r = l >> 3, c = l & 7;
    rA = *(const LAS u32x4*)(scr + r * 128 + ((c ^ r) << 4));
    rB = *(const LAS u32x4*)(scr + 1024 + r * 128 + ((c ^ r) << 4));
    asm volatile("" ::: "memory");
}
}

#define XB_TMO      128
#define XB_XCNT(j)  (256  + 64 * (j))
#define XB_XSUB(j)  (1280 + 64 * (j))
#define XB_XGEN(j)  (2304 + 64 * (j))
#define XB_TOP      3328
#define XB_TOPGEN   3392
#define XCD_BAR_WORDS 3456
#define XB_SPIN_CAP (1u << 18)
__device__ __forceinline__ unsigned xb_ld(unsigned* p)              { return __hip_atomic_load(p, __ATOMIC_RELAXED, __HIP_MEMORY_SCOPE_AGENT); }
__device__ __forceinline__ unsigned xb_add(unsigned* p, unsigned v) { return __hip_atomic_fetch_add(p, v, __ATOMIC_RELAXED, __HIP_MEMORY_SCOPE_AGENT); }
__device__ __forceinline__ unsigned xb_xcc_id() { return (unsigned)__builtin_amdgcn_s_getreg((3 << 11) | 20) & 0xFu; }
#define XB_SPIN(cond, bar) do { unsigned _sp = 0; while (cond) { __builtin_amdgcn_s_sleep(1); \
    if ((++_sp & 255u) == 0u) { if (xb_ld(&(bar)[XB_TMO])) break; if (_sp > XB_SPIN_CAP) { atomicAdd(&(bar)[XB_TMO], 1u); break; } } } } while (0)
struct XcdBarrier { unsigned* bar; unsigned x; volatile LAS unsigned* st; };
__device__ __forceinline__ XcdBarrier xcd_barrier_post(unsigned* bar, volatile LAS unsigned* st) {
    XcdBarrier b; b.bar = bar; b.x = xb_xcc_id(); b.st = st;
    if (threadIdx.x == 0) (void)xb_add(&bar[XB_XCNT(b.x)], 1u);
    return b;
}
__device__ __forceinline__ void xcd_barrier_complete(unsigned* bar, unsigned x, unsigned& nloc, unsigned& nx) {
    const unsigned G = gridDim.x * gridDim.y * gridDim.z;
    unsigned sum, cnt, mine, sp = 0u;
    for (;;) {
        sum = 0u; cnt = 0u; mine = 0u;
#pragma unroll
        for (unsigned j = 0; j < 16; ++j) { const unsigned c = xb_ld(&bar[XB_XCNT(j)]); sum += c; cnt += (c > 0u) ? 1u : 0u; mine = (j == x) ? c : mine; }
        if (sum == G) break;
        __builtin_amdgcn_s_sleep(1);
        if ((++sp & 255u) == 0u) { if (xb_ld(&bar[XB_TMO])) break; if (sp > XB_SPIN_CAP) { atomicAdd(&bar[XB_TMO], 1u); break; } }
    }
    nloc = mine > 0u ? mine : 1u; nx = cnt > 0u ? cnt : 1u;
}
__device__ __forceinline__ void xcd_barrier(const XcdBarrier& b) {
    asm volatile("s_waitcnt vmcnt(0)" ::: "memory");
    __syncthreads();
    if (threadIdx.x == 0) {
        unsigned* bar = b.bar;
        __builtin_amdgcn_s_waitcnt(0);
        unsigned nloc = b.st[0], nx = b.st[1];
        if (nloc == 0u) { xcd_barrier_complete(bar, b.x, nloc, nx); b.st[0] = nloc; b.st[1] = nx; }
        const unsigned old = xb_add(&bar[XB_XSUB(b.x)], 1u);
        const unsigned gen = old / nloc;
        if (old + 1u == (gen + 1u) * nloc) {
            __builtin_amdgcn_fence(__ATOMIC_RELEASE, "agent");
            asm volatile("s_waitcnt vmcnt(0)" ::: "memory");
            const unsigned og = xb_add(&bar[XB_TOP], 1u);
            const unsigned tg = og / nx;
            if (og + 1u == (tg + 1u) * nx) xb_add(&bar[XB_TOPGEN], 1u);
            else XB_SPIN(xb_ld(&bar[XB_TOPGEN]) == tg, bar);
            __builtin_amdgcn_fence(__ATOMIC_ACQUIRE, "agent");
            xb_add(&bar[XB_XGEN(b.x)], 1u);
            asm volatile("s_waitcnt vmcnt(0)" ::: "memory");
        } else {
            XB_SPIN(xb_ld(&bar[XB_XGEN(b.x)]) == gen, bar);
            __builtin_amdgcn_fence(__ATOMIC_ACQUIRE, "agent");
            asm volatile("s_waitcnt vmcnt(0)" ::: "memory");
        }
    }
    __syncthreads();
}

struct Args { const float* in[24]; float* out; unsigned char* ws; };
struct Frame {
    LAS unsigned char* lds;
    int tid, lane, wave, vcu, G;
};

template <int MODE>
__device__ __forceinline__ void p0_transpose_item(const float* W, int K, int N, bf16* WT, LAS float* scr, int item, int lane) {
    const int nblk = N / 32, kb = item / nblk, nb = item % nblk, k0 = 64 * kb, n0 = 32 * nb;
    f32x4 v[8];
#pragma unroll
    for (int i = 0; i < 8; ++i) v[i] = *(const f32x4*)(W + (size_t)(k0 + 8 * i + (lane >> 3)) * N + n0 + 4 * (lane & 7));
#pragma unroll
    for (int i = 0; i < 8; ++i) { LAS float* d = scr + (8 * i + (lane >> 3)) * 33 + 4 * (lane & 7); d[0] = v[i].x; d[1] = v[i].y; d[2] = v[i].z; d[3] = v[i].w; }
    asm volatile("s_waitcnt lgkmcnt(0)" ::: "memory");
    const int c = lane & 7;
#pragma unroll
    for (int j = 0; j < 4; ++j) { const int n = (lane >> 3) + 8 * j; const LAS float* s = scr + (8 * c) * 33 + n;
        u32x4 o; o.x = cvtpk(s[0 * 33], s[1 * 33]); o.y = cvtpk(s[2 * 33], s[3 * 33]); o.z = cvtpk(s[4 * 33], s[5 * 33]); o.w = cvtpk(s[6 * 33], s[7 * 33]);
        const int f = n0 + n; int row = f;
        if (MODE == 1) row = ((f >> 7) << 8) + (((f >> 5) & 3) << 6) + (f & 31);
        if (MODE == 2) row = ((f >> 7) << 8) + (((f >> 5) & 3) << 6) + 32 + (f & 31);
        *(u32x4*)(WT + (size_t)row * K + k0 + 8 * c) = o; }
    asm volatile("s_waitcnt lgkmcnt(0)" ::: "memory");
}

__device__ __forceinline__ void p0_prologue(const Frame& F, const Args& a) {
    unsigned char* ws = a.ws;
    if (F.vcu < 96) {
        LAS float* cact = (LAS float*)F.lds;
        LAS float* red = (LAS float*)(F.lds + 32768);
        const float* c = a.in[1];
        for (int i = F.tid; i < 8192; i += NTHREADS) { const int b = i >> 10, k = i & 1023; cact[k * 8 + b] = siluf_(c[i]); }
        __syncthreads();
        const int j = F.vcu * 64 + F.lane;
        const float* w = a.in[2] + (size_t)(128 * F.wave) * 6144 + j;
        float acc[8];
#pragma unroll
        for (int b = 0; b < 8; ++b) acc[b] = 0.f;
#pragma unroll 16
        for (int k = 0; k < 128; ++k) { const float wv = w[(size_t)k * 6144]; const LAS float* cp = cact + (128 * F.wave + k) * 8; const f32x4 c0 = *(const LAS f32x4*)cp, c1 = *(const LAS f32x4*)(cp + 4);
            acc[0] += c0.x * wv; acc[1] += c0.y * wv; acc[2] += c0.z * wv; acc[3] += c0.w * wv; acc[4] += c1.x * wv; acc[5] += c1.y * wv; acc[6] += c1.z * wv; acc[7] += c1.w * wv; }
#pragma unroll
        for (int b = 0; b < 8; ++b) red[(F.wave * 8 + b) * 64 + F.lane] = acc[b];
        __syncthreads();
        { const int b = F.tid >> 6; float s = 0.f;
#pragma unroll
          for (int ww = 0; ww < 8; ++ww) s += red[(ww * 8 + b) * 64 + F.lane];
          ((float*)(ws + WS_MOD))[b * 6144 + j] = s + a.in[3][j]; }
        __syncthreads();
    }
    LAS float* scr = (LAS float*)(F.lds + F.wave * 16384);
    const int gw = F.vcu * NWAVES + F.wave, NGW = F.G * NWAVES;
    constexpr int I_IN = 16 * 112, I_OUT = 16 * 32;
    constexpr int NITEMS = I_IN + I_OUT;
    bf16* win = (bf16*)(ws + WS_WIN); bf16* wout = (bf16*)(ws + WS_WOUT);
    for (int it = NITEMS - 1 - gw; it >= 0; it -= NGW) {
        int r = it;
        if (r < I_IN) { p0_transpose_item<0>(a.in[6], 1024, INW, win, scr, r, F.lane); continue; } r -= I_IN;
        p0_transpose_item<0>(a.in[15], 1024, 1024, wout, scr, r, F.lane);
    }
}

__device__ __forceinline__ void p0b_norm1(const Frame& F, const Args& a) {
    const float* x = a.in[0]; const float* ng = a.in[4]; const float* mod = (const float*)(a.ws + WS_MOD);
    bf16* H = (bf16*)(a.ws + WS_H);
    const int gw = F.vcu * NWAVES + F.wave, NGW = F.G * NWAVES;
    const int per = (NTOK + NGW - 1) / NGW;
    const int m0 = gw * per, m1 = (m0 + per < NTOK) ? m0 + per : NTOK;
    if (m0 >= NTOK) return;
    for (int s0 = m0; s0 < m1; ) {
        const int b = s0 >> 13, e1 = ((b + 1) << 13) < m1 ? ((b + 1) << 13) : m1;
        f32x4 ga[4], sha[4];
        { const f32x4* gp = (const f32x4*)ng + F.lane; const f32x4* shp = (const f32x4*)(mod + b * 6144) + F.lane; const f32x4* scp = (const f32x4*)(mod + b * 6144 + 1024) + F.lane;
#pragma unroll
          for (int j = 0; j < 4; ++j) { ga[j] = gp[64 * j] * (scp[64 * j] + 1.f); sha[j] = shp[64 * j]; } }
        f32x4 nx[4];
        { const f32x4* xr = (const f32x4*)(x + (size_t)s0 * D) + F.lane;
#pragma unroll
          for (int j = 0; j < 4; ++j) nx[j] = xr[64 * j]; }
        for (int m = s0; m < e1; ++m) {
            f32x4 v[4];
#pragma unroll
            for (int j = 0; j < 4; ++j) v[j] = nx[j];
            { const int mn = (m + 1 < e1) ? m + 1 : m; const f32x4* xr = (const f32x4*)(x + (size_t)mn * D) + F.lane;
#pragma unroll
              for (int j = 0; j < 4; ++j) nx[j] = xr[64 * j]; }
            float s = 0.f;
#pragma unroll
            for (int j = 0; j < 4; ++j) s += (v[j].x * v[j].x + v[j].y * v[j].y) + (v[j].z * v[j].z + v[j].w * v[j].w);
            const float r = __builtin_amdgcn_rsqf(wave_sum(s) * (1.f / D) + EPS);
            u32x2* o8 = (u32x2*)(H + (size_t)m * D) + F.lane;
#pragma unroll
            for (int j = 0; j < 4; ++j) { const f32x4 y = v[j] * r * ga[j] + sha[j];
                u32x2 o; o.x = cvtpk(y.x, y.y); o.y = cvtpk(y.z, y.w); o8[64 * j] = o; }
        }
        s0 = e1;
    }
}

struct EpiProj {
    static constexpr bool PERM = true;
    static constexpr int NST = 16;
    bf16* O; const float* lbraw;
    bf16* QC; bf16* KV;
    LAS unsigned char* scr;
    __device__ __forceinline__ void operator()(const f32x4 (&acc)[2][2][4][2], const pg8::Unit& u, int wr, int wc, int fr, int fq) const {
        const int seg = u.pn >> 1;
        const int col0 = u.pn * 256 + wc * 64 + 8 * fq;
        float lb[2][8];
        if (seg == 4) {
#pragma unroll
            for (int bj = 0; bj < 2; ++bj)
#pragma unroll
                for (int i = 0; i < 8; ++i) { const int k = col0 + bj * 32 + i - COL_FR; const float r0 = lbraw[k], r1 = lbraw[512 + k]; lb[bj][i] = fast_rcp(1.f + fast_exp2((r1 - r0) * LOG2E)); }
        }
        LAS unsigned char* ws_ = scr + (wr * 4 + wc) * 2048;
        const int l = fr + 16 * fq, r8 = l >> 3, c8 = l & 7;
        const int colT = u.pn * 256 + wc * 64 + 8 * c8, rowT = u.pm * 256 + wr * 64 + r8;
        u32x4 rq[2][2];
#pragma unroll
        for (int it = 0; it <= 8; ++it) {
            if (it < 8) { const int ai = it >> 2, m = it & 3; u32x4 w[2];
#pragma unroll
                for (int bj = 0; bj < 2; ++bj) { float v[8];
#pragma unroll
                    for (int i = 0; i < 4; ++i) { v[i] = acc[ai][bj][m][0][i]; v[4 + i] = acc[ai][bj][m][1][i]; }
                    if (seg == 0) {
#pragma unroll
                        for (int i = 0; i < 8; ++i) v[i] *= QSCALE;
                    } else if (seg == 3 || seg == 6) {
#pragma unroll
                        for (int i = 0; i < 8; ++i) v[i] = siluf_(v[i]);
                    } else if (seg == 4) {
#pragma unroll
                        for (int i = 0; i < 8; ++i) { const float lw = lb[bj][i]; v[i] = __builtin_amdgcn_logf(lw + (1.f - lw) * sigmoidf_(v[i])) * 0.6931471805599453f; }
                    }
                    w[bj].x = cvtpk(v[0], v[1]); w[bj].y = cvtpk(v[2], v[3]); w[bj].z = cvtpk(v[4], v[5]); w[bj].w = cvtpk(v[6], v[7]); }
                pg8::xpose128(ws_, fr, fq, w[0], w[1], rq[it & 1][0], rq[it & 1][1]); }
            if (it > 0) { const int ai = (it - 1) >> 2, m = (it - 1) & 3; const u32x4 rA = rq[(it - 1) & 1][0], rB = rq[(it - 1) & 1][1];
                const int row = rowT + ai * 128 + m * 16;
                if (seg < 3) {
                    const int c = colT & 511, hh = c >> 7, e = c & 127; const size_t tokrow = (size_t)((row >> 13) * 4 + hh) * SEQ + (row & (SEQ - 1));
                    if (seg == 0) { bf16* dst = QC + tokrow * 128 + e; *(u32x4*)dst = rA; *(u32x4*)(dst + 8 * 128) = rB; }
                    else { bf16* dst = KV + tokrow * 256 + (seg == 2 ? 128 : 0) + e; *(u32x4*)dst = rA; *(u32x4*)(dst + 8 * 256) = rB; }
                } else { bf16* rowp = O + (size_t)row * INW + colT; *(u32x4*)rowp = rA; *(u32x4*)(rowp + (size_t)8 * INW) = rB; } } }
    }
};

struct EpiRes1 {
    static constexpr bool PERM = true;
    static constexpr int NST = 16;
    const float* x; bf16* x1b; const float* mod;
    LAS unsigned char* scr;
    __device__ __forceinline__ void operator()(const f32x4 (&acc)[2][2][4][2], const pg8::Unit& u, int wr, int wc, int fr, int fq) const {
        const int b = (u.pm * 256) >> 13;
        const int col0 = u.pn * 256 + wc * 64 + 8 * fq;
        f32x4 gv[2][2];
#pragma unroll
        for (int bj = 0; bj < 2; ++bj)
#pragma unroll
            for (int n = 0; n < 2; ++n) gv[bj][n] = *(const f32x4*)(mod + b * 6144 + 2048 + col0 + bj * 32 + n * 4);
        LAS unsigned char* ws_ = scr + (wr * 4 + wc) * 2048;
        const int l = fr + 16 * fq, r8 = l >> 3, c8 = l & 7;
        const int colT = u.pn * 256 + wc * 64 + 8 * c8, rowT = u.pm * 256 + wr * 64 + r8;
        f32x4 xb[3][4];
#define RES1_LOAD(it) do { const size_t o_ = (size_t)(rowT + ((it) >> 2) * 128 + ((it) & 3) * 16) * D + colT; \
            xb[(it) % 3][0] = *(const f32x4*)(x + o_); xb[(it) % 3][1] = *(const f32x4*)(x + o_ + 4); xb[(it) % 3][2] = *(const f32x4*)(x + o_ + 8 * D); xb[(it) % 3][3] = *(const f32x4*)(x + o_ + 8 * D + 4); } while (0)
        RES1_LOAD(0); RES1_LOAD(1);
#pragma unroll
        for (int it = 0; it < 8; ++it) { const int ai = it >> 2, m = it & 3; const size_t off = (size_t)(rowT + ai * 128 + m * 16) * D + colT;
            if (it + 2 < 8) RES1_LOAD(it + 2);
            u32x4 w[2];
#pragma unroll
            for (int bj = 0; bj < 2; ++bj) { const f32x4 t0 = gv[bj][0] * acc[ai][bj][m][0], t1 = gv[bj][1] * acc[ai][bj][m][1];
                w[bj].x = cvtpk(t0.x, t0.y); w[bj].y = cvtpk(t0.z, t0.w); w[bj].z = cvtpk(t1.x, t1.y); w[bj].w = cvtpk(t1.z, t1.w); }
            u32x4 rA, rB; pg8::xpose128(ws_, fr, fq, w[0], w[1], rA, rB);
            const f32x4 xa0 = xb[it % 3][0], xa1 = xb[it % 3][1], xb0 = xb[it % 3][2], xb1 = xb[it % 3][3];
            u32x4 o;
            o.x = cvtpk(xa0.x + bflo(rA.x), xa0.y + bfhi(rA.x)); o.y = cvtpk(xa0.z + bflo(rA.y), xa0.w + bfhi(rA.y));
            o.z = cvtpk(xa1.x + bflo(rA.z), xa1.y + bfhi(rA.z)); o.w = cvtpk(xa1.z + bflo(rA.w), xa1.w + bfhi(rA.w));
            *(u32x4*)(x1b + off) = o;
            o.x = cvtpk(xb0.x + bflo(rB.x), xb0.y + bfhi(rB.x)); o.y = cvtpk(xb0.z + bflo(rB.y), xb0.w + bfhi(rB.y));
            o.z = cvtpk(xb1.x + bflo(rB.z), xb1.y + bfhi(rB.z)); o.w = cvtpk(xb1.z + bflo(rB.w), xb1.w + bfhi(rB.w));
            *(u32x4*)(x1b + off + 8 * D) = o; }
#undef RES1_LOAD
    }
};

constexpr int WC_ITEMS = 3 * 32 * 256, WC_CHUNKS = WC_ITEMS / (32 * 8);
typedef const __attribute__((address_space(1))) f32x4* gcf4p;
typedef __attribute__((address_space(1))) u32x4* gu4p;
__device__ __forceinline__ void wconv_load(const Args& a, f32x4 (&v)[8], int it, int lane) {
    const int m = it >> 13, r = it & 8191, e = r >> 8, blk = r & 255;
    const int N = m < 2 ? 512 : 1024, nb = m < 2 ? (blk & 15) : (blk & 31), kb = m < 2 ? (blk >> 4) : (blk >> 5);
    const float* p1 = a.in[20]; const float* p3 = a.in[21]; const float* p2 = a.in[22]; asm volatile("" : "+s"(p1), "+s"(p3), "+s"(p2));
    const float* W = (m == 0 ? p1 : m == 1 ? p3 : p2) + (size_t)e * (1024 * 512) + (size_t)(64 * kb + 8 * (lane >> 3)) * N + 32 * nb + 4 * (lane & 7);
#pragma unroll
    for (int i = 0; i < 8; ++i) v[i] = *(gcf4p)(W + (size_t)i * N);
}
__device__ __forceinline__ void wconv_store(const Args& a, const f32x4 (&v)[8], int it, int lane, LAS unsigned char* scr) {
    const int m = it >> 13, r = it & 8191, e = r >> 8, blk = r & 255;
    const int K = m < 2 ? 1024 : 512, nb = m < 2 ? (blk & 15) : (blk & 31), kb = m < 2 ? (blk >> 4) : (blk >> 5);
    bf16* q13 = (bf16*)(a.ws + WS_W13); bf16* q2 = (bf16*)(a.ws + WS_W2); asm volatile("" : "+s"(q13), "+s"(q2));
    bf16* WT = (m < 2 ? q13 + (size_t)e * (1024 * 1024) : q2 + (size_t)e * (1024 * 512)) + 64 * kb;
    const int kk = lane >> 3, nn = lane & 7;
#pragma unroll
    for (int h = 0; h < 2; ++h) {
#pragma unroll
        for (int jj = 0; jj < 2; ++jj) { const int j = 2 * h + jj;
            u32x4 o; o.x = cvtpk(v[0][j], v[1][j]); o.y = cvtpk(v[2][j], v[3][j]); o.z = cvtpk(v[4][j], v[5][j]); o.w = cvtpk(v[6][j], v[7][j]);
            *(LAS u32x4*)(scr + (8 * jj + nn) * 128 + ((kk ^ nn) << 4)) = o; }
        asm volatile("" ::: "memory");
#pragma unroll
        for (int p = 0; p < 2; ++p) { const int f = 32 * nb + 4 * kk + 2 * h + p;
            const u32x4 o = *(const LAS u32x4*)(scr + (8 * p + kk) * 128 + ((nn ^ kk) << 4));
            const int row = m < 2 ? ((f >> 7) << 8) + (((f >> 5) & 3) << 6) + (m == 1 ? 32 : 0) + (f & 31) : f;
            *(gu4p)(WT + (size_t)row * K + 8 * nn) = o; }
        asm volatile("" ::: "memory");
    }
}

constexpr int HG_RS_ = 272, HG_SCS = 144, HG_ARR = 64 * HG_RS_;
constexpr int HG_RAW = 0, HG_QT = 3 * HG_ARR, HG_KT = HG_QT + HG_ARR, HG_SC = HG_KT + HG_ARR, HG_SEG = HG_SC + 64 * HG_SCS, HG_EL = HG_SEG + 4096, HG_OUT = HG_EL + 512, HG_END = HG_OUT + HG_ARR;
static_assert(HG_END <= RING_BYTES, "hgrn LDS map");
__device__ __forceinline__ s16x4 tr16(const LAS unsigned char* p) { return __builtin_bit_cast(s16x4, __builtin_amdgcn_ds_read_tr16_b64_v4i16((LAS s16x4*)p)); }

__device__ __forceinline__ void hgrn_stream(const Frame& F, const Args& a, int bh) {
    const int b = bh >> 2, h = bh & 3;
    const bf16* P = (const bf16*)(a.ws + WS_PROJ) + (size_t)b * SEQ * INW;
    bf16* Y = (bf16*)(a.ws + WS_Y) + (size_t)b * SEQ * D + 512 + h * 128;
    LAS unsigned char* lds = F.lds;
    const int tid = F.tid, lane = F.lane, w = F.wave, l15 = lane & 15, g = lane >> 4;
    u32x4 pre[4][2], gsr[2];
    const __amdgpu_buffer_rsrc_t prs = __builtin_amdgcn_make_buffer_rsrc((void*)P, (short)0, SEQ * INW * 2, 0x00020000);
    const unsigned hg_voff = (unsigned)((tid >> 4) * INW + COL_QR + h * 128 + (tid & 15) * 8) * 2u;
#define HG_LOAD(c) do { _Pragma("unroll") for (int ar = 0; ar < 4; ++ar) _Pragma("unroll") for (int i = 0; i < 2; ++i) { \
        pre[ar][i] = __builtin_bit_cast(u32x4, __builtin_amdgcn_raw_buffer_load_b128(prs, hg_voff, (unsigned)((((c) * 64 + 32 * i) * INW + 512 * ar) * 2), 0)); } } while (0)
#define HG_STORE() do { _Pragma("unroll") for (int ar = 0; ar < 3; ++ar) _Pragma("unroll") for (int i = 0; i < 2; ++i) { const int q = tid + 512 * i, row = q >> 4, ch = q & 15; \
        *(LAS u32x4*)(lds + HG_RAW + ar * HG_ARR + row * HG_RS_ + ch * 16) = pre[ar][i]; } gsr[0] = pre[3][0]; gsr[1] = pre[3][1]; } while (0)
    f32x4 S[8];
#pragma unroll
    for (int kb = 0; kb < 8; ++kb) S[kb] = (f32x4){0.f, 0.f, 0.f, 0.f};
    float ngc[8];
    { const float* ngp = a.in[14] + h * 128 + (tid & 15) * 8;
#pragma unroll
      for (int i = 0; i < 8; ++i) ngc[i] = ngp[i]; }
    HG_LOAD(0);
    HG_STORE();
    for (int c = 0; c < SEQ / 64; ++c) {
        __syncthreads();
        if (c + 1 < SEQ / 64) HG_LOAD(c + 1);
        const bool wdo = c < WC_CHUNKS; const int wit = (c * 32 + bh) * 8 + w;
        f32x4 wv[8];
        if (wdo) wconv_load(a, wv, wit, lane);
        else {
#pragma unroll
            for (int i = 0; i < 8; ++i) wv[i] = (f32x4){0.f, 0.f, 0.f, 0.f}; }
        float bl[8][2];
        {
            float run0 = 0.f, run1 = 0.f;
#pragma unroll
            for (int i = 0; i < 8; ++i) { const unsigned v = *(const LAS unsigned*)(lds + HG_RAW + HG_ARR + (8 * w + i) * HG_RS_ + 4 * lane);
                run0 += bflo(v); run1 += bfhi(v); bl[i][0] = run0; bl[i][1] = run1; }
            *(LAS f32x2*)(lds + HG_SEG + (w * 128 + 2 * lane) * 4) = (f32x2){run0, run1};
        }
        __syncthreads();
        {
            float off0 = 0.f, off1 = 0.f, tot0 = 0.f, tot1 = 0.f;
#pragma unroll
            for (int s = 0; s < 8; ++s) { const f32x2 v = *(const LAS f32x2*)(lds + HG_SEG + (s * 128 + 2 * lane) * 4); if (s < w) { off0 += v.x; off1 += v.y; } tot0 += v.x; tot1 += v.y; }
            if (w == 0) *(LAS f32x2*)(lds + HG_EL + 2 * lane * 4) = (f32x2){fast_exp2(tot0 * LOG2E), fast_exp2(tot1 * LOG2E)};
#pragma unroll
            for (int i = 0; i < 8; ++i) { const int t = 8 * w + i;
                const unsigned lfv = *(const LAS unsigned*)(lds + HG_RAW + HG_ARR + t * HG_RS_ + 4 * lane);
                const unsigned qv = *(const LAS unsigned*)(lds + HG_RAW + t * HG_RS_ + 4 * lane);
                const float b0 = bl[i][0] + off0, b1 = bl[i][1] + off1;
                const float e0 = fast_exp2(b0 * LOG2E), e1 = fast_exp2(b1 * LOG2E);
                const float k0 = 1.f - fast_exp2(bflo(lfv) * LOG2E), k1 = 1.f - fast_exp2(bfhi(lfv) * LOG2E);
                *(LAS unsigned*)(lds + HG_QT + t * HG_RS_ + 4 * lane) = cvtpk(bflo(qv) * e0, bfhi(qv) * e1);
                *(LAS unsigned*)(lds + HG_KT + t * HG_RS_ + 4 * lane) = cvtpk(k0 * fast_rcp(e0), k1 * fast_rcp(e1)); }
        }
        __syncthreads();
#pragma unroll
        for (int i = 0; i < 2; ++i) { const int tile = 2 * w + i, tb = tile >> 2, sb = tile & 3;
            f32x4 sc = (f32x4){0.f, 0.f, 0.f, 0.f};
#pragma unroll
            for (int ks = 0; ks < 4; ++ks) { const bf16x8 af = *(const LAS bf16x8*)(lds + HG_QT + (16 * tb + l15) * HG_RS_ + (32 * ks + 8 * g) * 2);
                const bf16x8 bfr = *(const LAS bf16x8*)(lds + HG_KT + (16 * sb + l15) * HG_RS_ + (32 * ks + 8 * g) * 2);
                sc = __builtin_amdgcn_mfma_f32_16x16x32_bf16(af, bfr, sc, 0, 0, 0); }
#pragma unroll
            for (int r = 0; r < 4; ++r) { const int t = 16 * tb + 4 * g + r, s = 16 * sb + l15; const float v = (s <= t) ? sc[r] : 0.f;
                *(LAS unsigned short*)(lds + HG_SC + t * HG_SCS + s * 2) = (unsigned short)(cvtpk(v, 0.f) & 0xffffu); } }
        __syncthreads();
        bf16x8 vf[2];
#pragma unroll
        for (int ss = 0; ss < 2; ++ss) { const LAS unsigned char* vp = lds + HG_RAW + 2 * HG_ARR + (32 * ss + 8 * g + (l15 >> 2)) * HG_RS_ + (16 * w + 4 * (l15 & 3)) * 2;
            const s16x4 lo = tr16(vp), hi = tr16(vp + 4 * HG_RS_); vf[ss] = (bf16x8){lo[0], lo[1], lo[2], lo[3], hi[0], hi[1], hi[2], hi[3]}; }
        f32x4 o[4];
        {
            bf16x8 sf[4];
#pragma unroll
            for (int ks = 0; ks < 4; ++ks) { u32x4 t4; t4.x = cvtpk(S[2 * ks][0], S[2 * ks][1]); t4.y = cvtpk(S[2 * ks][2], S[2 * ks][3]); t4.z = cvtpk(S[2 * ks + 1][0], S[2 * ks + 1][1]); t4.w = cvtpk(S[2 * ks + 1][2], S[2 * ks + 1][3]);
                sf[ks] = __builtin_bit_cast(bf16x8, t4); }
#pragma unroll
            for (int tb = 0; tb < 4; ++tb) { f32x4 acc = (f32x4){0.f, 0.f, 0.f, 0.f};
#pragma unroll
                for (int ks = 0; ks < 4; ++ks) { const LAS unsigned char* qp = lds + HG_QT + (16 * tb + l15) * HG_RS_ + (32 * ks + 4 * g) * 2;
                    const u32x2 q0 = *(const LAS u32x2*)qp, q1 = *(const LAS u32x2*)(qp + 32);
                    const u32x4 q4 = (u32x4){q0.x, q0.y, q1.x, q1.y};
                    acc = __builtin_amdgcn_mfma_f32_16x16x32_bf16(__builtin_bit_cast(bf16x8, q4), sf[ks], acc, 0, 0, 0); }
#pragma unroll
                for (int ss = 0; ss < 2; ++ss) { const bf16x8 af = *(const LAS bf16x8*)(lds + HG_SC + (16 * tb + l15) * HG_SCS + (32 * ss + 8 * g) * 2);
                    acc = __builtin_amdgcn_mfma_f32_16x16x32_bf16(af, vf[ss], acc, 0, 0, 0); }
                o[tb] = acc; }
        }
#pragma unroll
        for (int kb = 0; kb < 8; ++kb) {
#pragma unroll
            for (int ss = 0; ss < 2; ++ss) { const LAS unsigned char* kp = lds + HG_KT + (32 * ss + 8 * g + (l15 >> 2)) * HG_RS_ + (16 * kb + 4 * (l15 & 3)) * 2;
                const s16x4 lo = tr16(kp), hi = tr16(kp + 4 * HG_RS_); const bf16x8 af = (bf16x8){lo[0], lo[1], lo[2], lo[3], hi[0], hi[1], hi[2], hi[3]};
                S[kb] = __builtin_amdgcn_mfma_f32_16x16x32_bf16(af, vf[ss], S[kb], 0, 0, 0); }
            const f32x4 el = *(const LAS f32x4*)(lds + HG_EL + (16 * kb + 4 * g) * 4);
            S[kb] = S[kb] * el; }
#pragma unroll
        for (int tb = 0; tb < 4; ++tb)
#pragma unroll
            for (int r = 0; r < 4; ++r) *(LAS unsigned short*)(lds + HG_OUT + (16 * tb + 4 * g + r) * HG_RS_ + (16 * w + l15) * 2) = (unsigned short)(cvtpk(o[tb][r], 0.f) & 0xffffu);
        __syncthreads();
#pragma unroll
        for (int i = 0; i < 2; ++i) { const int q = tid + 512 * i, row = q >> 4, ch = q & 15;
            const u32x4 ov = *(const LAS u32x4*)(lds + HG_OUT + row * HG_RS_ + ch * 16);
            float x[8]; x[0] = bflo(ov.x); x[1] = bfhi(ov.x); x[2] = bflo(ov.y); x[3] = bfhi(ov.y); x[4] = bflo(ov.z); x[5] = bfhi(ov.z); x[6] = bflo(ov.w); x[7] = bfhi(ov.w);
            float ss = 0.f;
#pragma unroll
            for (int j = 0; j < 8; ++j) ss += x[j] * x[j];
            ss = row_sum(ss);
            const float rr = __builtin_amdgcn_rsqf(ss * (1.f / 128.f) + EPS);
            const u32x4 gv = gsr[i];
            u32x4 yo;
            yo.x = cvtpk(x[0] * rr * ngc[0] * bflo(gv.x), x[1] * rr * ngc[1] * bfhi(gv.x)); yo.y = cvtpk(x[2] * rr * ngc[2] * bflo(gv.y), x[3] * rr * ngc[3] * bfhi(gv.y));
            yo.z = cvtpk(x[4] * rr * ngc[4] * bflo(gv.z), x[5] * rr * ngc[5] * bfhi(gv.z)); yo.w = cvtpk(x[6] * rr * ngc[6] * bflo(gv.w), x[7] * rr * ngc[7] * bfhi(gv.w));
            *(u32x4*)(Y + (size_t)(c * 64 + row) * D + ch * 8) = yo; }
        if (c + 1 < SEQ / 64) HG_STORE();
        if (wdo) wconv_store(a, wv, wit, lane, lds + EPI_SCR + w * 2048);
    }
    __syncthreads();
#undef HG_LOAD
#undef HG_STORE
}

constexpr int AT_BUF = 32768, AT_LUT = MISC_OFF + 4096, AT_WS = MISC_OFF + 6144, AT_TKT = MISC_OFF + 8192;
__device__ __forceinline__ int crow(int r, int hi) { return (r & 3) + 8 * (r >> 2) + 4 * hi; }
__device__ __forceinline__ int t5_bucket(int n) {
    if (n < 16) return n;
    int b = 16;
    b += (n >= 19); b += (n >= 21); b += (n >= 24); b += (n >= 27); b += (n >= 31); b += (n >= 35); b += (n >= 40); b += (n >= 46);
    b += (n >= 52); b += (n >= 59); b += (n >= 67); b += (n >= 77); b += (n >= 87); b += (n >= 99); b += (n >= 113);
    return b;
}
__device__ __forceinline__ float fmax_nc(float x, float y) { return __builtin_amdgcn_fmed3f(x, y, INFINITY); }
#define AT_SB() __builtin_amdgcn_sched_barrier(0)

__device__ __forceinline__ void at_qk(f32x16& p0, f32x16& p1, const LAS unsigned char* kb, const bf16x8 (&qf)[4]) {
    bf16x8 kf[8];
#pragma unroll
    for (int d0 = 0; d0 < 4; ++d0) { kf[2 * d0] = *(const LAS bf16x8*)(kb + d0 * 2048); kf[2 * d0 + 1] = *(const LAS bf16x8*)(kb + d0 * 2048 + 512); }
#pragma unroll
    for (int r = 0; r < 16; ++r) { p0[r] = 0.f; p1[r] = 0.f; }
#pragma unroll
    for (int d0 = 0; d0 < 4; ++d0) { p0 = __builtin_amdgcn_mfma_f32_32x32x16_bf16(kf[2 * d0], qf[d0], p0, 0, 0, 0); p1 = __builtin_amdgcn_mfma_f32_32x32x16_bf16(kf[2 * d0 + 1], qf[d0], p1, 0, 0, 0); }
}
__device__ __forceinline__ bf16x8 at_vfrag(const LAS unsigned char* vb, int db, int ks) {
    const s16x4 lo = tr16(vb + db * 4096 + ks * 1024), hh = tr16(vb + db * 4096 + ks * 1024 + 512);
    return (bf16x8){lo[0], lo[1], lo[2], lo[3], hh[0], hh[1], hh[2], hh[3]};
}
__device__ __forceinline__ bf16x8 at_kfrag(const LAS unsigned char* kb, int i) { return *(const LAS bf16x8*)(kb + (i >> 1) * 2048 + (i & 1) * 512); }
__device__ __forceinline__ float at_rowmax(const f32x16& c0, const f32x16& c1) {
    float a, b2;
    asm volatile("s_nop 15\n\ts_nop 7\n\tv_max3_f32 %0, %1, %2, %3" : "=v"(a) : "v"(c0[0]), "v"(c0[1]), "v"(c1[0]));
    asm volatile("v_max3_f32 %0, %1, %2, %3" : "=v"(b2) : "v"(c0[2]), "v"(c0[3]), "v"(c1[1]));
    asm volatile("v_max3_f32 %0, %1, %2, %3" : "=v"(a) : "v"(a), "v"(c1[2]), "v"(c1[3]));
#pragma unroll
    for (int r = 4; r < 16; r += 4) {
        asm volatile("v_max3_f32 %0, %1, %2, %3" : "=v"(a) : "v"(a), "v"(c0[r]), "v"(c0[r + 1]));
        asm volatile("v_max3_f32 %0, %1, %2, %3" : "=v"(b2) : "v"(b2), "v"(c0[r + 2]), "v"(c0[r + 3]));
        asm volatile("v_max3_f32 %0, %1, %2, %3" : "=v"(a) : "v"(a), "v"(c1[r]), "v"(c1[r + 1]));
        asm volatile("v_max3_f32 %0, %1, %2, %3" : "=v"(b2) : "v"(b2), "v"(c1[r + 2]), "v"(c1[r + 3]));
    }
    float m;
    asm volatile("v_max_f32_e32 %0, %1, %2" : "=v"(m) : "v"(a), "v"(b2));
    return fmaxf(m, __shfl_xor(m, 32));
}
constexpr float AT_THR = 6.0f;
#define AT_PK2(P, i) cvtpk(P[i], P[i + 1])

__device__ __forceinline__ void at_step(f32x16& C0, f32x16& C1, const f32x16& P0, const f32x16& P1, f32x16 (&O)[4], const bf16x8 (&qf)[4],
                                        const __amdgpu_buffer_rsrc_t prs, const unsigned k_voff, const unsigned v_voff, const unsigned so0, u32x4 (&pk)[2], u32x4 (&pv)[2],
                                        const LAS unsigned char* kb, const LAS unsigned char* vbp, const LAS unsigned char* kbn,
                                        float& mhat, float& l_reg, bool& resc, const LAS float* lut, bool band, LAS float* wsf, int r32, int hi) {
    bf16x8 va[4], vb[4];
    u32x4 pw0, pw1, pw2, pw3;
    float sacc = 0.f;
    f32x16 z16;
#pragma unroll
    for (int r = 0; r < 16; ++r) z16[r] = 0.f;
    bf16x8 k0 = at_kfrag(kb, 0), k1 = at_kfrag(kb, 1);
    __builtin_amdgcn_s_setprio(1);
    C0 = __builtin_amdgcn_mfma_f32_32x32x16_bf16(k0, qf[0], z16, 0, 0, 0); k0 = at_kfrag(kb, 2); va[0] = at_vfrag(vbp, 0, 0);
    sacc += (P0[0] + P0[1]) + (P0[2] + P0[3]); pw0.x = AT_PK2(P0, 0); pw0.y = AT_PK2(P0, 2); AT_SB();
    C1 = __builtin_amdgcn_mfma_f32_32x32x16_bf16(k1, qf[0], z16, 0, 0, 0); k1 = at_kfrag(kb, 3); va[1] = at_vfrag(vbp, 0, 1);
    sacc += (P0[4] + P0[5]) + (P0[6] + P0[7]); pw0.z = AT_PK2(P0, 4); pw0.w = AT_PK2(P0, 6); AT_SB();
    C0 = __builtin_amdgcn_mfma_f32_32x32x16_bf16(k0, qf[1], C0, 0, 0, 0); k0 = at_kfrag(kb, 4); va[2] = at_vfrag(vbp, 0, 2);
    sacc += (P0[8] + P0[9]) + (P0[10] + P0[11]); pw1.x = AT_PK2(P0, 8); pw1.y = AT_PK2(P0, 10); AT_SB();
    C1 = __builtin_amdgcn_mfma_f32_32x32x16_bf16(k1, qf[1], C1, 0, 0, 0); k1 = at_kfrag(kb, 5); va[3] = at_vfrag(vbp, 0, 3);
    sacc += (P0[12] + P0[13]) + (P0[14] + P0[15]); pw1.z = AT_PK2(P0, 12); pw1.w = AT_PK2(P0, 14); AT_SB();
    C0 = __builtin_amdgcn_mfma_f32_32x32x16_bf16(k0, qf[2], C0, 0, 0, 0); k0 = at_kfrag(kb, 6);
    sacc += (P1[0] + P1[1]) + (P1[2] + P1[3]); pw2.x = AT_PK2(P1, 0); pw2.y = AT_PK2(P1, 2); AT_SB();
    C1 = __builtin_amdgcn_mfma_f32_32x32x16_bf16(k1, qf[2], C1, 0, 0, 0); k1 = at_kfrag(kb, 7);
    sacc += (P1[4] + P1[5]) + (P1[6] + P1[7]); pw2.z = AT_PK2(P1, 4); pw2.w = AT_PK2(P1, 6); AT_SB();
    C0 = __builtin_amdgcn_mfma_f32_32x32x16_bf16(k0, qf[3], C0, 0, 0, 0);
    sacc += (P1[8] + P1[9]) + (P1[10] + P1[11]); pw3.x = AT_PK2(P1, 8); pw3.y = AT_PK2(P1, 10); AT_SB();
    C1 = __builtin_amdgcn_mfma_f32_32x32x16_bf16(k1, qf[3], C1, 0, 0, 0);
    sacc += (P1[12] + P1[13]) + (P1[14] + P1[15]); pw3.z = AT_PK2(P1, 12); pw3.w = AT_PK2(P1, 14); AT_SB();
    { bf16x8 kone, qneg;
      { u32x4 t4 = (u32x4){0u, 0u, 0u, 0u}; if (hi == 0) t4.x = 0x3F80u; kone = __builtin_bit_cast(bf16x8, t4);
        t4.x = 0u; if (hi == 0) t4.x = cvtpk(-mhat, 0.f) & 0xffffu; qneg = __builtin_bit_cast(bf16x8, t4); }
      C0 = __builtin_amdgcn_mfma_f32_32x32x16_bf16(kone, qneg, C0, 0, 0, 0);
      C1 = __builtin_amdgcn_mfma_f32_32x32x16_bf16(kone, qneg, C1, 0, 0, 0); } AT_SB();
    pk[0] = __builtin_bit_cast(u32x4, __builtin_amdgcn_raw_buffer_load_b128(prs, k_voff, so0, 0)); pv[0] = __builtin_bit_cast(u32x4, __builtin_amdgcn_raw_buffer_load_b128(prs, v_voff, so0, 0));
    pk[1] = __builtin_bit_cast(u32x4, __builtin_amdgcn_raw_buffer_load_b128(prs, k_voff, so0 + 32u * 512u, 0)); pv[1] = __builtin_bit_cast(u32x4, __builtin_amdgcn_raw_buffer_load_b128(prs, v_voff, so0 + 32u * 512u, 0));
    l_reg += sacc;
    __builtin_amdgcn_s_setprio(0);
    if (band) {
#pragma unroll
        for (int r = 0; r < 16; ++r) { const int ko = (r & 3) + 8 * (r >> 2); C0[r] += lut[-ko]; C1[r] += lut[-ko - 32]; }
    }
    const float rm = at_rowmax(C0, C1);
    resc = false;
    if (__any(rm > AT_THR)) {
        const float m_new = bf2f((unsigned short)(cvtpk(mhat + fmaxf(rm, 0.f), 0.f) & 0xffffu));
        const float dl = m_new - mhat;
        const float f = fast_exp2(-dl);
        l_reg *= f; if (hi == 0) wsf[r32] = f; mhat = m_new; resc = true;
#pragma unroll
        for (int r = 0; r < 16; ++r) { C0[r] -= dl; C1[r] -= dl; }
    }
    AT_SB();
    __builtin_amdgcn_s_setprio(1);
    const bf16x8 pa0 = __builtin_bit_cast(bf16x8, pw0), pa1 = __builtin_bit_cast(bf16x8, pw1), pa2 = __builtin_bit_cast(bf16x8, pw2), pa3 = __builtin_bit_cast(bf16x8, pw3);
#define AT_EX2(X, i) do { X[i] = fast_exp2(X[i]); X[i + 1] = fast_exp2(X[i + 1]); } while (0)
    O[0] = __builtin_amdgcn_mfma_f32_32x32x16_bf16(pa0, va[0], O[0], 0, 0, 0); vb[0] = at_vfrag(vbp, 1, 0); AT_EX2(C0, 0); AT_SB();
    O[0] = __builtin_amdgcn_mfma_f32_32x32x16_bf16(pa1, va[1], O[0], 0, 0, 0); vb[1] = at_vfrag(vbp, 1, 1); AT_EX2(C0, 2); AT_SB();
    O[0] = __builtin_amdgcn_mfma_f32_32x32x16_bf16(pa2, va[2], O[0], 0, 0, 0); vb[2] = at_vfrag(vbp, 1, 2); AT_EX2(C0, 4); AT_SB();
    O[0] = __builtin_amdgcn_mfma_f32_32x32x16_bf16(pa3, va[3], O[0], 0, 0, 0); vb[3] = at_vfrag(vbp, 1, 3); AT_EX2(C0, 6); AT_SB();
    O[1] = __builtin_amdgcn_mfma_f32_32x32x16_bf16(pa0, vb[0], O[1], 0, 0, 0); va[0] = at_vfrag(vbp, 2, 0); AT_EX2(C0, 8); AT_SB();
    O[1] = __builtin_amdgcn_mfma_f32_32x32x16_bf16(pa1, vb[1], O[1], 0, 0, 0); va[1] = at_vfrag(vbp, 2, 1); AT_EX2(C0, 10); AT_SB();
    O[1] = __builtin_amdgcn_mfma_f32_32x32x16_bf16(pa2, vb[2], O[1], 0, 0, 0); va[2] = at_vfrag(vbp, 2, 2); AT_EX2(C0, 12); AT_SB();
    O[1] = __builtin_amdgcn_mfma_f32_32x32x16_bf16(pa3, vb[3], O[1], 0, 0, 0); va[3] = at_vfrag(vbp, 2, 3); AT_EX2(C0, 14); AT_SB();
    O[2] = __builtin_amdgcn_mfma_f32_32x32x16_bf16(pa0, va[0], O[2], 0, 0, 0); vb[0] = at_vfrag(vbp, 3, 0); AT_EX2(C1, 0); AT_SB();
    O[2] = __builtin_amdgcn_mfma_f32_32x32x16_bf16(pa1, va[1], O[2], 0, 0, 0); vb[1] = at_vfrag(vbp, 3, 1); AT_EX2(C1, 2); AT_SB();
    O[2] = __builtin_amdgcn_mfma_f32_32x32x16_bf16(pa2, va[2], O[2], 0, 0, 0); vb[2] = at_vfrag(vbp, 3, 2); AT_EX2(C1, 4); AT_SB();
    O[2] = __builtin_amdgcn_mfma_f32_32x32x16_bf16(pa3, va[3], O[2], 0, 0, 0); vb[3] = at_vfrag(vbp, 3, 3); AT_EX2(C1, 6); AT_SB();
    O[3] = __builtin_amdgcn_mfma_f32_32x32x16_bf16(pa0, vb[0], O[3], 0, 0, 0); AT_EX2(C1, 8); AT_SB();
    O[3] = __builtin_amdgcn_mfma_f32_32x32x16_bf16(pa1, vb[1], O[3], 0, 0, 0); AT_EX2(C1, 10); AT_SB();
    O[3] = __builtin_amdgcn_mfma_f32_32x32x16_bf16(pa2, vb[2], O[3], 0, 0, 0); AT_EX2(C1, 12); AT_SB();
    O[3] = __builtin_amdgcn_mfma_f32_32x32x16_bf16(pa3, vb[3], O[3], 0, 0, 0); AT_EX2(C1, 14); AT_SB();
    __builtin_amdgcn_s_setprio(0);
#undef AT_EX2
}
__device__ __forceinline__ void at_rescale(f32x16 (&O)[4], const LAS float* wsf, int hi) {
#pragma unroll
    for (int gq = 0; gq < 4; ++gq) { const f32x4 al = *(const LAS f32x4*)(wsf + 8 * gq + 4 * hi);
#pragma unroll
        for (int db = 0; db < 4; ++db) { O[db][4 * gq + 0] *= al.x; O[db][4 * gq + 1] *= al.y; O[db][4 * gq + 2] *= al.z; O[db][4 * gq + 3] *= al.w; } }
}

__device__ __forceinline__ void attn_unit(const Frame& F, const Args& a, int bh, int qb, float lam) {
    const int b = bh >> 2, h = bh & 3;
    const bf16* KVb = (const bf16*)(a.ws + WS_KV) + (size_t)bh * SEQ * 256;
    const bf16* QCb = (const bf16*)(a.ws + WS_QC) + (size_t)bh * SEQ * 128;
    LAS unsigned char* lds = F.lds;
    int tid = F.tid; asm volatile("" : "+v"(tid));
    const int lane = tid & 63, w = F.wave, wq = w & 3, mc = w >> 2, r32 = lane & 31, hi = lane >> 5;
    const int q0 = qb * 128, NT = 2 * qb + 2;
    LAS float* wsf = (LAS float*)(lds + AT_WS + 256 * w);
    const int k_kv = ((tid >> 7) << 3) + (tid & 7), k_ch = (tid >> 3) & 15;
    const int k_lds = (k_ch >> 3) * 8192 + (k_ch & 7) * 1024 + k_kv * 16;
    const unsigned k_voff = (unsigned)(k_kv * 256 + k_ch * 8) * 2u;
    const int v_kv = (((tid >> 5) & 15) << 1) + ((tid >> 2) & 1), v_ch = (((tid >> 3) & 3) << 2) + (tid & 3);
    const int v_lds = 16384 + (v_ch >> 2) * 4096 + v_kv * 64 + (v_ch & 3) * 16;
    const unsigned v_voff = (unsigned)(v_kv * 256 + 128 + v_ch * 8) * 2u;
    const __amdgpu_buffer_rsrc_t prs = __builtin_amdgcn_make_buffer_rsrc((void*)KVb, (short)0, SEQ * 512, 0x00020000);
    u32x4 pk[2], pv[2];
#define AT_LOAD(j) do { _Pragma("unroll") for (int i = 0; i < 2; ++i) { const unsigned so = (unsigned)(((j) * 64 + 32 * i) * 512); \
        pk[i] = __builtin_bit_cast(u32x4, __builtin_amdgcn_raw_buffer_load_b128(prs, k_voff, so, 0)); pv[i] = __builtin_bit_cast(u32x4, __builtin_amdgcn_raw_buffer_load_b128(prs, v_voff, so, 0)); } } while (0)
#define AT_STORE(bufo) do { _Pragma("unroll") for (int i = 0; i < 2; ++i) { *(LAS u32x4*)(lds + (bufo) + k_lds + 32 * 16 * i) = pk[i]; *(LAS u32x4*)(lds + (bufo) + v_lds + 32 * 64 * i) = pv[i]; } } while (0)
    bf16x8 qf[4];
    { const bf16* qp = QCb + (size_t)(q0 + 32 * wq + r32) * 128 + mc * 64 + 8 * hi;
#pragma unroll
      for (int d0 = 0; d0 < 4; ++d0) qf[d0] = *(const bf16x8*)(qp + 16 * d0); }
    f32x16 O[4];
#pragma unroll
    for (int db = 0; db < 4; ++db)
#pragma unroll
        for (int r = 0; r < 16; ++r) O[db][r] = 0.f;
    float mhat = -INFINITY, l_reg = 0.f;
    {
        u32x4 qk[3][2], qv[3][2]; const int j2 = NT > 2 ? 2 : 1;
#pragma unroll
        for (int tl = 0; tl < 3; ++tl) { const int jt = tl < 2 ? tl : j2;
#pragma unroll
            for (int i = 0; i < 2; ++i) { const unsigned so = (unsigned)((jt * 64 + 32 * i) * 512);
                qk[tl][i] = __builtin_bit_cast(u32x4, __builtin_amdgcn_raw_buffer_load_b128(prs, k_voff, so, 0)); qv[tl][i] = __builtin_bit_cast(u32x4, __builtin_amdgcn_raw_buffer_load_b128(prs, v_voff, so, 0)); } }
#pragma unroll
        for (int tl = 0; tl < 3; ++tl)
#pragma unroll
            for (int i = 0; i < 2; ++i) { *(LAS u32x4*)(lds + tl * AT_BUF + k_lds + 32 * 16 * i) = qk[tl][i]; *(LAS u32x4*)(lds + tl * AT_BUF + v_lds + 32 * 64 * i) = qv[tl][i]; }
    }
    __syncthreads();
    const int koff = mc * 8192 + hi * 1024 + r32 * 16;
    const int voff = 16384 + ((lane >> 4) & 1) * 32 + (lane & 3) * 8 + (4 * hi + ((lane & 15) >> 2)) * 64;
    const LAS float* lutp = (const LAS float*)(lds + AT_LUT) + (q0 + 32 * wq + r32 + 127 - 4 * hi);
    f32x16 pA0, pA1, pB0, pB1;
    at_qk(pA0, pA1, lds + koff, qf);
    if (0 >= NT - 4) {
#pragma unroll
        for (int r = 0; r < 16; ++r) { const int ko = (r & 3) + 8 * (r >> 2); pA0[r] += lutp[-ko]; pA1[r] += lutp[-ko - 32]; }
    }
    mhat = bf2f((unsigned short)(cvtpk(at_rowmax(pA0, pA1), 0.f) & 0xffffu));
#pragma unroll
    for (int r = 0; r < 16; ++r) { pA0[r] = fast_exp2(pA0[r] - mhat); pA1[r] = fast_exp2(pA1[r] - mhat); }
    bool resc = false;
#define AT_SLOT(t) (((t) & 3) * AT_BUF)
#define AT_STEP(CA, CB, PA, PB, t) do { const int jl_ = ((t) + 2 < NT) ? (t) + 2 : NT - 1; \
        at_step(CA, CB, PA, PB, O, qf, prs, k_voff, v_voff, (unsigned)(jl_ * 64 * 512), pk, pv, lds + AT_SLOT(t) + koff, lds + AT_SLOT((t) - 1) + voff, lds + AT_SLOT((t) + 1) + koff, mhat, l_reg, resc, lutp - 64 * (t), (t) >= NT - 4, wsf, r32, hi); \
        AT_STORE(AT_SLOT((t) + 2)); __syncthreads(); if (resc) at_rescale(O, wsf, hi); } while (0)
    int t = 1;
    for (; t + 1 < NT; t += 2) { AT_STEP(pB0, pB1, pA0, pA1, t); AT_STEP(pA0, pA1, pB0, pB1, t + 1); }
    AT_STEP(pB0, pB1, pA0, pA1, t);
    {
        float sacc = 0.f;
#pragma unroll
        for (int r = 0; r < 16; ++r) sacc += pB0[r] + pB1[r];
        l_reg += sacc;
        u32x4 q4; bf16x8 pa[4];
        q4.x = AT_PK2(pB0, 0); q4.y = AT_PK2(pB0, 2); q4.z = AT_PK2(pB0, 4); q4.w = AT_PK2(pB0, 6); pa[0] = __builtin_bit_cast(bf16x8, q4);
        q4.x = AT_PK2(pB0, 8); q4.y = AT_PK2(pB0, 10); q4.z = AT_PK2(pB0, 12); q4.w = AT_PK2(pB0, 14); pa[1] = __builtin_bit_cast(bf16x8, q4);
        q4.x = AT_PK2(pB1, 0); q4.y = AT_PK2(pB1, 2); q4.z = AT_PK2(pB1, 4); q4.w = AT_PK2(pB1, 6); pa[2] = __builtin_bit_cast(bf16x8, q4);
        q4.x = AT_PK2(pB1, 8); q4.y = AT_PK2(pB1, 10); q4.z = AT_PK2(pB1, 12); q4.w = AT_PK2(pB1, 14); pa[3] = __builtin_bit_cast(bf16x8, q4);
        const LAS unsigned char* vbp = lds + AT_SLOT(NT - 1) + voff;
#pragma unroll
        for (int db = 0; db < 4; ++db)
#pragma unroll
            for (int ks = 0; ks < 4; ++ks) O[db] = __builtin_amdgcn_mfma_f32_32x32x16_bf16(pa[ks], at_vfrag(vbp, db, ks), O[db], 0, 0, 0);
    }
    __syncthreads();
    l_reg = sum_x32(l_reg, l_reg);
    { const float sc = (mc == 0 ? 1.f : lam) * fast_rcp(l_reg);
      if (hi == 0) wsf[r32] = sc;
      at_rescale(O, wsf, hi); }
    LAS float* ex = (LAS float*)lds + (mc * 4 + wq) * 4096;
#pragma unroll
    for (int db = 0; db < 4; ++db)
#pragma unroll
        for (int r = 0; r < 16; ++r) ex[crow(r, hi) * 128 + 32 * db + r32] = O[db][r];
    __syncthreads();
    {
        const int l15 = lane & 15, lr = lane >> 4;
        float gv[8];
        { const float* sg = a.in[11] + 8 * l15;
#pragma unroll
          for (int i = 0; i < 8; ++i) gv[i] = sg[i] * 0.8f; }
        bf16* Y = (bf16*)(a.ws + WS_Y) + (size_t)(b * SEQ + q0) * D + h * 128 + 8 * l15;
#pragma unroll
        for (int p = 0; p < 4; ++p) { const int R = 16 * w + 4 * p + lr;
            const LAS float* pa = (const LAS float*)lds + (R >> 5) * 4096 + (R & 31) * 128 + 8 * l15; const LAS float* pb = pa + 4 * 4096;
            const f32x4 a0 = *(const LAS f32x4*)pa, a1 = *(const LAS f32x4*)(pa + 4), b0 = *(const LAS f32x4*)pb, b1 = *(const LAS f32x4*)(pb + 4);
            const f32x4 o0 = a0 - b0, o1 = a1 - b1;
            float ss = (o0.x * o0.x + o0.y * o0.y) + (o0.z * o0.z + o0.w * o0.w) + (o1.x * o1.x + o1.y * o1.y) + (o1.z * o1.z + o1.w * o1.w);
            ss = row_sum(ss);
            const float rr = __builtin_amdgcn_rsqf(ss * (1.f / 128.f) + EPS);
            u32x4 yo;
            yo.x = cvtpk(o0.x * rr * gv[0], o0.y * rr * gv[1]); yo.y = cvtpk(o0.z * rr * gv[2], o0.w * rr * gv[3]);
            yo.z = cvtpk(o1.x * rr * gv[4], o1.y * rr * gv[5]); yo.w = cvtpk(o1.z * rr * gv[6], o1.w * rr * gv[7]);
            *(u32x4*)(Y + (size_t)R * D) = yo; }
    }
    __syncthreads();
#undef AT_LOAD
#undef AT_STORE
#undef AT_SLOT
#undef AT_STEP
}

__device__ __forceinline__ void p2_mixers(const Frame& F, const Args& a) {
    float lam;
    { const float v1 = a.in[7][F.lane] * a.in[8][F.lane], v2 = a.in[9][F.lane] * a.in[10][F.lane];
      lam = __expf(wave_sum(v1)) - __expf(wave_sum(v2)) + 0.2f; }
    const int per = F.G / 32;
    if (per < 1) return;
    const int bh = F.vcu / per, s = F.vcu % per;
    if (bh >= 32) return;
    { const int h = bh & 3; const float* tab = a.in[12]; const float t31 = tab[31 * 4 + h];
      for (int i = F.tid; i < 384; i += NTHREADS) { const int dist = i - 127; ((LAS float*)(F.lds + AT_LUT))[i] = dist < 0 ? -INFINITY : (tab[t5_bucket(dist) * 4 + h] - t31) * LOG2E; } }
    if (s == 0) hgrn_stream(F, a, bh);
    constexpr int NDYN = 14;
    if (s >= 1) {
        const int na = per - 1;
        for (int k = 0; k * na < 64 - NDYN; ++k) {
            const int idx = k * na + ((k & 1) ? (na - s) : (s - 1));
            if (idx < 64 - NDYN) attn_unit(F, a, bh, 63 - idx, lam);
        }
    }
    {
        unsigned* qhead = (unsigned*)(a.ws + WS_CTL) + CW_Q + 64 * bh;
        LAS unsigned* tk = (LAS unsigned*)(F.lds + AT_TKT);
        for (;;) {
            if (F.tid == 0) *tk = __hip_atomic_fetch_add(qhead, 1u, __ATOMIC_RELAXED, __HIP_MEMORY_SCOPE_AGENT);
            __syncthreads();
            const unsigned t = *tk;
            __syncthreads();
            if (t >= (unsigned)NDYN) break;
            attn_unit(F, a, bh, NDYN - 1 - (int)t, lam);
        }
    }
}

constexpr int RT_W = 0, RT_HIST = 73728, RT_BASE = 73856;
__device__ __forceinline__ void p4_router(const Frame& F, const Args& a) {
    LAS unsigned char* lds = F.lds;
    const float* wg = a.in[16]; const float* bg = a.in[17]; const float* we = a.in[18]; const float* be = a.in[19];
    for (int i = F.tid; i < 4 * 1024; i += NTHREADS) { const int d = i >> 2, e = i & 3;
        ((LAS unsigned short*)(lds + RT_W))[e * 1024 + d] = (unsigned short)(cvtpk(wg[i], 0.f) & 0xffffu); }
    for (int i = F.tid; i < 32 * 1024; i += NTHREADS) { const int d = i >> 5, e = i & 31;
        ((LAS unsigned short*)(lds + RT_W))[(4 + e) * 1024 + d] = (unsigned short)(cvtpk(we[i], 0.f) & 0xffffu); }
    if (F.tid < 32) ((LAS unsigned*)(lds + RT_HIST))[F.tid] = 0u;
    __syncthreads();
    const bf16* x1 = (const bf16*)(a.ws + WS_X1B); const float* ng = a.in[5]; const float* mod = (const float*)(a.ws + WS_MOD);
    bf16* H = (bf16*)(a.ws + WS_H);
    const int gw = F.vcu * NWAVES + F.wave, NGW = F.G * NWAVES, lane = F.lane;
    int my_tok = -1, my_e0 = 0, my_e1 = 0; float my_w0 = 0.f, my_w1 = 0.f;
    const int per = (NTOK + NGW - 1) / NGW;
    const int m0 = gw * per, m1 = (m0 + per < NTOK) ? m0 + per : NTOK;
    int it = 0;
    for (int s0 = m0; s0 < m1; ) {
      const int b = s0 >> 13, e1 = ((b + 1) << 13) < m1 ? ((b + 1) << 13) : m1;
      f32x4 ga[4], sha[4];
      { const f32x4* gp = (const f32x4*)ng + lane; const f32x4* shp = (const f32x4*)(mod + b * 6144 + 3072) + lane; const f32x4* scp = (const f32x4*)(mod + b * 6144 + 4096) + lane;
#pragma unroll
        for (int j = 0; j < 4; ++j) { ga[j] = gp[64 * j] * (scp[64 * j] + 1.f); sha[j] = shp[64 * j]; } }
      u32x2 nxv[4];
      { const u32x2* xr = (const u32x2*)(x1 + (size_t)s0 * D) + lane;
#pragma unroll
        for (int j = 0; j < 4; ++j) nxv[j] = xr[64 * j]; }
      for (int m = s0; m < e1; ++m, ++it) {
        f32x4 v[4]; float s = 0.f;
#pragma unroll
        for (int j = 0; j < 4; ++j) { const u32x2 xv = nxv[j]; v[j] = (f32x4){bflo(xv.x), bfhi(xv.x), bflo(xv.y), bfhi(xv.y)}; s += (v[j].x * v[j].x + v[j].y * v[j].y) + (v[j].z * v[j].z + v[j].w * v[j].w); }
        { const int mn = (m + 1 < e1) ? m + 1 : m; const u32x2* xr = (const u32x2*)(x1 + (size_t)mn * D) + lane;
#pragma unroll
          for (int j = 0; j < 4; ++j) nxv[j] = xr[64 * j]; }
        const float r = __builtin_amdgcn_rsqf(wave_sum(s) * (1.f / D) + EPS);
        u32x2* o8 = (u32x2*)(H + (size_t)m * D) + lane;
        u32x2 hp[4];
#pragma unroll
        for (int j = 0; j < 4; ++j) {
            v[j] = v[j] * r * ga[j] + sha[j];
            u32x2 o; o.x = cvtpk(v[j].x, v[j].y); o.y = cvtpk(v[j].z, v[j].w); o8[64 * j] = o; asm("" : "+v"(o.x), "+v"(o.y)); hp[j] = o; }
        asm volatile("" ::: "memory");
        float lg[4];
#pragma unroll
        for (int e = 0; e < 4; ++e) { float acc = 0.f;
#pragma unroll
            for (int j = 0; j < 4; ++j) { const u32x2 wv = *(const LAS u32x2*)(lds + RT_W + (e * 1024 + 256 * j + 4 * lane) * 2);
                acc = dot2bf(wv.x, hp[j].x, acc); acc = dot2bf(wv.y, hp[j].y, acc); }
            lg[e] = wave_sum(acc) + bg[e]; }
        int gi = 0; float gm = lg[0];
#pragma unroll
        for (int i = 1; i < 4; ++i) if (lg[i] > gm) { gm = lg[i]; gi = i; }
        gi = __builtin_amdgcn_readfirstlane(gi);
        float gs = 0.f;
#pragma unroll
        for (int i = 0; i < 4; ++i) gs += __expf(lg[i] - gm);
        const float gate = 1.f / gs;
        float pe[8];
        { const LAS unsigned char* wb_ = lds + RT_W + (size_t)(4 + gi * 8) * 2048;
#pragma unroll
          for (int e = 0; e < 8; ++e) { float acc = 0.f;
#pragma unroll
              for (int j = 0; j < 4; ++j) { const u32x2 wv = *(const LAS u32x2*)(wb_ + (e * 1024 + 256 * j + 4 * lane) * 2);
                  acc = dot2bf(wv.x, hp[j].x, acc); acc = dot2bf(wv.y, hp[j].y, acc); }
              pe[e] = acc; } }
        float t4[4], t2[2], t1;
#pragma unroll
        for (int i = 0; i < 4; ++i) t4[i] = sum_x32(pe[i], pe[i + 4]);
#pragma unroll
        for (int i = 0; i < 2; ++i) t2[i] = sum_x16(t4[i], t4[i + 2]);
        { const bool up = (lane & 8) != 0; const float keep = up ? t2[1] : t2[0], send = up ? t2[0] : t2[1]; t1 = keep + dppf<0x128>(send); }
        t1 += dppf<0xB1>(t1); t1 += dppf<0x4E>(t1); t1 += dppf<0x141>(t1);
        float el[8];
#pragma unroll
        for (int i = 0; i < 8; ++i) el[i] = __builtin_bit_cast(float, __builtin_amdgcn_readlane(__builtin_bit_cast(int, t1), 8 * ((i & 1) + 2 * ((i >> 1) & 1) + 4 * ((i >> 2) & 1)))) + be[gi * 8 + i];
        int ia = 0; float va = el[0];
#pragma unroll
        for (int i = 1; i < 8; ++i) if (el[i] > va) { va = el[i]; ia = i; }
        int ib = -1; float vb = -INFINITY;
#pragma unroll
        for (int i = 0; i < 8; ++i) if (i != ia && el[i] > vb) { vb = el[i]; ib = i; }
        const float wa = gate / (1.f + __expf(vb - va)), wb = gate - wa;
        if (lane == it) { my_tok = m; my_e0 = gi * 8 + ia; my_e1 = gi * 8 + ib; my_w0 = wa; my_w1 = wb; }
      }
      s0 = e1;
    }
    LAS unsigned* hist = (LAS unsigned*)(lds + RT_HIST); LAS unsigned* base = (LAS unsigned*)(lds + RT_BASE);
    unsigned r0 = 0, r1 = 0;
    if (my_tok >= 0) { r0 = atomicAdd((unsigned*)hist + my_e0, 1u); r1 = atomicAdd((unsigned*)hist + my_e1, 1u); }
    __syncthreads();
    unsigned* cnt = (unsigned*)(a.ws + WS_CTL) + CW_CNT;
    if (F.tid < 32) { const unsigned hv = hist[F.tid]; base[F.tid] = hv ? __hip_atomic_fetch_add(cnt + F.tid, hv, __ATOMIC_RELAXED, __HIP_MEMORY_SCOPE_AGENT) : 0u; }
    __syncthreads();
    if (my_tok >= 0) {
        int* list = (int*)(a.ws + WS_LIST); float* tw = (float*)(a.ws + WS_TOKW);
        const int p0_ = (int)(base[my_e0] + r0), p1_ = (int)(base[my_e1] + r1);
        list[(size_t)my_e0 * NTOK + p0_] = my_tok * 2;
        list[(size_t)my_e1 * NTOK + p1_] = my_tok * 2 + 1;
        tw[my_tok * 2] = my_w0; tw[my_tok * 2 + 1] = my_w1;
        int* toks = (int*)(a.ws + WS_TOKS);
        toks[my_tok * 2] = (my_e0 << 20) | p0_; toks[my_tok * 2 + 1] = (my_e1 << 20) | p1_;
    }
}

constexpr int MOE_CNTL = MISC_OFF + 256, MOE_LTOK = MISC_OFF + 4096, MOE_MAXU = 12;
struct MoeOrder {
    const LAS int* pre; const LAS int* cntl; const LAS int* ltok; const int* list; int G, c, lane; bool gather;
    __device__ __forceinline__ bool next(int i, pg8::Unit& u) const {
        const int total = pre[32];
        int rt, pn;
        if (G == 256) {
            rt = (i * 8 + (c & 7)) * 8 + ((c >> 3) & 7); pn = c >> 6;
            if (rt >= total) return false;
        } else { const long L = (long)i * G + c; if (L >= (long)total * 4) return false; rt = (int)(L >> 2); pn = (int)(L & 3); }
        const int e = __builtin_popcountll(__ballot(pre[(lane & 31) + 1] <= rt) & 0xffffffffull);
        u.e = e; u.pm = rt; u.pn = e * 4 + pn; u.r0 = (rt - pre[e]) * 256; const int n = cntl[e] - u.r0; u.nrows = n < 256 ? n : 256; u.slot = i; return true;
    }
    __device__ __forceinline__ int arow(const pg8::Unit& u, int r) const {
        if (!gather) return u.pm * 256 + r;
        if (u.slot < MOE_MAXU) return ltok[u.slot * 256 + r];
        return r < u.nrows ? (list[(size_t)u.e * NTOK + u.r0 + r] >> 1) : 0;
    }
};
struct EpiSwiGLU {
    static constexpr bool PERM = true;
    static constexpr int NST = 8;
    bf16* act;
    LAS unsigned char* scr;
    __device__ __forceinline__ void operator()(const f32x4 (&acc)[2][2][4][2], const pg8::Unit& u, int wr, int wc, int fr, int fq) const {
        LAS unsigned char* ws_ = scr + (wr * 4 + wc) * 2048;
        const int l = fr + 16 * fq, r8 = l >> 3, c8 = l & 7;
        bf16* base = act + (size_t)(u.pm * 256 + wr * 64 + (c8 >> 2) * 16 + r8) * FF + (u.pn & 3) * 128 + wc * 32 + 8 * (c8 & 3);
        u32x4 rq[2][2];
#pragma unroll
        for (int it = 0; it <= 4; ++it) {
            if (it < 4) { const int ai = it >> 1, m2 = it & 1; u32x4 w[2];
#pragma unroll
                for (int q = 0; q < 2; ++q) { const int m = 2 * m2 + q; const f32x4 a0 = acc[ai][0][m][0], a1 = acc[ai][0][m][1], b0 = acc[ai][1][m][0], b1 = acc[ai][1][m][1];
                    w[q].x = cvtpk(siluf_(a0.x) * b0.x, siluf_(a0.y) * b0.y); w[q].y = cvtpk(siluf_(a0.z) * b0.z, siluf_(a0.w) * b0.w);
                    w[q].z = cvtpk(siluf_(a1.x) * b1.x, siluf_(a1.y) * b1.y); w[q].w = cvtpk(siluf_(a1.z) * b1.z, siluf_(a1.w) * b1.w); }
                pg8::xpose128(ws_, fr, fq, w[0], w[1], rq[it & 1][0], rq[it & 1][1]); }
            if (it > 0) { const int ai = (it - 1) >> 1, m2 = (it - 1) & 1;
                bf16* rowp = base + (size_t)(ai * 128 + m2 * 32) * FF;
                *(u32x4*)rowp = rq[(it - 1) & 1][0]; *(u32x4*)(rowp + (size_t)8 * FF) = rq[(it - 1) & 1][1]; } }
    }
};
struct EpiScatter {
    static constexpr bool PERM = true;
    static constexpr int NST = 16;
    bf16* ybuf;
    LAS unsigned char* scr;
    __device__ __forceinline__ void operator()(const f32x4 (&acc)[2][2][4][2], const pg8::Unit& u, int wr, int wc, int fr, int fq) const {
        LAS unsigned char* ws_ = scr + (wr * 4 + wc) * 2048;
        const int l = fr + 16 * fq, r8 = l >> 3, c8 = l & 7;
        bf16* base = ybuf + (size_t)(u.pm * 256 + wr * 64 + r8) * D + (u.pn & 3) * 256 + wc * 64 + 8 * c8;
        u32x4 rq[2][2];
#pragma unroll
        for (int it = 0; it <= 8; ++it) {
            if (it < 8) { const int ai = it >> 2, m = it & 3; u32x4 w[2];
#pragma unroll
                for (int bj = 0; bj < 2; ++bj) { const f32x4 v0 = acc[ai][bj][m][0], v1 = acc[ai][bj][m][1];
                    w[bj].x = cvtpk(v0.x, v0.y); w[bj].y = cvtpk(v0.z, v0.w); w[bj].z = cvtpk(v1.x, v1.y); w[bj].w = cvtpk(v1.z, v1.w); }
                pg8::xpose128(ws_, fr, fq, w[0], w[1], rq[it & 1][0], rq[it & 1][1]); }
            if (it > 0) { const int ai = (it - 1) >> 2, m = (it - 1) & 3;
                bf16* rowp = base + (size_t)(ai * 128 + m * 16) * D;
                *(u32x4*)rowp = rq[(it - 1) & 1][0]; *(u32x4*)(rowp + (size_t)8 * D) = rq[(it - 1) & 1][1]; } }
    }
};

__device__ __forceinline__ void p7_final(const Frame& F, const Args& a) {
    float* out = a.out; const float* fg = a.in[23]; const float* mod = (const float*)(a.ws + WS_MOD);
    const bf16* yb = (const bf16*)(a.ws + WS_YBUF); const float* tw = (const float*)(a.ws + WS_TOKW); const int* toks = (const int*)(a.ws + WS_TOKS); const bf16* x1b = (const bf16*)(a.ws + WS_X1B);
    const int gw = F.vcu * NWAVES + F.wave, NGW = F.G * NWAVES, lane = F.lane;
    const int per = (NTOK + NGW - 1) / NGW;
    const int m0 = gw * per, m1 = (m0 + per < NTOK) ? m0 + per : NTOK;
    if (m0 >= NTOK) return;
    const int prev = ((const LAS int*)(F.lds + MISC_OFF))[lane & 31];
    u32x4 nx[2], ny0[2], ny1[2];
#define P7_ROW(sv) (__builtin_amdgcn_readlane(prev, (sv) >> 20) * 256 + ((sv) & 0xFFFFF))
#define P7_LOAD(mm, ra, rb) do { _Pragma("unroll") for (int j = 0; j < 2; ++j) { nx[j] = *((const u32x4*)(x1b + (size_t)(mm) * D) + lane + 64 * j); \
        ny0[j] = *((const u32x4*)(yb + (size_t)(ra) * D) + lane + 64 * j); ny1[j] = *((const u32x4*)(yb + (size_t)(rb) * D) + lane + 64 * j); } } while (0)
    f32x4 fgr[2][2];
#pragma unroll
    for (int j = 0; j < 2; ++j) { const f32x4* gp = (const f32x4*)(fg + 512 * j) + 2 * lane; fgr[j][0] = gp[0]; fgr[j][1] = gp[1]; }
    for (int s0 = m0; s0 < m1; ) {
        const int b = s0 >> 13; int e1 = ((b + 1) << 13) < m1 ? ((b + 1) << 13) : m1; if (e1 > s0 + 32) e1 = s0 + 32;
        const int nrow = e1 - s0;
        const int tv = (lane < 2 * nrow) ? toks[2 * s0 + lane] : 0; const float wv = (lane < 2 * nrow) ? tw[2 * s0 + lane] : 0.f;
        f32x4 g2r[2][2];
#pragma unroll
        for (int j = 0; j < 2; ++j) { const f32x4* g2p = (const f32x4*)(mod + b * 6144 + 5120 + 512 * j) + 2 * lane; g2r[j][0] = g2p[0]; g2r[j][1] = g2p[1]; }
        { const int sa = __builtin_amdgcn_readlane(tv, 0), sb = __builtin_amdgcn_readlane(tv, 1); P7_LOAD(s0, P7_ROW(sa), P7_ROW(sb)); }
        for (int i = 0; i < nrow; ++i) { const int m = s0 + i;
            u32x4 cx[2], cy0[2], cy1[2];
#pragma unroll
            for (int j = 0; j < 2; ++j) { cx[j] = nx[j]; cy0[j] = ny0[j]; cy1[j] = ny1[j]; }
            { const int in_ = (i + 1 < nrow) ? i + 1 : i; const int sa = __builtin_amdgcn_readlane(tv, 2 * in_), sb = __builtin_amdgcn_readlane(tv, 2 * in_ + 1); P7_LOAD(s0 + in_, P7_ROW(sa), P7_ROW(sb)); }
            const float w0 = __builtin_bit_cast(float, __builtin_amdgcn_readlane(__builtin_bit_cast(int, wv), 2 * i)), w1 = __builtin_bit_cast(float, __builtin_amdgcn_readlane(__builtin_bit_cast(int, wv), 2 * i + 1));
            float v[2][8]; float s = 0.f;
#pragma unroll
            for (int j = 0; j < 2; ++j) { const f32x4 ga = g2r[j][0], gb = g2r[j][1];
                const float g2[8] = {ga.x, ga.y, ga.z, ga.w, gb.x, gb.y, gb.z, gb.w};
                const unsigned xw[4] = {cx[j].x, cx[j].y, cx[j].z, cx[j].w}, aw[4] = {cy0[j].x, cy0[j].y, cy0[j].z, cy0[j].w}, bw[4] = {cy1[j].x, cy1[j].y, cy1[j].z, cy1[j].w};
#pragma unroll
                for (int k = 0; k < 4; ++k) { const float mm0 = w0 * bflo(aw[k]) + w1 * bflo(bw[k]), mm1 = w0 * bfhi(aw[k]) + w1 * bfhi(bw[k]);
                    v[j][2 * k] = bflo(xw[k]) + g2[2 * k] * mm0; v[j][2 * k + 1] = bfhi(xw[k]) + g2[2 * k + 1] * mm1;
                    s += v[j][2 * k] * v[j][2 * k] + v[j][2 * k + 1] * v[j][2 * k + 1]; } }
            const float r = __builtin_amdgcn_rsqf(wave_sum(s) * (1.f / D) + EPS);
#pragma unroll
            for (int j = 0; j < 2; ++j) { const f32x4 ga = fgr[j][0], gb = fgr[j][1];
                f32x4* op = (f32x4*)(out + (size_t)m * D + 512 * j) + 2 * lane;
                op[0] = (f32x4){v[j][0] * r * ga.x, v[j][1] * r * ga.y, v[j][2] * r * ga.z, v[j][3] * r * ga.w};
                op[1] = (f32x4){v[j][4] * r * gb.x, v[j][5] * r * gb.y, v[j][6] * r * gb.z, v[j][7] * r * gb.w}; }
        }
        s0 = e1;
    }
#undef P7_LOAD
#undef P7_ROW
}

constexpr unsigned long long P1_CPERM = 0x0ull | (0ull << 0) | (1ull << 4) | (2ull << 8) | (3ull << 12) | (4ull << 16) | (5ull << 20) | (10ull << 24) | (11ull << 28)
                                       | (6ull << 32) | (7ull << 36) | (12ull << 40) | (13ull << 44) | (8ull << 48) | (9ull << 52) | (15ull << 60);
#define LOAD_ARGS(la) Args la; { const __attribute__((address_space(4))) Args* ap_ = (const __attribute__((address_space(4))) Args*)__builtin_amdgcn_kernarg_segment_ptr(); asm volatile("" : "+s"(ap_)); la = *(const Args*)ap_; }
__global__ void __launch_bounds__(NTHREADS, 2) fwd_megakernel(Args args_unused) {
    extern __shared__ __attribute__((aligned(16))) unsigned char lds_raw[];
    cg::grid_group grid = cg::this_grid();
    Frame F;
    F.lds = (LAS unsigned char*)lds_raw;
    F.tid = threadIdx.x; F.lane = F.tid & 63; F.wave = __builtin_amdgcn_readfirstlane(F.tid >> 6);
    F.G = gridDim.x; { const int bx = blockIdx.x; F.vcu = (F.G % 8 == 0) ? (bx % 8) * (F.G / 8) + bx / 8 : bx; }
#define REFRAME() do { int l_; asm volatile("v_mbcnt_lo_u32_b32 %0, -1, 0\n\tv_mbcnt_hi_u32_b32 %0, -1, %0" : "=v"(l_)); F.lane = l_; F.tid = F.wave * 64 + l_; } while (0)
    for (int u = F.tid; u < (LDS_BYTES - MISC_OFF) / 4; u += NTHREADS) ((LAS unsigned*)(F.lds + MISC_OFF))[u] = 0u;
    __syncthreads();
    XcdBarrier xbar;
    { LOAD_ARGS(args0); xbar = xcd_barrier_post((unsigned*)(args0.ws + WS_CTL) + CW_BAR, (volatile LAS unsigned*)(F.lds + MISC_OFF + 1024)); }
#define GRID_BAR() xcd_barrier(xbar)

    { REFRAME(); LOAD_ARGS(args); p0_prologue(F, args); }
    grid.sync();
    { REFRAME(); LOAD_ARGS(args); p0b_norm1(F, args); }
    GRID_BAR();
    {
        REFRAME(); LOAD_ARGS(args); unsigned char* ws = args.ws;
        pg8::Gemm g{(const bf16*)(ws + WS_H), (const bf16*)(ws + WS_WIN), 1024}; pg8::DenseOrder S; S.init(NTOK, INW, F.G, (int)blockIdx.x, P1_CPERM);
        EpiProj E{(bf16*)(ws + WS_PROJ), args.in[13], (bf16*)(ws + WS_QC), (bf16*)(ws + WS_KV), F.lds + EPI_SCR};
        pg8::gemm_phase<EpiProj, pg8::DenseOrder>(F.lds, g, S, E, F.tid);
    }
    GRID_BAR();
    { REFRAME(); LOAD_ARGS(args); p2_mixers(F, args); }
    GRID_BAR();
    {
        REFRAME(); LOAD_ARGS(args); unsigned char* ws = args.ws;
        pg8::Gemm g{(const bf16*)(ws + WS_Y), (const bf16*)(ws + WS_WOUT), 1024}; pg8::DenseOrder S; S.init(NTOK, D, F.G, (int)blockIdx.x);
        EpiRes1 E{args.in[0], (bf16*)(ws + WS_X1B), (const float*)(ws + WS_MOD), F.lds + EPI_SCR};
        pg8::gemm_phase<EpiRes1, pg8::DenseOrder>(F.lds, g, S, E, F.tid);
    }
    GRID_BAR();
    { REFRAME(); LOAD_ARGS(args); p4_router(F, args); }
    GRID_BAR();
    {
        LAS int* pre = (LAS int*)(F.lds + MISC_OFF);
        { LOAD_ARGS(args);
          const unsigned* cnt = (const unsigned*)(args.ws + WS_CTL) + CW_CNT;
          if (F.tid < 64) {
              const int lane = F.tid; const int cv_ = (int)__hip_atomic_load(cnt + (lane & 31), __ATOMIC_RELAXED, __HIP_MEMORY_SCOPE_AGENT); const int tl = lane < 32 ? ((cv_ + 255) >> 8) : 0;
              if (lane < 32) ((LAS int*)(F.lds + MOE_CNTL))[lane] = cv_;
              int inc = tl;
#pragma unroll
              for (int o = 1; o < 32; o <<= 1) { const int t = __shfl_up(inc, o); if (lane >= o) inc += t; }
              if (lane < 32) pre[lane] = inc - tl;
              if (lane == 31) pre[32] = inc; } }
        __syncthreads();
        {
            REFRAME(); LOAD_ARGS(args); unsigned char* ws = args.ws;
            pg8::Gemm g{(const bf16*)(ws + WS_H), (const bf16*)(ws + WS_W13), 1024};
            MoeOrder S{pre, (const LAS int*)(F.lds + MOE_CNTL), (const LAS int*)(F.lds + MOE_LTOK), (const int*)(ws + WS_LIST), F.G, (int)blockIdx.x, F.lane, true};
            {
                const int* list = (const int*)(ws + WS_LIST); int tv[MOE_MAXU];
#pragma unroll
                for (int i = 0; i < MOE_MAXU; ++i) { pg8::Unit u; tv[i] = 0;
                    if (F.tid < 256 && S.next(i, u) && F.tid < u.nrows) tv[i] = list[(size_t)u.e * NTOK + u.r0 + F.tid] >> 1; }
#pragma unroll
                for (int i = 0; i < MOE_MAXU; ++i) if (F.tid < 256) ((LAS int*)(F.lds + MOE_LTOK))[i * 256 + F.tid] = tv[i];
                __syncthreads();
            }
            EpiSwiGLU E{(bf16*)(ws + WS_ACT), F.lds + EPI_SCR};
            pg8::gemm_phase<EpiSwiGLU, MoeOrder>(F.lds, g, S, E, F.tid);
        }
        GRID_BAR();
        {
            REFRAME(); LOAD_ARGS(args); unsigned char* ws = args.ws;
            pg8::Gemm g{(const bf16*)(ws + WS_ACT), (const bf16*)(ws + WS_W2), 512};
            MoeOrder S{pre, (const LAS int*)(F.lds + MOE_CNTL), (const LAS int*)(F.lds + MOE_LTOK), (const int*)(ws + WS_LIST), F.G, (int)blockIdx.x, F.lane, false};
            EpiScatter E{(bf16*)(ws + WS_YBUF), F.lds + EPI_SCR};
            pg8::gemm_phase<EpiScatter, MoeOrder>(F.lds, g, S, E, F.tid);
        }
    }
    GRID_BAR();
    { REFRAME(); LOAD_ARGS(args); p7_final(F, args); }
}

extern "C" void kernel_launch(void* const* d_in, const int* in_sizes, int n_in, void* d_out, int out_size, void* d_ws, size_t ws_size, hipStream_t stream) {
    static int grid = 0;
    if (grid == 0) {
        if (n_in != 24 || out_size != NTOK * D || ws_size < WS_END) { fprintf(stderr, "kernel_launch: unexpected problem (n_in %d out %d ws %zu)\n", n_in, out_size, ws_size); grid = -1; return; }
        int dev = 0, cus = 0, per_cu = 0;
        hipGetDevice(&dev);
        hipDeviceGetAttribute(&cus, hipDeviceAttributeMultiprocessorCount, dev);
        hipFuncSetAttribute((const void*)fwd_megakernel, hipFuncAttributeMaxDynamicSharedMemorySize, LDS_BYTES);
        hipOccupancyMaxActiveBlocksPerMultiprocessor(&per_cu, (const void*)fwd_megakernel, NTHREADS, LDS_BYTES);
        if (per_cu < 1) { fprintf(stderr, "kernel_launch: occupancy query says %d blocks per CU\n", per_cu); per_cu = 1; }
        grid = cus;
        (void)hipGetLastError();
    }
    if (grid < 0) return;
    hipMemsetAsync((char*)d_ws + WS_CTL, 0, CTL_ZERO_BYTES, stream);
    Args a{};
    for (int i = 0; i < 24; ++i) a.in[i] = (const float*)d_in[i];
    a.out = (float*)d_out; a.ws = (unsigned char*)d_ws;
    void* kargs[] = {&a};
    hipError_t e = hipLaunchCooperativeKernel((const void*)fwd_megakernel, dim3(grid), dim3(NTHREADS), kargs, LDS_BYTES, stream);
    if (e != hipSuccess) fprintf(stderr, "cooperative launch failed: %s (grid %d)\n", hipGetErrorString(e), grid);
}
```

```cpp
#include <hip/hip_runtime.h>
#include <hip/hip_cooperative_groups.h>
#include <cstdint>
#include <cstdio>
namespace cg = cooperative_groups;

#define LAS __attribute__((address_space(3)))
#define GAS __attribute__((address_space(1)))
typedef unsigned short bf16;
typedef short bf16x8 __attribute__((ext_vector_type(8)));
typedef short s16x4 __attribute__((ext_vector_type(4)));
typedef float f32x2 __attribute__((ext_vector_type(2)));
typedef float f32x4 __attribute__((ext_vector_type(4)));
typedef float f32x16 __attribute__((ext_vector_type(16)));
typedef unsigned u32x2 __attribute__((ext_vector_type(2)));
typedef unsigned u32x4 __attribute__((ext_vector_type(4)));
typedef __bf16 bf16x2_t __attribute__((ext_vector_type(2)));

constexpr int D = 1024, BATCH = 8, SEQ = 8192, NTOK = BATCH * SEQ;
constexpr int INW = 3584;
constexpr int COL_QA = 0, COL_KA = 512, COL_VA = 1024, COL_QR = 1536, COL_FR = 2048, COL_IR = 2560, COL_GR = 3072;
constexpr int NEXP = 32, FF = 512;
constexpr float EPS = 1e-6f;
constexpr float LOG2E = 1.4426950408889634f;
constexpr float QSCALE = 0.125f * LOG2E;
constexpr int NWAVES = 8, NTHREADS = 512;

constexpr size_t MiB = 1u << 20;
constexpr size_t WS_CTL = 0, CTL_ZERO_BYTES = 64 * 1024;
constexpr size_t WS_MOD = 1 * MiB;
constexpr size_t WS_WIN = 2 * MiB;
constexpr size_t WS_WOUT = 9 * MiB;
constexpr size_t WS_W13 = 11 * MiB;
constexpr size_t WS_W2 = 75 * MiB;
constexpr size_t WS_LIST = 107 * MiB;
constexpr size_t WS_TOKW = 115 * MiB;
constexpr size_t WS_TOKS = 115 * MiB + 512 * 1024;
constexpr size_t WS_H = 116 * MiB;
constexpr size_t WS_Y = 244 * MiB;
constexpr size_t WS_PROJ = 372 * MiB;
constexpr size_t WS_ACT = 372 * MiB;
constexpr size_t WS_YBUF = 508 * MiB;
constexpr size_t WS_QC = 820 * MiB;
constexpr size_t WS_KV = 884 * MiB;
constexpr size_t WS_X1B = 884 * MiB;
constexpr size_t WS_END = 1012 * MiB;
constexpr int CW_CNT = 0;
constexpr int CW_Q = 64;
constexpr int CW_BAR = 8192;

constexpr int RING_BYTES = 131072;
constexpr int MISC_OFF = RING_BYTES;
constexpr int EPI_SCR = MISC_OFF + 16384;
constexpr int LDS_BYTES = 163840;

__device__ __forceinline__ unsigned cvtpk(float lo, float hi) { f32x2 v = {lo, hi}; bf16x2_t b = __builtin_convertvector(v, bf16x2_t); return __builtin_bit_cast(unsigned, b); }
__device__ __forceinline__ float dot2bf(unsigned a, unsigned b, float acc) {
    asm("" : "+v"(a));
    return __builtin_amdgcn_fdot2_f32_bf16(__builtin_bit_cast(bf16x2_t, a), __builtin_bit_cast(bf16x2_t, b), acc, false); }
__device__ __forceinline__ float bf2f(unsigned short x) { return __uint_as_float(((unsigned)x) << 16); }
__device__ __forceinline__ float bflo(unsigned x) { return __uint_as_float(x << 16); }
__device__ __forceinline__ float bfhi(unsigned x) { return __uint_as_float(x & 0xffff0000u); }
template <int CTRL> __device__ __forceinline__ float dppf(float x) { return __builtin_bit_cast(float, __builtin_amdgcn_update_dpp(0, __builtin_bit_cast(int, x), CTRL, 0xf, 0xf, false)); }
__device__ __forceinline__ void swap32(float a, float b, float& r0, float& r1) { auto r = __builtin_amdgcn_permlane32_swap(__builtin_bit_cast(unsigned, a), __builtin_bit_cast(unsigned, b), false, false);
    unsigned u0 = r[0], u1 = r[1]; asm("" : "+v"(u0), "+v"(u1)); r0 = __builtin_bit_cast(float, u0); r1 = __builtin_bit_cast(float, u1); }
__device__ __forceinline__ void swap16(float a, float b, float& r0, float& r1) { auto r = __builtin_amdgcn_permlane16_swap(__builtin_bit_cast(unsigned, a), __builtin_bit_cast(unsigned, b), false, false);
    unsigned u0 = r[0], u1 = r[1]; asm("" : "+v"(u0), "+v"(u1)); r0 = __builtin_bit_cast(float, u0); r1 = __builtin_bit_cast(float, u1); }
__device__ __forceinline__ float sum_x32(float a, float b) { float r0, r1; swap32(a, b, r0, r1); return r0 + r1; }
__device__ __forceinline__ float sum_x16(float a, float b) { float r0, r1; swap16(a, b, r0, r1); return r0 + r1; }
__device__ __forceinline__ float row_sum(float v) { v += dppf<0xB1>(v); v += dppf<0x4E>(v); v += dppf<0x141>(v); v += dppf<0x140>(v); return v; }
__device__ __forceinline__ float wave_sum(float v) { v = row_sum(v); v = sum_x16(v, v); return sum_x32(v, v); }
__device__ __forceinline__ float fast_exp2(float x) { return __builtin_amdgcn_exp2f(x); }
__device__ __forceinline__ float fast_rcp(float x) { return __builtin_amdgcn_rcpf(x); }
__device__ __forceinline__ float sigmoidf_(float x) { return fast_rcp(1.f + fast_exp2(-x * LOG2E)); }
__device__ __forceinline__ float siluf_(float x) { return x * sigmoidf_(x); }

namespace pg8 {
constexpr int BM = 256, BK = 64, HALF = 128, HTB = HALF * BK * 2, STAGE_BYTES = 8 * HTB;
__host__ __device__ __forceinline__ int lds_byte(int r, int c) { const int st = (r >> 4) * 2 + (c >> 5), rr = r & 15, cc = c & 31, ob = rr * 64 + cc * 2; return st * 1024 + (ob ^ (((ob >> 9) & 1) << 5)); }
__host__ __device__ __forceinline__ void stage_rc(int b, int& R, int& C) { const int st = b / 1024, sb = b % 1024, swz = sb ^ (((sb >> 9) & 1) << 5); R = (st >> 1) * 16 + swz / 64; C = (st & 1) * 32 + (swz % 64) / 2; }
__host__ __device__ __forceinline__ int perm32(int rho) { const int n = rho >> 4, i = rho & 15; return 8 * (i >> 2) + 4 * n + (i & 3); }

template <int STRICT, int LAX> __device__ __forceinline__ void wait_v_sel(int sel) {
    asm volatile("s_cmp_lg_u32 %0, 0\n\ts_cbranch_scc1 1f\n\ts_waitcnt vmcnt(%1)\n1:\n\ts_waitcnt vmcnt(%2)" :: "s"(sel), "n"(STRICT), "n"(LAX) : "scc", "memory"); }
template <int N> __device__ __forceinline__ void wait_v() { asm volatile("s_waitcnt vmcnt(%0)" :: "n"(N) : "memory"); }
struct Unit { int pm, pn, e, r0, nrows, slot; };
struct Gemm { const bf16* A; const bf16* Bt; int K; };

template <class Epi, class Sched>
__device__ __forceinline__ void gemm_phase(LAS unsigned char* lds, const Gemm g, const Sched& S, const Epi& E, const int tid) {
    const int  wid = __builtin_amdgcn_readfirstlane(tid >> 6), lane = tid & 63, wr = wid >> 2, wc = wid & 3, fr = lane & 15, fq = lane >> 4;
    const int K = g.K, nt = K / BK;
    int RA[2], CA[2]; unsigned voffB[2];
#pragma unroll
    for (int i = 0; i < 2; ++i) { int R, C; stage_rc(tid * 16 + i * 8192, R, C); const int Rb = Epi::PERM ? (64 * (R >> 5) + perm32(R & 31)) : R;
        RA[i] = R; CA[i] = C; voffB[i] = (unsigned)(Rb * K + C) * 2u; }
    const size_t kstep = (size_t)(BK * 2);
    const size_t hstep = (size_t)(Epi::PERM ? 32 : HALF) * K * 2;
    const size_t tstep = (size_t)BM * K * 2;
    const unsigned ldsw = (unsigned)wid * 1024u;
    const int aoff = lds_byte(wr * 64 + fr, fq * 8), boff = lds_byte(wc * 32 + fr, fq * 8);
#define PG8_SA(b, h) (((b) * 2 + (h)) * HTB)
#define PG8_SB(b, h) ((4 + (b) * 2 + (h)) * HTB)
#define PG8_STAGE(bufoff, gbase, voff) do { _Pragma("unroll") for (int _i = 0; _i < 2; ++_i) \
        __builtin_amdgcn_global_load_lds((const unsigned*)((const char*)(gbase) + (voff)[_i]), (LAS unsigned*)(lds + (bufoff) + ldsw + _i * 8192), 16, 0, 0); } while (0)
#define PG8_LDA(dst, b, h) do { _Pragma("unroll") for (int m = 0; m < 4; ++m) _Pragma("unroll") for (int k = 0; k < 2; ++k) dst[m][k] = *(const LAS bf16x8*)(lds + PG8_SA(b, h) + aoff + m * 2048 + k * 1024); } while (0)
#define PG8_LDB(dst, b, h) do { _Pragma("unroll") for (int n = 0; n < 2; ++n) _Pragma("unroll") for (int k = 0; k < 2; ++k) dst[n][k] = *(const LAS bf16x8*)(lds + PG8_SB(b, h) + boff + n * 2048 + k * 1024); } while (0)
#define PG8_MMA(ai, bj, At, Bt) do { __builtin_amdgcn_s_setprio(1); _Pragma("unroll") for (int m = 0; m < 4; ++m) _Pragma("unroll") for (int n = 0; n < 2; ++n) _Pragma("unroll") for (int k = 0; k < 2; ++k) \
        acc[ai][bj][m][n] = __builtin_amdgcn_mfma_f32_16x16x32_bf16(Bt[n][k], At[m][k], acc[ai][bj][m][n], 0, 0, 0); __builtin_amdgcn_s_setprio(0); } while (0)
#define PG8_WAIT_V(n) asm volatile("s_waitcnt vmcnt(" #n ")" ::: "memory")
#define PG8_WAIT_L(n) asm volatile("s_waitcnt lgkmcnt(" #n ")" ::: "memory")
#define PG8_BAR __builtin_amdgcn_s_barrier()
#define PG8_SCHED __builtin_amdgcn_sched_barrier(0)
#define PG8_AOFF(dst, u) do { _Pragma("unroll") for (int _h = 0; _h < 2; ++_h) _Pragma("unroll") for (int _i = 0; _i < 2; ++_i) \
        dst[_h][_i] = ((unsigned)S.arow(u, _h * HALF + RA[_i]) * (unsigned)K + (unsigned)CA[_i]) * 2u; } while (0)
    Unit cur, nxt; int ui = 0;
    if (!S.next(0, cur)) return;
    f32x4 acc[2][2][4][2];
#pragma unroll
    for (int a = 0; a < 2; ++a)
#pragma unroll
        for (int b = 0; b < 2; ++b)
#pragma unroll
            for (int m = 0; m < 4; ++m)
#pragma unroll
                for (int n = 0; n < 2; ++n) acc[a][b][m][n] = (f32x4){0.f, 0.f, 0.f, 0.f};
    bf16x8 At[4][2], B0[2][2], B1[2][2];
    unsigned cv[2][2], nv[2][2];
    PG8_AOFF(cv, cur);
    const char* Ab = (const char*)g.A;
    const char* cB = (const char*)g.Bt + (size_t)cur.pn * tstep;
    {
        PG8_STAGE(PG8_SB(0, 0), cB, voffB); PG8_STAGE(PG8_SB(0, 1), cB + hstep, voffB); PG8_STAGE(PG8_SA(0, 0), Ab, cv[0]); PG8_STAGE(PG8_SA(0, 1), Ab, cv[1]);
        if (wr == 1) PG8_BAR;
        PG8_WAIT_V(2); PG8_BAR;
        PG8_STAGE(PG8_SB(1, 0), cB + kstep, voffB); PG8_STAGE(PG8_SA(1, 0), Ab + kstep, cv[0]); PG8_STAGE(PG8_SB(1, 1), cB + hstep + kstep, voffB);
        PG8_WAIT_V(6); PG8_BAR;
    }
    for (;;) {
        const bool has_next = S.next(ui + 1, nxt);
        if (has_next) { PG8_AOFF(nv, nxt); } else {
#pragma unroll
            for (int _h = 0; _h < 2; ++_h)
#pragma unroll
                for (int _i = 0; _i < 2; ++_i) nv[_h][_i] = cv[_h][_i]; }
        const char* nB = has_next ? (const char*)g.Bt + (size_t)nxt.pn * tstep : cB;
        for (int t = 0; t < nt; t += 2) {
            const bool last = (t == nt - 2);
            const int relax = __builtin_amdgcn_readfirstlane(((t == 0) && (ui > 0)) ? 1 : 0);
            const char* a1 = Ab + (size_t)(t + 1) * kstep;
            const char* a2 = last ? Ab : Ab + (size_t)(t + 2) * kstep; const char* b2 = last ? nB : cB + (size_t)(t + 2) * kstep;
            const char* a3 = a2 + kstep; const char* b3 = b2 + kstep;
            unsigned o2[2][2];
#pragma unroll
            for (int _h = 0; _h < 2; ++_h)
#pragma unroll
                for (int _i = 0; _i < 2; ++_i) o2[_h][_i] = last ? nv[_h][_i] : cv[_h][_i];
            PG8_LDB(B0, 0, 0); PG8_LDB(B1, 0, 1); PG8_SCHED; PG8_LDA(At, 0, 0); PG8_STAGE(PG8_SA(1, 1), a1, cv[1]);
            wait_v_sel<8, 8 + Epi::NST>(relax);
            PG8_WAIT_L(0); PG8_BAR; PG8_MMA(0, 0, At, B0); PG8_MMA(0, 1, At, B1); PG8_BAR; PG8_SCHED;
            PG8_LDA(At, 0, 1); PG8_STAGE(PG8_SB(0, 0), b2, voffB); PG8_STAGE(PG8_SB(0, 1), b2 + hstep, voffB); PG8_STAGE(PG8_SA(0, 0), a2, o2[0]);
            wait_v_sel<8, 8 + Epi::NST>(relax);
            PG8_WAIT_L(0); PG8_BAR; PG8_MMA(1, 0, At, B0); PG8_MMA(1, 1, At, B1); PG8_BAR; PG8_SCHED;
            PG8_LDB(B0, 1, 0); PG8_LDB(B1, 1, 1); PG8_SCHED; PG8_LDA(At, 1, 0); PG8_STAGE(PG8_SA(0, 1), a2, o2[1]);
            PG8_WAIT_V(8); PG8_WAIT_L(0); PG8_BAR; PG8_MMA(0, 0, At, B0); PG8_MMA(0, 1, At, B1); PG8_BAR; PG8_SCHED;
            PG8_LDA(At, 1, 1); PG8_STAGE(PG8_SB(1, 0), b3, voffB); PG8_STAGE(PG8_SB(1, 1), b3 + hstep, voffB); PG8_STAGE(PG8_SA(1, 0), a3, o2[0]);
            PG8_WAIT_V(8); PG8_WAIT_L(0); PG8_BAR; PG8_MMA(1, 0, At, B0); PG8_MMA(1, 1, At, B1); PG8_BAR; PG8_SCHED;
        }
        if (wr == 0) PG8_BAR;
        { int le; asm volatile("v_mbcnt_lo_u32_b32 %0, -1, 0\n\tv_mbcnt_hi_u32_b32 %0, -1, %0" : "=v"(le));
          E(acc, cur, wr, wc, le & 15, le >> 4); }
        if (!has_next) break;
#pragma unroll
        for (int a = 0; a < 2; ++a)
#pragma unroll
            for (int b = 0; b < 2; ++b)
#pragma unroll
                for (int m = 0; m < 4; ++m)
#pragma unroll
                    for (int n = 0; n < 2; ++n) acc[a][b][m][n] = (f32x4){0.f, 0.f, 0.f, 0.f};
        cur = nxt; cB = nB; ++ui;
#pragma unroll
        for (int _h = 0; _h < 2; ++_h)
#pragma unroll
            for (int _i = 0; _i < 2; ++_i) cv[_h][_i] = nv[_h][_i];
        if (wr == 1) PG8_BAR;
    }
    PG8_WAIT_V(0);
    PG8_BAR;
#undef PG8_SA
#undef PG8_SB
#undef PG8_STAGE
#undef PG8_LDA
#undef PG8_LDB
#undef PG8_MMA
#undef PG8_WAIT_V
#undef PG8_WAIT_L
#undef PG8_BAR
#undef PG8_SCHED
#undef PG8_AOFF
}

struct DenseOrder {
    int nM, nN, nwg, G, c; unsigned long long cperm;
    __device__ void init(int M, int N, int G_, int c_, unsigned long long cperm_ = 0ull) { nM = M / BM; nN = N / BM; nwg = nM * nN; G = G_; c = c_; cperm = cperm_; }
    __device__ __forceinline__ bool next(int i, Unit& u) const {
        const long L = (long)i * G + c; if (L >= nwg) return false;
        int wgid = (int)L; { const int q = nwg / 8, r = nwg % 8, xcd = wgid % 8, off = wgid / 8; wgid = (xcd < r ? xcd * (q + 1) : r * (q + 1) + (xcd - r) * q) + off; }
        const int nig = 8 * nN, gid = wgid / nig, fm = gid * 8, gsz = (nM - fm) < 8 ? (nM - fm) : 8;
        u.pm = fm + ((wgid % nig) % gsz); u.pn = (wgid % nig) / gsz; if (cperm) u.pn = (int)((cperm >> (4 * u.pn)) & 15ull);
        u.e = 0; u.r0 = 0; u.nrows = BM; u.slot = 0; return true;
    }
    __device__ __forceinline__ int arow(const Unit& u, int r) const { return u.pm * BM + r; }
};
__device__ __forceinline__ void xpose128(LAS unsigned char* scr, int fr, int fq, const u32x4& w0, const u32x4& w1, u32x4& rA, u32x4& rB) {
    const int sw = fr & 7;
    *(LAS u32x4*)(scr + fr * 128 + ((fq ^ sw) << 4)) = w0;
    *(LAS u32x4*)(scr + fr * 128 + (((4 + fq) ^ sw) << 4)) = w1;
    asm volatile("" ::: "memory");
    const int l = fr + 16 * fq, r = l >> 3, c = l & 7;
    rA = *(const LAS u32x4*)(scr + r * 128 + ((c ^ r) << 4));
    rB = *(const LAS u32x4*)(scr + 1024 + r * 128 + ((c ^ r) << 4));
    asm volatile("" ::: "memory");
}
}

#define XB_TMO      128
#define XB_XCNT(j)  (256  + 64 * (j))
#define XB_XSUB(j)  (1280 + 64 * (j))
#define XB_XGEN(j)  (2304 + 64 * (j))
#define XB_TOP      3328
#define XB_TOPGEN   3392
#define XCD_BAR_WORDS 3456
#define XB_SPIN_CAP (1u << 18)
__device__ __forceinline__ unsigned xb_ld(unsigned* p)              { return __hip_atomic_load(p, __ATOMIC_RELAXED, __HIP_MEMORY_SCOPE_AGENT); }
__device__ __forceinline__ unsigned xb_add(unsigned* p, unsigned v) { return __hip_atomic_fetch_add(p, v, __ATOMIC_RELAXED, __HIP_MEMORY_SCOPE_AGENT); }
__device__ __forceinline__ unsigned xb_xcc_id() { return (unsigned)__builtin_amdgcn_s_getreg((3 << 11) | 20) & 0xFu; }
#define XB_SPIN(cond, bar) do { unsigned _sp = 0; while (cond) { __builtin_amdgcn_s_sleep(1); \
    if ((++_sp & 255u) == 0u) { if (xb_ld(&(bar)[XB_TMO])) break; if (_sp > XB_SPIN_CAP) { atomicAdd(&(bar)[XB_TMO], 1u); break; } } } } while (0)
struct XcdBarrier { unsigned* bar; unsigned x; volatile LAS unsigned* st; };
__device__ __forceinline__ XcdBarrier xcd_barrier_post(unsigned* bar, volatile LAS unsigned* st) {
    XcdBarrier b; b.bar = bar; b.x = xb_xcc_id(); b.st = st;
    if (threadIdx.x == 0) (void)xb_add(&bar[XB_XCNT(b.x)], 1u);
    return b;
}
__device__ __forceinline__ void xcd_barrier_complete(unsigned* bar, unsigned x, unsigned& nloc, unsigned& nx) {
    const unsigned G = gridDim.x * gridDim.y * gridDim.z;
    unsigned sum, cnt, mine, sp = 0u;
    for (;;) {
        sum = 0u; cnt = 0u; mine = 0u;
#pragma unroll
        for (unsigned j = 0; j < 16; ++j) { const unsigned c = xb_ld(&bar[XB_XCNT(j)]); sum += c; cnt += (c > 0u) ? 1u : 0u; mine = (j == x) ? c : mine; }
        if (sum == G) break;
        __builtin_amdgcn_s_sleep(1);
        if ((++sp & 255u) == 0u) { if (xb_ld(&bar[XB_TMO])) break; if (sp > XB_SPIN_CAP) { atomicAdd(&bar[XB_TMO], 1u); break; } }
    }
    nloc = mine > 0u ? mine : 1u; nx = cnt > 0u ? cnt : 1u;
}
__device__ __forceinline__ void xcd_barrier(const XcdBarrier& b) {
    asm volatile("s_waitcnt vmcnt(0)" ::: "memory");
    __syncthreads();
    if (threadIdx.x == 0) {
        unsigned* bar = b.bar;
        __builtin_amdgcn_s_waitcnt(0);
        unsigned nloc = b.st[0], nx = b.st[1];
        if (nloc == 0u) { xcd_barrier_complete(bar, b.x, nloc, nx); b.st[0] = nloc; b.st[1] = nx; }
        const unsigned old = xb_add(&bar[XB_XSUB(b.x)], 1u);
        const unsigned gen = old / nloc;
        if (old + 1u == (gen + 1u) * nloc) {
            __builtin_amdgcn_fence(__ATOMIC_RELEASE, "agent");
            asm volatile("s_waitcnt vmcnt(0)" ::: "memory");
            const unsigned og = xb_add(&bar[XB_TOP], 1u);
            const unsigned tg = og / nx;
            if (og + 1u == (tg + 1u) * nx) xb_add(&bar[XB_TOPGEN], 1u);
            else XB_SPIN(xb_ld(&bar[XB_TOPGEN]) == tg, bar);
            __builtin_amdgcn_fence(__ATOMIC_ACQUIRE, "agent");
            xb_add(&bar[XB_XGEN(b.x)], 1u);
            asm volatile("s_waitcnt vmcnt(0)" ::: "memory");
        } else {
            XB_SPIN(xb_ld(&bar[XB_XGEN(b.x)]) == gen, bar);
            __builtin_amdgcn_fence(__ATOMIC_ACQUIRE, "agent");
            asm volatile("s_waitcnt vmcnt(0)" ::: "memory");
        }
    }
    __syncthreads();
}

struct Args { const float* in[24]; float* out; unsigned char* ws; };
struct Frame {
    LAS unsigned char* lds;
    int tid, lane, wave, vcu, G;
};

template <int MODE>
__device__ __forceinline__ void p0_transpose_item(const float* W, int K, int N, bf16* WT, LAS float* scr, int item, int lane) {
    const int nblk = N / 32, kb = item / nblk, nb = item % nblk, k0 = 64 * kb, n0 = 32 * nb;
    f32x4 v[8];
#pragma unroll
    for (int i = 0; i < 8; ++i) v[i] = *(const f32x4*)(W + (size_t)(k0 + 8 * i + (lane >> 3)) * N + n0 + 4 * (lane & 7));
#pragma unroll
    for (int i = 0; i < 8; ++i) { LAS float* d = scr + (8 * i + (lane >> 3)) * 33 + 4 * (lane & 7); d[0] = v[i].x; d[1] = v[i].y; d[2] = v[i].z; d[3] = v[i].w; }
    asm volatile("s_waitcnt lgkmcnt(0)" ::: "memory");
    const int c = lane & 7;
#pragma unroll
    for (int j = 0; j < 4; ++j) { const int n = (lane >> 3) + 8 * j; const LAS float* s = scr + (8 * c) * 33 + n;
        u32x4 o; o.x = cvtpk(s[0 * 33], s[1 * 33]); o.y = cvtpk(s[2 * 33], s[3 * 33]); o.z = cvtpk(s[4 * 33], s[5 * 33]); o.w = cvtpk(s[6 * 33], s[7 * 33]);
        const int f = n0 + n; int row = f;
        if (MODE == 1) row = ((f >> 7) << 8) + (((f >> 5) & 3) << 6) + (f & 31);
        if (MODE == 2) row = ((f >> 7) << 8) + (((f >> 5) & 3) << 6) + 32 + (f & 31);
        *(u32x4*)(WT + (size_t)row * K + k0 + 8 * c) = o; }
    asm volatile("s_waitcnt lgkmcnt(0)" ::: "memory");
}

__device__ __forceinline__ void p0_prologue(const Frame& F, const Args& a) {
    unsigned char* ws = a.ws;
    if (F.vcu < 96) {
        LAS float* cact = (LAS float*)F.lds;
        LAS float* red = (LAS float*)(F.lds + 32768);
        const float* c = a.in[1];
        for (int i = F.tid; i < 8192; i += NTHREADS) { const int b = i >> 10, k = i & 1023; cact[k * 8 + b] = siluf_(c[i]); }
        __syncthreads();
        const int j = F.vcu * 64 + F.lane;
        const float* w = a.in[2] + (size_t)(128 * F.wave) * 6144 + j;
        float acc[8];
#pragma unroll
        for (int b = 0; b < 8; ++b) acc[b] = 0.f;
#pragma unroll 16
        for (int k = 0; k < 128; ++k) { const float wv = w[(size_t)k * 6144]; const LAS float* cp = cact + (128 * F.wave + k) * 8; const f32x4 c0 = *(const LAS f32x4*)cp, c1 = *(const LAS f32x4*)(cp + 4);
            acc[0] += c0.x * wv; acc[1] += c0.y * wv; acc[2] += c0.z * wv; acc[3] += c0.w * wv; acc[4] += c1.x * wv; acc[5] += c1.y * wv; acc[6] += c1.z * wv; acc[7] += c1.w * wv; }
#pragma unroll
        for (int b = 0; b < 8; ++b) red[(F.wave * 8 + b) * 64 + F.lane] = acc[b];
        __syncthreads();
        { const int b = F.tid >> 6; float s = 0.f;
#pragma unroll
          for (int ww = 0; ww < 8; ++ww) s += red[(ww * 8 + b) * 64 + F.lane];
          ((float*)(ws + WS_MOD))[b * 6144 + j] = s + a.in[3][j]; }
        __syncthreads();
    }
    LAS float* scr = (LAS float*)(F.lds + F.wave * 16384);
    const int gw = F.vcu * NWAVES + F.wave, NGW = F.G * NWAVES;
    constexpr int I_IN = 16 * 112, I_OUT = 16 * 32;
    constexpr int NITEMS = I_IN + I_OUT;
    bf16* win = (bf16*)(ws + WS_WIN); bf16* wout = (bf16*)(ws + WS_WOUT);
    for (int it = NITEMS - 1 - gw; it >= 0; it -= NGW) {
        int r = it;
        if (r < I_IN) { p0_transpose_item<0>(a.in[6], 1024, INW, win, scr, r, F.lane); continue; } r -= I_IN;
        p0_transpose_item<0>(a.in[15], 1024, 1024, wout, scr, r, F.lane);
    }
}

__device__ __forceinline__ void p0b_norm1(const Frame& F, const Args& a) {
    const float* x = a.in[0]; const float* ng = a.in[4]; const float* mod = (const float*)(a.ws + WS_MOD);
    bf16* H = (bf16*)(a.ws + WS_H);
    const int gw = F.vcu * NWAVES + F.wave, NGW = F.G * NWAVES;
    const int per = (NTOK + NGW - 1) / NGW;
    const int m0 = gw * per, m1 = (m0 + per < NTOK) ? m0 + per : NTOK;
    if (m0 >= NTOK) return;
    for (int s0 = m0; s0 < m1; ) {
        const int b = s0 >> 13, e1 = ((b + 1) << 13) < m1 ? ((b + 1) << 13) : m1;
        f32x4 ga[4], sha[4];
        { const f32x4* gp = (const f32x4*)ng + F.lane; const f32x4* shp = (const f32x4*)(mod + b * 6144) + F.lane; const f32x4* scp = (const f32x4*)(mod + b * 6144 + 1024) + F.lane;
#pragma unroll
          for (int j = 0; j < 4; ++j) { ga[j] = gp[64 * j] * (scp[64 * j] + 1.f); sha[j] = shp[64 * j]; } }
        f32x4 nx[4];
        { const f32x4* xr = (const f32x4*)(x + (size_t)s0 * D) + F.lane;
#pragma unroll
          for (int j = 0; j < 4; ++j) nx[j] = xr[64 * j]; }
        for (int m = s0; m < e1; ++m) {
            f32x4 v[4];
#pragma unroll
            for (int j = 0; j < 4; ++j) v[j] = nx[j];
            { const int mn = (m + 1 < e1) ? m + 1 : m; const f32x4* xr = (const f32x4*)(x + (size_t)mn * D) + F.lane;
#pragma unroll
              for (int j = 0; j < 4; ++j) nx[j] = xr[64 * j]; }
            float s = 0.f;
#pragma unroll
            for (int j = 0; j < 4; ++j) s += (v[j].x * v[j].x + v[j].y * v[j].y) + (v[j].z * v[j].z + v[j].w * v[j].w);
            const float r = __builtin_amdgcn_rsqf(wave_sum(s) * (1.f / D) + EPS);
            u32x2* o8 = (u32x2*)(H + (size_t)m * D) + F.lane;
#pragma unroll
            for (int j = 0; j < 4; ++j) { const f32x4 y = v[j] * r * ga[j] + sha[j];
                u32x2 o; o.x = cvtpk(y.x, y.y); o.y = cvtpk(y.z, y.w); o8[64 * j] = o; }
        }
        s0 = e1;
    }
}

struct EpiProj {
    static constexpr bool PERM = true;
    static constexpr int NST = 16;
    bf16* O; const float* lbraw;
    bf16* QC; bf16* KV;
    LAS unsigned char* scr;
    __device__ __forceinline__ void operator()(const f32x4 (&acc)[2][2][4][2], const pg8::Unit& u, int wr, int wc, int fr, int fq) const {
        const int seg = u.pn >> 1;
        const int col0 = u.pn * 256 + wc * 64 + 8 * fq;
        float lb[2][8];
        if (seg == 4) {
#pragma unroll
            for (int bj = 0; bj < 2; ++bj)
#pragma unroll
                for (int i = 0; i < 8; ++i) { const int k = col0 + bj * 32 + i - COL_FR; const float r0 = lbraw[k], r1 = lbraw[512 + k]; lb[bj][i] = fast_rcp(1.f + fast_exp2((r1 - r0) * LOG2E)); }
        }
        LAS unsigned char* ws_ = scr + (wr * 4 + wc) * 2048;
        const int l = fr + 16 * fq, r8 = l >> 3, c8 = l & 7;
        const int colT = u.pn * 256 + wc * 64 + 8 * c8, rowT = u.pm * 256 + wr * 64 + r8;
        u32x4 rq[2][2];
#pragma unroll
        for (int it = 0; it <= 8; ++it) {
            if (it < 8) { const int ai = it >> 2, m = it & 3; u32x4 w[2];
#pragma unroll
                for (int bj = 0; bj < 2; ++bj) { float v[8];
#pragma unroll
                    for (int i = 0; i < 4; ++i) { v[i] = acc[ai][bj][m][0][i]; v[4 + i] = acc[ai][bj][m][1][i]; }
                    if (seg == 0) {
#pragma unroll
                        for (int i = 0; i < 8; ++i) v[i] *= QSCALE;
                    } else if (seg == 3 || seg == 6) {
#pragma unroll
                        for (int i = 0; i < 8; ++i) v[i] = siluf_(v[i]);
                    } else if (seg == 4) {
#pragma unroll
                        for (int i = 0; i < 8; ++i) { const float lw = lb[bj][i]; v[i] = __builtin_amdgcn_logf(lw + (1.f - lw) * sigmoidf_(v[i])) * 0.6931471805599453f; }
                    }
                    w[bj].x = cvtpk(v[0], v[1]); w[bj].y = cvtpk(v[2], v[3]); w[bj].z = cvtpk(v[4], v[5]); w[bj].w = cvtpk(v[6], v[7]); }
                pg8::xpose128(ws_, fr, fq, w[0], w[1], rq[it & 1][0], rq[it & 1][1]); }
            if (it > 0) { const int ai = (it - 1) >> 2, m = (it - 1) & 3; const u32x4 rA = rq[(it - 1) & 1][0], rB = rq[(it - 1) & 1][1];
                const int row = rowT + ai * 128 + m * 16;
                if (seg < 3) {
                    const int c = colT & 511, hh = c >> 7, e = c & 127; const size_t tokrow = (size_t)((row >> 13) * 4 + hh) * SEQ + (row & (SEQ - 1));
                    if (seg == 0) { bf16* dst = QC + tokrow * 128 + e; *(u32x4*)dst = rA; *(u32x4*)(dst + 8 * 128) = rB; }
                    else { bf16* dst = KV + tokrow * 256 + (seg == 2 ? 128 : 0) + e; *(u32x4*)dst = rA; *(u32x4*)(dst + 8 * 256) = rB; }
                } else { bf16* rowp = O + (size_t)row * INW + colT; *(u32x4*)rowp = rA; *(u32x4*)(rowp + (size_t)8 * INW) = rB; } } }
    }
};

struct EpiRes1 {
    static constexpr bool PERM = true;
    static constexpr int NST = 16;
    const float* x; bf16* x1b; const float* mod;
    LAS unsigned char* scr;
    __device__ __forceinline__ void operator()(const f32x4 (&acc)[2][2][4][2], const pg8::Unit& u, int wr, int wc, int fr, int fq) const {
        const int b = (u.pm * 256) >> 13;
        const int col0 = u.pn * 256 + wc * 64 + 8 * fq;
        f32x4 gv[2][2];
#pragma unroll
        for (int bj = 0; bj < 2; ++bj)
#pragma unroll
            for (int n = 0; n < 2; ++n) gv[bj][n] = *(const f32x4*)(mod + b * 6144 + 2048 + col0 + bj * 32 + n * 4);
        LAS unsigned char* ws_ = scr + (wr * 4 + wc) * 2048;
        const int l = fr + 16 * fq, r8 = l >> 3, c8 = l & 7;
        const int colT = u.pn * 256 + wc * 64 + 8 * c8, rowT = u.pm * 256 + wr * 64 + r8;
        f32x4 xb[3][4];
#define RES1_LOAD(it) do { const size_t o_ = (size_t)(rowT + ((it) >> 2) * 128 + ((it) & 3) * 16) * D + colT; \
            xb[(it) % 3][0] = *(const f32x4*)(x + o_); xb[(it) % 3][1] = *(const f32x4*)(x + o_ + 4); xb[(it) % 3][2] = *(const f32x4*)(x + o_ + 8 * D); xb[(it) % 3][3] = *(const f32x4*)(x + o_ + 8 * D + 4); } while (0)
        RES1_LOAD(0); RES1_LOAD(1);
#pragma unroll
        for (int it = 0; it < 8; ++it) { const int ai = it >> 2, m = it & 3; const size_t off = (size_t)(rowT + ai * 128 + m * 16) * D + colT;
            if (it + 2 < 8) RES1_LOAD(it + 2);
            u32x4 w[2];
#pragma unroll
            for (int bj = 0; bj < 2; ++bj) { const f32x4 t0 = gv[bj][0] * acc[ai][bj][m][0], t1 = gv[bj][1] * acc[ai][bj][m][1];
                w[bj].x = cvtpk(t0.x, t0.y); w[bj].y = cvtpk(t0.z, t0.w); w[bj].z = cvtpk(t1.x, t1.y); w[bj].w = cvtpk(t1.z, t1.w); }
            u32x4 rA, rB; pg8::xpose128(ws_, fr, fq, w[0], w[1], rA, rB);
            const f32x4 xa0 = xb[it % 3][0], xa1 = xb[it % 3][1], xb0 = xb[it % 3][2], xb1 = xb[it % 3][3];
            u32x4 o;
            o.x = cvtpk(xa0.x + bflo(rA.x), xa0.y + bfhi(rA.x)); o.y = cvtpk(xa0.z + bflo(rA.y), xa0.w + bfhi(rA.y));
            o.z = cvtpk(xa1.x + bflo(rA.z), xa1.y + bfhi(rA.z)); o.w = cvtpk(xa1.z + bflo(rA.w), xa1.w + bfhi(rA.w));
            *(u32x4*)(x1b + off) = o;
            o.x = cvtpk(xb0.x + bflo(rB.x), xb0.y + bfhi(rB.x)); o.y = cvtpk(xb0.z + bflo(rB.y), xb0.w + bfhi(rB.y));
            o.z = cvtpk(xb1.x + bflo(rB.z), xb1.y + bfhi(rB.z)); o.w = cvtpk(xb1.z + bflo(rB.w), xb1.w + bfhi(rB.w));
            *(u32x4*)(x1b + off + 8 * D) = o; }
#undef RES1_LOAD
    }
};

constexpr int WC_ITEMS = 3 * 32 * 256, WC_CHUNKS = WC_ITEMS / (32 * 8);
typedef const __attribute__((address_space(1))) f32x4* gcf4p;
typedef __attribute__((address_space(1))) u32x4* gu4p;
__device__ __forceinline__ void wconv_load(const Args& a, f32x4 (&v)[8], int it, int lane) {
    const int m = it >> 13, r = it & 8191, e = r >> 8, blk = r & 255;
    const int N = m < 2 ? 512 : 1024, nb = m < 2 ? (blk & 15) : (blk & 31), kb = m < 2 ? (blk >> 4) : (blk >> 5);
    const float* p1 = a.in[20]; const float* p3 = a.in[21]; const float* p2 = a.in[22]; asm volatile("" : "+s"(p1), "+s"(p3), "+s"(p2));
    const float* W = (m == 0 ? p1 : m == 1 ? p3 : p2) + (size_t)e * (1024 * 512) + (size_t)(64 * kb + 8 * (lane >> 3)) * N + 32 * nb + 4 * (lane & 7);
#pragma unroll
    for (int i = 0; i < 8; ++i) v[i] = *(gcf4p)(W + (size_t)i * N);
}
__device__ __forceinline__ void wconv_store(const Args& a, const f32x4 (&v)[8], int it, int lane, LAS unsigned char* scr) {
    const int m = it >> 13, r = it & 8191, e = r >> 8, blk = r & 255;
    const int K = m < 2 ? 1024 : 512, nb = m < 2 ? (blk & 15) : (blk & 31), kb = m < 2 ? (blk >> 4) : (blk >> 5);
    bf16* q13 = (bf16*)(a.ws + WS_W13); bf16* q2 = (bf16*)(a.ws + WS_W2); asm volatile("" : "+s"(q13), "+s"(q2));
    bf16* WT = (m < 2 ? q13 + (size_t)e * (1024 * 1024) : q2 + (size_t)e * (1024 * 512)) + 64 * kb;
    const int kk = lane >> 3, nn = lane & 7;
#pragma unroll
    for (int h = 0; h < 2; ++h) {
#pragma unroll
        for (int jj = 0; jj < 2; ++jj) { const int j = 2 * h + jj;
            u32x4 o; o.x = cvtpk(v[0][j], v[1][j]); o.y = cvtpk(v[2][j], v[3][j]); o.z = cvtpk(v[4][j], v[5][j]); o.w = cvtpk(v[6][j], v[7][j]);
            *(LAS u32x4*)(scr + (8 * jj + nn) * 128 + ((kk ^ nn) << 4)) = o; }
        asm volatile("" ::: "memory");
#pragma unroll
        for (int p = 0; p < 2; ++p) { const int f = 32 * nb + 4 * kk + 2 * h + p;
            const u32x4 o = *(const LAS u32x4*)(scr + (8 * p + kk) * 128 + ((nn ^ kk) << 4));
            const int row = m < 2 ? ((f >> 7) << 8) + (((f >> 5) & 3) << 6) + (m == 1 ? 32 : 0) + (f & 31) : f;
            *(gu4p)(WT + (size_t)row * K + 8 * nn) = o; }
        asm volatile("" ::: "memory");
    }
}

constexpr int HG_RS_ = 272, HG_SCS = 144, HG_ARR = 64 * HG_RS_;
constexpr int HG_RAW = 0, HG_QT = 3 * HG_ARR, HG_KT = HG_QT + HG_ARR, HG_SC = HG_KT + HG_ARR, HG_SEG = HG_SC + 64 * HG_SCS, HG_EL = HG_SEG + 4096, HG_OUT = HG_EL + 512, HG_END = HG_OUT + HG_ARR;
static_assert(HG_END <= RING_BYTES, "hgrn LDS map");
__device__ __forceinline__ s16x4 tr16(const LAS unsigned char* p) { return __builtin_bit_cast(s16x4, __builtin_amdgcn_ds_read_tr16_b64_v4i16((LAS s16x4*)p)); }

__device__ __forceinline__ void hgrn_stream(const Frame& F, const Args& a, int bh) {
    const int b = bh >> 2, h = bh & 3;
    const bf16* P = (const bf16*)(a.ws + WS_PROJ) + (size_t)b * SEQ * INW;
    bf16* Y = (bf16*)(a.ws + WS_Y) + (size_t)b * SEQ * D + 512 + h * 128;
    LAS unsigned char* lds = F.lds;
    const int tid = F.tid, lane = F.lane, w = F.wave, l15 = lane & 15, g = lane >> 4;
    u32x4 pre[4][2], gsr[2];
    const __amdgpu_buffer_rsrc_t prs = __builtin_amdgcn_make_buffer_rsrc((void*)P, (short)0, SEQ * INW * 2, 0x00020000);
    const unsigned hg_voff = (unsigned)((tid >> 4) * INW + COL_QR + h * 128 + (tid & 15) * 8) * 2u;
#define HG_LOAD(c) do { _Pragma("unroll") for (int ar = 0; ar < 4; ++ar) _Pragma("unroll") for (int i = 0; i < 2; ++i) { \
        pre[ar][i] = __builtin_bit_cast(u32x4, __builtin_amdgcn_raw_buffer_load_b128(prs, hg_voff, (unsigned)((((c) * 64 + 32 * i) * INW + 512 * ar) * 2), 0)); } } while (0)
#define HG_STORE() do { _Pragma("unroll") for (int ar = 0; ar < 3; ++ar) _Pragma("unroll") for (int i = 0; i < 2; ++i) { const int q = tid + 512 * i, row = q >> 4, ch = q & 15; \
        *(LAS u32x4*)(lds + HG_RAW + ar * HG_ARR + row * HG_RS_ + ch * 16) = pre[ar][i]; } gsr[0] = pre[3][0]; gsr[1] = pre[3][1]; } while (0)
    f32x4 S[8];
#pragma unroll
    for (int kb = 0; kb < 8; ++kb) S[kb] = (f32x4){0.f, 0.f, 0.f, 0.f};
    float ngc[8];
    { const float* ngp = a.in[14] + h * 128 + (tid & 15) * 8;
#pragma unroll
      for (int i = 0; i < 8; ++i) ngc[i] = ngp[i]; }
    HG_LOAD(0);
    HG_STORE();
    for (int c = 0; c < SEQ / 64; ++c) {
        __syncthreads();
        if (c + 1 < SEQ / 64) HG_LOAD(c + 1);
        const bool wdo = c < WC_CHUNKS; const int wit = (c * 32 + bh) * 8 + w;
        f32x4 wv[8];
        if (wdo) wconv_load(a, wv, wit, lane);
        else {
#pragma unroll
            for (int i = 0; i < 8; ++i) wv[i] = (f32x4){0.f, 0.f, 0.f, 0.f}; }
        float bl[8][2];
        {
            float run0 = 0.f, run1 = 0.f;
#pragma unroll
            for (int i = 0; i < 8; ++i) { const unsigned v = *(const LAS unsigned*)(lds + HG_RAW + HG_ARR + (8 * w + i) * HG_RS_ + 4 * lane);
                run0 += bflo(v); run1 += bfhi(v); bl[i][0] = run0; bl[i][1] = run1; }
            *(LAS f32x2*)(lds + HG_SEG + (w * 128 + 2 * lane) * 4) = (f32x2){run0, run1};
        }
        __syncthreads();
        {
            float off0 = 0.f, off1 = 0.f, tot0 = 0.f, tot1 = 0.f;
#pragma unroll
            for (int s = 0; s < 8; ++s) { const f32x2 v = *(const LAS f32x2*)(lds + HG_SEG + (s * 128 + 2 * lane) * 4); if (s < w) { off0 += v.x; off1 += v.y; } tot0 += v.x; tot1 += v.y; }
            if (w == 0) *(LAS f32x2*)(lds + HG_EL + 2 * lane * 4) = (f32x2){fast_exp2(tot0 * LOG2E), fast_exp2(tot1 * LOG2E)};
#pragma unroll
            for (int i = 0; i < 8; ++i) { const int t = 8 * w + i;
                const unsigned lfv = *(const LAS unsigned*)(lds + HG_RAW + HG_ARR + t * HG_RS_ + 4 * lane);
                const unsigned qv = *(const LAS unsigned*)(lds + HG_RAW + t * HG_RS_ + 4 * lane);
                const float b0 = bl[i][0] + off0, b1 = bl[i][1] + off1;
                const float e0 = fast_exp2(b0 * LOG2E), e1 = fast_exp2(b1 * LOG2E);
                const float k0 = 1.f - fast_exp2(bflo(lfv) * LOG2E), k1 = 1.f - fast_exp2(bfhi(lfv) * LOG2E);
                *(LAS unsigned*)(lds + HG_QT + t * HG_RS_ + 4 * lane) = cvtpk(bflo(qv) * e0, bfhi(qv) * e1);
                *(LAS unsigned*)(lds + HG_KT + t * HG_RS_ + 4 * lane) = cvtpk(k0 * fast_rcp(e0), k1 * fast_rcp(e1)); }
        }
        __syncthreads();
#pragma unroll
        for (int i = 0; i < 2; ++i) { const int tile = 2 * w + i, tb = tile >> 2, sb = tile & 3;
            f32x4 sc = (f32x4){0.f, 0.f, 0.f, 0.f};
#pragma unroll
            for (int ks = 0; ks < 4; ++ks) { const bf16x8 af = *(const LAS bf16x8*)(lds + HG_QT + (16 * tb + l15) * HG_RS_ + (32 * ks + 8 * g) * 2);
                const bf16x8 bfr = *(const LAS bf16x8*)(lds + HG_KT + (16 * sb + l15) * HG_RS_ + (32 * ks + 8 * g) * 2);
                sc = __builtin_amdgcn_mfma_f32_16x16x32_bf16(af, bfr, sc, 0, 0, 0); }
#pragma unroll
            for (int r = 0; r < 4; ++r) { const int t = 16 * tb + 4 * g + r, s = 16 * sb + l15; const float v = (s <= t) ? sc[r] : 0.f;
                *(LAS unsigned short*)(lds + HG_SC + t * HG_SCS + s * 2) = (unsigned short)(cvtpk(v, 0.f) & 0xffffu); } }
        __syncthreads();
        bf16x8 vf[2];
#pragma unroll
        for (int ss = 0; ss < 2; ++ss) { const LAS unsigned char* vp = lds + HG_RAW + 2 * HG_ARR + (32 * ss + 8 * g + (l15 >> 2)) * HG_RS_ + (16 * w + 4 * (l15 & 3)) * 2;
            const s16x4 lo = tr16(vp), hi = tr16(vp + 4 * HG_RS_); vf[ss] = (bf16x8){lo[0], lo[1], lo[2], lo[3], hi[0], hi[1], hi[2], hi[3]}; }
        f32x4 o[4];
        {
            bf16x8 sf[4];
#pragma unroll
            for (int ks = 0; ks < 4; ++ks) { u32x4 t4; t4.x = cvtpk(S[2 * ks][0], S[2 * ks][1]); t4.y = cvtpk(S[2 * ks][2], S[2 * ks][3]); t4.z = cvtpk(S[2 * ks + 1][0], S[2 * ks + 1][1]); t4.w = cvtpk(S[2 * ks + 1][2], S[2 * ks + 1][3]);
                sf[ks] = __builtin_bit_cast(bf16x8, t4); }
#pragma unroll
            for (int tb = 0; tb < 4; ++tb) { f32x4 acc = (f32x4){0.f, 0.f, 0.f, 0.f};
#pragma unroll
                for (int ks = 0; ks < 4; ++ks) { const LAS unsigned char* qp = lds + HG_QT + (16 * tb + l15) * HG_RS_ + (32 * ks + 4 * g) * 2;
                    const u32x2 q0 = *(const LAS u32x2*)qp, q1 = *(const LAS u32x2*)(qp + 32);
                    const u32x4 q4 = (u32x4){q0.x, q0.y, q1.x, q1.y};
                    acc = __builtin_amdgcn_mfma_f32_16x16x32_bf16(__builtin_bit_cast(bf16x8, q4), sf[ks], acc, 0, 0, 0); }
#pragma unroll
                for (int ss = 0; ss < 2; ++ss) { const bf16x8 af = *(const LAS bf16x8*)(lds + HG_SC + (16 * tb + l15) * HG_SCS + (32 * ss + 8 * g) * 2);
                    acc = __builtin_amdgcn_mfma_f32_16x16x32_bf16(af, vf[ss], acc, 0, 0, 0); }
                o[tb] = acc; }
        }
#pragma unroll
        for (int kb = 0; kb < 8; ++kb) {
#pragma unroll
            for (int ss = 0; ss < 2; ++ss) { const LAS unsigned char* kp = lds + HG_KT + (32 * ss + 8 * g + (l15 >> 2)) * HG_RS_ + (16 * kb + 4 * (l15 & 3)) * 2;
                const s16x4 lo = tr16(kp), hi = tr16(kp + 4 * HG_RS_); const bf16x8 af = (bf16x8){lo[0], lo[1], lo[2], lo[3], hi[0], hi[1], hi[2], hi[3]};
                S[kb] = __builtin_amdgcn_mfma_f32_16x16x32_bf16(af, vf[ss], S[kb], 0, 0, 0); }
            const f32x4 el = *(const LAS f32x4*)(lds + HG_EL + (16 * kb + 4 * g) * 4);
            S[kb] = S[kb] * el; }
#pragma unroll
        for (int tb = 0; tb < 4; ++tb)
#pragma unroll
            for (int r = 0; r < 4; ++r) *(LAS unsigned short*)(lds + HG_OUT + (16 * tb + 4 * g + r) * HG_RS_ + (16 * w + l15) * 2) = (unsigned short)(cvtpk(o[tb][r], 0.f) & 0xffffu);
        __syncthreads();
#pragma unroll
        for (int i = 0; i < 2; ++i) { const int q = tid + 512 * i, row = q >> 4, ch = q & 15;
            const u32x4 ov = *(const LAS u32x4*)(lds + HG_OUT + row * HG_RS_ + ch * 16);
            float x[8]; x[0] = bflo(ov.x); x[1] = bfhi(ov.x); x[2] = bflo(ov.y); x[3] = bfhi(ov.y); x[4] = bflo(ov.z); x[5] = bfhi(ov.z); x[6] = bflo(ov.w); x[7] = bfhi(ov.w);
            float ss = 0.f;
#pragma unroll
            for (int j = 0; j < 8; ++j) ss += x[j] * x[j];
            ss = row_sum(ss);
            const float rr = __builtin_amdgcn_rsqf(ss * (1.f / 128.f) + EPS);
            const u32x4 gv = gsr[i];
            u32x4 yo;
            yo.x = cvtpk(x[0] * rr * ngc[0] * bflo(gv.x), x[1] * rr * ngc[1] * bfhi(gv.x)); yo.y = cvtpk(x[2] * rr * ngc[2] * bflo(gv.y), x[3] * rr * ngc[3] * bfhi(gv.y));
            yo.z = cvtpk(x[4] * rr * ngc[4] * bflo(gv.z), x[5] * rr * ngc[5] * bfhi(gv.z)); yo.w = cvtpk(x[6] * rr * ngc[6] * bflo(gv.w), x[7] * rr * ngc[7] * bfhi(gv.w));
            *(u32x4*)(Y + (size_t)(c * 64 + row) * D + ch * 8) = yo; }
        if (c + 1 < SEQ / 64) HG_STORE();
        if (wdo) wconv_store(a, wv, wit, lane, lds + EPI_SCR + w * 2048);
    }
    __syncthreads();
#undef HG_LOAD
#undef HG_STORE
}

constexpr int AT_BUF = 32768, AT_LUT = MISC_OFF + 4096, AT_WS = MISC_OFF + 6144, AT_TKT = MISC_OFF + 8192;
__device__ __forceinline__ int crow(int r, int hi) { return (r & 3) + 8 * (r >> 2) + 4 * hi; }
__device__ __forceinline__ int t5_bucket(int n) {
    if (n < 16) return n;
    int b = 16;
    b += (n >= 19); b += (n >= 21); b += (n >= 24); b += (n >= 27); b += (n >= 31); b += (n >= 35); b += (n >= 40); b += (n >= 46);
    b += (n >= 52); b += (n >= 59); b += (n >= 67); b += (n >= 77); b += (n >= 87); b += (n >= 99); b += (n >= 113);
    return b;
}
__device__ __forceinline__ float fmax_nc(float x, float y) { return __builtin_amdgcn_fmed3f(x, y, INFINITY); }
#define AT_SB() __builtin_amdgcn_sched_barrier(0)

__device__ __forceinline__ void at_qk(f32x16& p0, f32x16& p1, const LAS unsigned char* kb, const bf16x8 (&qf)[4]) {
    bf16x8 kf[8];
#pragma unroll
    for (int d0 = 0; d0 < 4; ++d0) { kf[2 * d0] = *(const LAS bf16x8*)(kb + d0 * 2048); kf[2 * d0 + 1] = *(const LAS bf16x8*)(kb + d0 * 2048 + 512); }
#pragma unroll
    for (int r = 0; r < 16; ++r) { p0[r] = 0.f; p1[r] = 0.f; }
#pragma unroll
    for (int d0 = 0; d0 < 4; ++d0) { p0 = __builtin_amdgcn_mfma_f32_32x32x16_bf16(kf[2 * d0], qf[d0], p0, 0, 0, 0); p1 = __builtin_amdgcn_mfma_f32_32x32x16_bf16(kf[2 * d0 + 1], qf[d0], p1, 0, 0, 0); }
}
__device__ __forceinline__ bf16x8 at_vfrag(const LAS unsigned char* vb, int db, int ks) {
    const s16x4 lo = tr16(vb + db * 4096 + ks * 1024), hh = tr16(vb + db * 4096 + ks * 1024 + 512);
    return (bf16x8){lo[0], lo[1], lo[2], lo[3], hh[0], hh[1], hh[2], hh[3]};
}
__device__ __forceinline__ bf16x8 at_kfrag(const LAS unsigned char* kb, int i) { return *(const LAS bf16x8*)(kb + (i >> 1) * 2048 + (i & 1) * 512); }
__device__ __forceinline__ float at_rowmax(const f32x16& c0, const f32x16& c1) {
    float a, b2;
    asm volatile("s_nop 15\n\ts_nop 7\n\tv_max3_f32 %0, %1, %2, %3" : "=v"(a) : "v"(c0[0]), "v"(c0[1]), "v"(c1[0]));
    asm volatile("v_max3_f32 %0, %1, %2, %3" : "=v"(b2) : "v"(c0[2]), "v"(c0[3]), "v"(c1[1]));
    asm volatile("v_max3_f32 %0, %1, %2, %3" : "=v"(a) : "v"(a), "v"(c1[2]), "v"(c1[3]));
#pragma unroll
    for (int r = 4; r < 16; r += 4) {
        asm volatile("v_max3_f32 %0, %1, %2, %3" : "=v"(a) : "v"(a), "v"(c0[r]), "v"(c0[r + 1]));
        asm volatile("v_max3_f32 %0, %1, %2, %3" : "=v"(b2) : "v"(b2), "v"(c0[r + 2]), "v"(c0[r + 3]));
        asm volatile("v_max3_f32 %0, %1, %2, %3" : "=v"(a) : "v"(a), "v"(c1[r]), "v"(c1[r + 1]));
        asm volatile("v_max3_f32 %0, %1, %2, %3" : "=v"(b2) : "v"(b2), "v"(c1[r + 2]), "v"(c1[r + 3]));
    }
    float m;
    asm volatile("v_max_f32_e32 %0, %1, %2" : "=v"(m) : "v"(a), "v"(b2));
    return fmaxf(m, __shfl_xor(m, 32));
}
constexpr float AT_THR = 6.0f;
#define AT_PK2(P, i) cvtpk(P[i], P[i + 1])

__device__ __forceinline__ void at_step(f32x16& C0, f32x16& C1, const f32x16& P0, const f32x16& P1, f32x16 (&O)[4], const bf16x8 (&qf)[4],
                                        const __amdgpu_buffer_rsrc_t prs, const unsigned k_voff, const unsigned v_voff, const unsigned so0, u32x4 (&pk)[2], u32x4 (&pv)[2],
                                        const LAS unsigned char* kb, const LAS unsigned char* vbp, const LAS unsigned char* kbn,
                                        float& mhat, float& l_reg, bool& resc, const LAS float* lut, bool band, LAS float* wsf, int r32, int hi) {
    bf16x8 va[4], vb[4];
    u32x4 pw0, pw1, pw2, pw3;
    float sacc = 0.f;
    f32x16 z16;
#pragma unroll
    for (int r = 0; r < 16; ++r) z16[r] = 0.f;
    bf16x8 k0 = at_kfrag(kb, 0), k1 = at_kfrag(kb, 1);
    __builtin_amdgcn_s_setprio(1);
    C0 = __builtin_amdgcn_mfma_f32_32x32x16_bf16(k0, qf[0], z16, 0, 0, 0); k0 = at_kfrag(kb, 2); va[0] = at_vfrag(vbp, 0, 0);
    sacc += (P0[0] + P0[1]) + (P0[2] + P0[3]); pw0.x = AT_PK2(P0, 0); pw0.y = AT_PK2(P0, 2); AT_SB();
    C1 = __builtin_amdgcn_mfma_f32_32x32x16_bf16(k1, qf[0], z16, 0, 0, 0); k1 = at_kfrag(kb, 3); va[1] = at_vfrag(vbp, 0, 1);
    sacc += (P0[4] + P0[5]) + (P0[6] + P0[7]); pw0.z = AT_PK2(P0, 4); pw0.w = AT_PK2(P0, 6); AT_SB();
    C0 = __builtin_amdgcn_mfma_f32_32x32x16_bf16(k0, qf[1], C0, 0, 0, 0); k0 = at_kfrag(kb, 4); va[2] = at_vfrag(vbp, 0, 2);
    sacc += (P0[8] + P0[9]) + (P0[10] + P0[11]); pw1.x = AT_PK2(P0, 8); pw1.y = AT_PK2(P0, 10); AT_SB();
    C1 = __builtin_amdgcn_mfma_f32_32x32x16_bf16(k1, qf[1], C1, 0, 0, 0); k1 = at_kfrag(kb, 5); va[3] = at_vfrag(vbp, 0, 3);
    sacc += (P0[12] + P0[13]) + (P0[14] + P0[15]); pw1.z = AT_PK2(P0, 12); pw1.w = AT_PK2(P0, 14); AT_SB();
    C0 = __builtin_amdgcn_mfma_f32_32x32x16_bf16(k0, qf[2], C0, 0, 0, 0); k0 = at_kfrag(kb, 6);
    sacc += (P1[0] + P1[1]) + (P1[2] + P1[3]); pw2.x = AT_PK2(P1, 0); pw2.y = AT_PK2(P1, 2); AT_SB();
    C1 = __builtin_amdgcn_mfma_f32_32x32x16_bf16(k1, qf[2], C1, 0, 0, 0); k1 = at_kfrag(kb, 7);
    sacc += (P1[4] + P1[5]) + (P1[6] + P1[7]); pw2.z = AT_PK2(P1, 4); pw2.w = AT_PK2(P1, 6); AT_SB();
    C0 = __builtin_amdgcn_mfma_f32_32x32x16_bf16(k0, qf[3], C0, 0, 0, 0);
    sacc += (P1[8] + P1[9]) + (P1[10] + P1[11]); pw3.x = AT_PK2(P1, 8); pw3.y = AT_PK2(P1, 10); AT_SB();
    C1 = __builtin_amdgcn_mfma_f32_32x32x16_bf16(k1, qf[3], C1, 0, 0, 0);
    sacc += (P1[12] + P1[13]) + (P1[14] + P1[15]); pw3.z = AT_PK2(P1, 12); pw3.w = AT_PK2(P1, 14); AT_SB();
    { bf16x8 kone, qneg;
      { u32x4 t4 = (u32x4){0u, 0u, 0u, 0u}; if (hi == 0) t4.x = 0x3F80u; kone = __builtin_bit_cast(bf16x8, t4);
        t4.x = 0u; if (hi == 0) t4.x = cvtpk(-mhat, 0.f) & 0xffffu; qneg = __builtin_bit_cast(bf16x8, t4); }
      C0 = __builtin_amdgcn_mfma_f32_32x32x16_bf16(kone, qneg, C0, 0, 0, 0);
      C1 = __builtin_amdgcn_mfma_f32_32x32x16_bf16(kone, qneg, C1, 0, 0, 0); } AT_SB();
    pk[0] = __builtin_bit_cast(u32x4, __builtin_amdgcn_raw_buffer_load_b128(prs, k_voff, so0, 0)); pv[0] = __builtin_bit_cast(u32x4, __builtin_amdgcn_raw_buffer_load_b128(prs, v_voff, so0, 0));
    pk[1] = __builtin_bit_cast(u32x4, __builtin_amdgcn_raw_buffer_load_b128(prs, k_voff, so0 + 32u * 512u, 0)); pv[1] = __builtin_bit_cast(u32x4, __builtin_amdgcn_raw_buffer_load_b128(prs, v_voff, so0 + 32u * 512u, 0));
    l_reg += sacc;
    __builtin_amdgcn_s_setprio(0);
    if (band) {
#pragma unroll
        for (int r = 0; r < 16; ++r) { const int ko = (r & 3) + 8 * (r >> 2); C0[r] += lut[-ko]; C1[r] += lut[-ko - 32]; }
    }
    const float rm = at_rowmax(C0, C1);
    resc = false;
    if (__any(rm > AT_THR)) {
        const float m_new = bf2f((unsigned short)(cvtpk(mhat + fmaxf(rm, 0.f), 0.f) & 0xffffu));
        const float dl = m_new - mhat;
        const float f = fast_exp2(-dl);
        l_reg *= f; if (hi == 0) wsf[r32] = f; mhat = m_new; resc = true;
#pragma unroll
        for (int r = 0; r < 16; ++r) { C0[r] -= dl; C1[r] -= dl; }
    }
    AT_SB();
    __builtin_amdgcn_s_setprio(1);
    const bf16x8 pa0 = __builtin_bit_cast(bf16x8, pw0), pa1 = __builtin_bit_cast(bf16x8, pw1), pa2 = __builtin_bit_cast(bf16x8, pw2), pa3 = __builtin_bit_cast(bf16x8, pw3);
#define AT_EX2(X, i) do { X[i] = fast_exp2(X[i]); X[i + 1] = fast_exp2(X[i + 1]); } while (0)
    O[0] = __builtin_amdgcn_mfma_f32_32x32x16_bf16(pa0, va[0], O[0], 0, 0, 0); vb[0] = at_vfrag(vbp, 1, 0); AT_EX2(C0, 0); AT_SB();
    O[0] = __builtin_amdgcn_mfma_f32_32x32x16_bf16(pa1, va[1], O[0], 0, 0, 0); vb[1] = at_vfrag(vbp, 1, 1); AT_EX2(C0, 2); AT_SB();
    O[0] = __builtin_amdgcn_mfma_f32_32x32x16_bf16(pa2, va[2], O[0], 0, 0, 0); vb[2] = at_vfrag(vbp, 1, 2); AT_EX2(C0, 4); AT_SB();
    O[0] = __builtin_amdgcn_mfma_f32_32x32x16_bf16(pa3, va[3], O[0], 0, 0, 0); vb[3] = at_vfrag(vbp, 1, 3); AT_EX2(C0, 6); AT_SB();
    O[1] = __builtin_amdgcn_mfma_f32_32x32x16_bf16(pa0, vb[0], O[1], 0, 0, 0); va[0] = at_vfrag(vbp, 2, 0); AT_EX2(C0, 8); AT_SB();
    O[1] = __builtin_amdgcn_mfma_f32_32x32x16_bf16(pa1, vb[1], O[1], 0, 0, 0); va[1] = at_vfrag(vbp, 2, 1); AT_EX2(C0, 10); AT_SB();
    O[1] = __builtin_amdgcn_mfma_f32_32x32x16_bf16(pa2, vb[2], O[1], 0, 0, 0); va[2] = at_vfrag(vbp, 2, 2); AT_EX2(C0, 12); AT_SB();
    O[1] = __builtin_amdgcn_mfma_f32_32x32x16_bf16(pa3, vb[3], O[1], 0, 0, 0); va[3] = at_vfrag(vbp, 2, 3); AT_EX2(C0, 14); AT_SB();
    O[2] = __builtin_amdgcn_mfma_f32_32x32x16_bf16(pa0, va[0], O[2], 0, 0, 0); vb[0] = at_vfrag(vbp, 3, 0); AT_EX2(C1, 0); AT_SB();
    O[2] = __builtin_amdgcn_mfma_f32_32x32x16_bf16(pa1, va[1], O[2], 0, 0, 0); vb[1] = at_vfrag(vbp, 3, 1); AT_EX2(C1, 2); AT_SB();
    O[2] = __builtin_amdgcn_mfma_f32_32x32x16_bf16(pa2, va[2], O[2], 0, 0, 0); vb[2] = at_vfrag(vbp, 3, 2); AT_EX2(C1, 4); AT_SB();
    O[2] = __builtin_amdgcn_mfma_f32_32x32x16_bf16(pa3, va[3], O[2], 0, 0, 0); vb[3] = at_vfrag(vbp, 3, 3); AT_EX2(C1, 6); AT_SB();
    O[3] = __builtin_amdgcn_mfma_f32_32x32x16_bf16(pa0, vb[0], O[3], 0, 0, 0); AT_EX2(C1, 8); AT_SB();
    O[3] = __builtin_amdgcn_mfma_f32_32x32x16_bf16(pa1, vb[1], O[3], 0, 0, 0); AT_EX2(C1, 10); AT_SB();
    O[3] = __builtin_amdgcn_mfma_f32_32x32x16_bf16(pa2, vb[2], O[3], 0, 0, 0); AT_EX2(C1, 12); AT_SB();
    O[3] = __builtin_amdgcn_mfma_f32_32x32x16_bf16(pa3, vb[3], O[3], 0, 0, 0); AT_EX2(C1, 14); AT_SB();
    __builtin_amdgcn_s_setprio(0);
#undef AT_EX2
}
__device__ __forceinline__ void at_rescale(f32x16 (&O)[4], const LAS float* wsf, int hi) {
#pragma unroll
    for (int gq = 0; gq < 4; ++gq) { const f32x4 al = *(const LAS f32x4*)(wsf + 8 * gq + 4 * hi);
#pragma unroll
        for (int db = 0; db < 4; ++db) { O[db][4 * gq + 0] *= al.x; O[db][4 * gq + 1] *= al.y; O[db][4 * gq + 2] *= al.z; O[db][4 * gq + 3] *= al.w; } }
}

__device__ __forceinline__ void attn_unit(const Frame& F, const Args& a, int bh, int qb, float lam) {
    const int b = bh >> 2, h = bh & 3;
    const bf16* KVb = (const bf16*)(a.ws + WS_KV) + (size_t)bh * SEQ * 256;
    const bf16* QCb = (const bf16*)(a.ws + WS_QC) + (size_t)bh * SEQ * 128;
    LAS unsigned char* lds = F.lds;
    int tid = F.tid; asm volatile("" : "+v"(tid));
    const int lane = tid & 63, w = F.wave, wq = w & 3, mc = w >> 2, r32 = lane & 31, hi = lane >> 5;
    const int q0 = qb * 128, NT = 2 * qb + 2;
    LAS float* wsf = (LAS float*)(lds + AT_WS + 256 * w);
    const int k_kv = ((tid >> 7) << 3) + (tid & 7), k_ch = (tid >> 3) & 15;
    const int k_lds = (k_ch >> 3) * 8192 + (k_ch & 7) * 1024 + k_kv * 16;
    const unsigned k_voff = (unsigned)(k_kv * 256 + k_ch * 8) * 2u;
    const int v_kv = (((tid >> 5) & 15) << 1) + ((tid >> 2) & 1), v_ch = (((tid >> 3) & 3) << 2) + (tid & 3);
    const int v_lds = 16384 + (v_ch >> 2) * 4096 + v_kv * 64 + (v_ch & 3) * 16;
    const unsigned v_voff = (unsigned)(v_kv * 256 + 128 + v_ch * 8) * 2u;
    const __amdgpu_buffer_rsrc_t prs = __builtin_amdgcn_make_buffer_rsrc((void*)KVb, (short)0, SEQ * 512, 0x00020000);
    u32x4 pk[2], pv[2];
#define AT_LOAD(j) do { _Pragma("unroll") for (int i = 0; i < 2; ++i) { const unsigned so = (unsigned)(((j) * 64 + 32 * i) * 512); \
        pk[i] = __builtin_bit_cast(u32x4, __builtin_amdgcn_raw_buffer_load_b128(prs, k_voff, so, 0)); pv[i] = __builtin_bit_cast(u32x4, __builtin_amdgcn_raw_buffer_load_b128(prs, v_voff, so, 0)); } } while (0)
#define AT_STORE(bufo) do { _Pragma("unroll") for (int i = 0; i < 2; ++i) { *(LAS u32x4*)(lds + (bufo) + k_lds + 32 * 16 * i) = pk[i]; *(LAS u32x4*)(lds + (bufo) + v_lds + 32 * 64 * i) = pv[i]; } } while (0)
    bf16x8 qf[4];
    { const bf16* qp = QCb + (size_t)(q0 + 32 * wq + r32) * 128 + mc * 64 + 8 * hi;
#pragma unroll
      for (int d0 = 0; d0 < 4; ++d0) qf[d0] = *(const bf16x8*)(qp + 16 * d0); }
    f32x16 O[4];
#pragma unroll
    for (int db = 0; db < 4; ++db)
#pragma unroll
        for (int r = 0; r < 16; ++r) O[db][r] = 0.f;
    float mhat = -INFINITY, l_reg = 0.f;
    {
        u32x4 qk[3][2], qv[3][2]; const int j2 = NT > 2 ? 2 : 1;
#pragma unroll
        for (int tl = 0; tl < 3; ++tl) { const int jt = tl < 2 ? tl : j2;
#pragma unroll
            for (int i = 0; i < 2; ++i) { const unsigned so = (unsigned)((jt * 64 + 32 * i) * 512);
                qk[tl][i] = __builtin_bit_cast(u32x4, __builtin_amdgcn_raw_buffer_load_b128(prs, k_voff, so, 0)); qv[tl][i] = __builtin_bit_cast(u32x4, __builtin_amdgcn_raw_buffer_load_b128(prs, v_voff, so, 0)); } }
#pragma unroll
        for (int tl = 0; tl < 3; ++tl)
#pragma unroll
            for (int i = 0; i < 2; ++i) { *(LAS u32x4*)(lds + tl * AT_BUF + k_lds + 32 * 16 * i) = qk[tl][i]; *(LAS u32x4*)(lds + tl * AT_BUF + v_lds + 32 * 64 * i) = qv[tl][i]; }
    }
    __syncthreads();
    const int koff = mc * 8192 + hi * 1024 + r32 * 16;
    const int voff = 16384 + ((lane >> 4) & 1) * 32 + (lane & 3) * 8 + (4 * hi + ((lane & 15) >> 2)) * 64;
    const LAS float* lutp = (const LAS float*)(lds + AT_LUT) + (q0 + 32 * wq + r32 + 127 - 4 * hi);
    f32x16 pA0, pA1, pB0, pB1;
    at_qk(pA0, pA1, lds + koff, qf);
    if (0 >= NT - 4) {
#pragma unroll
        for (int r = 0; r < 16; ++r) { const int ko = (r & 3) + 8 * (r >> 2); pA0[r] += lutp[-ko]; pA1[r] += lutp[-ko - 32]; }
    }
    mhat = bf2f((unsigned short)(cvtpk(at_rowmax(pA0, pA1), 0.f) & 0xffffu));
#pragma unroll
    for (int r = 0; r < 16; ++r) { pA0[r] = fast_exp2(pA0[r] - mhat); pA1[r] = fast_exp2(pA1[r] - mhat); }
    bool resc = false;
#define AT_SLOT(t) (((t) & 3) * AT_BUF)
#define AT_STEP(CA, CB, PA, PB, t) do { const int jl_ = ((t) + 2 < NT) ? (t) + 2 : NT - 1; \
        at_step(CA, CB, PA, PB, O, qf, prs, k_voff, v_voff, (unsigned)(jl_ * 64 * 512), pk, pv, lds + AT_SLOT(t) + koff, lds + AT_SLOT((t) - 1) + voff, lds + AT_SLOT((t) + 1) + koff, mhat, l_reg, resc, lutp - 64 * (t), (t) >= NT - 4, wsf, r32, hi); \
        AT_STORE(AT_SLOT((t) + 2)); __syncthreads(); if (resc) at_rescale(O, wsf, hi); } while (0)
    int t = 1;
    for (; t + 1 < NT; t += 2) { AT_STEP(pB0, pB1, pA0, pA1, t); AT_STEP(pA0, pA1, pB0, pB1, t + 1); }
    AT_STEP(pB0, pB1, pA0, pA1, t);
    {
        float sacc = 0.f;
#pragma unroll
        for (int r = 0; r < 16; ++r) sacc += pB0[r] + pB1[r];
        l_reg += sacc;
        u32x4 q4; bf16x8 pa[4];
        q4.x = AT_PK2(pB0, 0); q4.y = AT_PK2(pB0, 2); q4.z = AT_PK2(pB0, 4); q4.w = AT_PK2(pB0, 6); pa[0] = __builtin_bit_cast(bf16x8, q4);
        q4.x = AT_PK2(pB0, 8); q4.y = AT_PK2(pB0, 10); q4.z = AT_PK2(pB0, 12); q4.w = AT_PK2(pB0, 14); pa[1] = __builtin_bit_cast(bf16x8, q4);
        q4.x = AT_PK2(pB1, 0); q4.y = AT_PK2(pB1, 2); q4.z = AT_PK2(pB1, 4); q4.w = AT_PK2(pB1, 6); pa[2] = __builtin_bit_cast(bf16x8, q4);
        q4.x = AT_PK2(pB1, 8); q4.y = AT_PK2(pB1, 10); q4.z = AT_PK2(pB1, 12); q4.w = AT_PK2(pB1, 14); pa[3] = __builtin_bit_cast(bf16x8, q4);
        const LAS unsigned char* vbp = lds + AT_SLOT(NT - 1) + voff;
#pragma unroll
        for (int db = 0; db < 4; ++db)
#pragma unroll
            for (int ks = 0; ks < 4; ++ks) O[db] = __builtin_amdgcn_mfma_f32_32x32x16_bf16(pa[ks], at_vfrag(vbp, db, ks), O[db], 0, 0, 0);
    }
    __syncthreads();
    l_reg = sum_x32(l_reg, l_reg);
    { const float sc = (mc == 0 ? 1.f : lam) * fast_rcp(l_reg);
      if (hi == 0) wsf[r32] = sc;
      at_rescale(O, wsf, hi); }
    LAS float* ex = (LAS float*)lds + (mc * 4 + wq) * 4096;
#pragma unroll
    for (int db = 0; db < 4; ++db)
#pragma unroll
        for (int r = 0; r < 16; ++r) ex[crow(r, hi) * 128 + 32 * db + r32] = O[db][r];
    __syncthreads();
    {
        const int l15 = lane & 15, lr = lane >> 4;
        float gv[8];
        { const float* sg = a.in[11] + 8 * l15;
#pragma unroll
          for (int i = 0; i < 8; ++i) gv[i] = sg[i] * 0.8f; }
        bf16* Y = (bf16*)(a.ws + WS_Y) + (size_t)(b * SEQ + q0) * D + h * 128 + 8 * l15;
#pragma unroll
        for (int p = 0; p < 4; ++p) { const int R = 16 * w + 4 * p + lr;
            const LAS float* pa = (const LAS float*)lds + (R >> 5) * 4096 + (R & 31) * 128 + 8 * l15; const LAS float* pb = pa + 4 * 4096;
            const f32x4 a0 = *(const LAS f32x4*)pa, a1 = *(const LAS f32x4*)(pa + 4), b0 = *(const LAS f32x4*)pb, b1 = *(const LAS f32x4*)(pb + 4);
            const f32x4 o0 = a0 - b0, o1 = a1 - b1;
            float ss = (o0.x * o0.x + o0.y * o0.y) + (o0.z * o0.z + o0.w * o0.w) + (o1.x * o1.x + o1.y * o1.y) + (o1.z * o1.z + o1.w * o1.w);
            ss = row_sum(ss);
            const float rr = __builtin_amdgcn_rsqf(ss * (1.f / 128.f) + EPS);
            u32x4 yo;
            yo.x = cvtpk(o0.x * rr * gv[0], o0.y * rr * gv[1]); yo.y = cvtpk(o0.z * rr * gv[2], o0.w * rr * gv[3]);
            yo.z = cvtpk(o1.x * rr * gv[4], o1.y * rr * gv[5]); yo.w = cvtpk(o1.z * rr * gv[6], o1.w * rr * gv[7]);
            *(u32x4*)(Y + (size_t)R * D) = yo; }
    }
    __syncthreads();
#undef AT_LOAD
#undef AT_STORE
#undef AT_SLOT
#undef AT_STEP
}

__device__ __forceinline__ void p2_mixers(const Frame& F, const Args& a) {
    float lam;
    { const float v1 = a.in[7][F.lane] * a.in[8][F.lane], v2 = a.in[9][F.lane] * a.in[10][F.lane];
      lam = __expf(wave_sum(v1)) - __expf(wave_sum(v2)) + 0.2f; }
    const int per = F.G / 32;
    if (per < 1) return;
    const int bh = F.vcu / per, s = F.vcu % per;
    if (bh >= 32) return;
    { const int h = bh & 3; const float* tab = a.in[12]; const float t31 = tab[31 * 4 + h];
      for (int i = F.tid; i < 384; i += NTHREADS) { const int dist = i - 127; ((LAS float*)(F.lds + AT_LUT))[i] = dist < 0 ? -INFINITY : (tab[t5_bucket(dist) * 4 + h] - t31) * LOG2E; } }
    if (s == 0) hgrn_stream(F, a, bh);
    constexpr int NDYN = 14;
    if (s >= 1) {
        const int na = per - 1;
        for (int k = 0; k * na < 64 - NDYN; ++k) {
            const int idx = k * na + ((k & 1) ? (na - s) : (s - 1));
            if (idx < 64 - NDYN) attn_unit(F, a, bh, 63 - idx, lam);
        }
    }
    {
        unsigned* qhead = (unsigned*)(a.ws + WS_CTL) + CW_Q + 64 * bh;
        LAS unsigned* tk = (LAS unsigned*)(F.lds + AT_TKT);
        for (;;) {
            if (F.tid == 0) *tk = __hip_atomic_fetch_add(qhead, 1u, __ATOMIC_RELAXED, __HIP_MEMORY_SCOPE_AGENT);
            __syncthreads();
            const unsigned t = *tk;
            __syncthreads();
            if (t >= (unsigned)NDYN) break;
            attn_unit(F, a, bh, NDYN - 1 - (int)t, lam);
        }
    }
}

constexpr int RT_W = 0, RT_HIST = 73728, RT_BASE = 73856;
__device__ __forceinline__ void p4_router(const Frame& F, const Args& a) {
    LAS unsigned char* lds = F.lds;
    const float* wg = a.in[16]; const float* bg = a.in[17]; const float* we = a.in[18]; const float* be = a.in[19];
    for (int i = F.tid; i < 4 * 1024; i += NTHREADS) { const int d = i >> 2, e = i & 3;
        ((LAS unsigned short*)(lds + RT_W))[e * 1024 + d] = (unsigned short)(cvtpk(wg[i], 0.f) & 0xffffu); }
    for (int i = F.tid; i < 32 * 1024; i += NTHREADS) { const int d = i >> 5, e = i & 31;
        ((LAS unsigned short*)(lds + RT_W))[(4 + e) * 1024 + d] = (unsigned short)(cvtpk(we[i], 0.f) & 0xffffu); }
    if (F.tid < 32) ((LAS unsigned*)(lds + RT_HIST))[F.tid] = 0u;
    __syncthreads();
    const bf16* x1 = (const bf16*)(a.ws + WS_X1B); const float* ng = a.in[5]; const float* mod = (const float*)(a.ws + WS_MOD);
    bf16* H = (bf16*)(a.ws + WS_H);
    const int gw = F.vcu * NWAVES + F.wave, NGW = F.G * NWAVES, lane = F.lane;
    int my_tok = -1, my_e0 = 0, my_e1 = 0; float my_w0 = 0.f, my_w1 = 0.f;
    const int per = (NTOK + NGW - 1) / NGW;
    const int m0 = gw * per, m1 = (m0 + per < NTOK) ? m0 + per : NTOK;
    int it = 0;
    for (int s0 = m0; s0 < m1; ) {
      const int b = s0 >> 13, e1 = ((b + 1) << 13) < m1 ? ((b + 1) << 13) : m1;
      f32x4 ga[4], sha[4];
      { const f32x4* gp = (const f32x4*)ng + lane; const f32x4* shp = (const f32x4*)(mod + b * 6144 + 3072) + lane; const f32x4* scp = (const f32x4*)(mod + b * 6144 + 4096) + lane;
#pragma unroll
        for (int j = 0; j < 4; ++j) { ga[j] = gp[64 * j] * (scp[64 * j] + 1.f); sha[j] = shp[64 * j]; } }
      u32x2 nxv[4];
      { const u32x2* xr = (const u32x2*)(x1 + (size_t)s0 * D) + lane;
#pragma unroll
        for (int j = 0; j < 4; ++j) nxv[j] = xr[64 * j]; }
      for (int m = s0; m < e1; ++m, ++it) {
        f32x4 v[4]; float s = 0.f;
#pragma unroll
        for (int j = 0; j < 4; ++j) { const u32x2 xv = nxv[j]; v[j] = (f32x4){bflo(xv.x), bfhi(xv.x), bflo(xv.y), bfhi(xv.y)}; s += (v[j].x * v[j].x + v[j].y * v[j].y) + (v[j].z * v[j].z + v[j].w * v[j].w); }
        { const int mn = (m + 1 < e1) ? m + 1 : m; const u32x2* xr = (const u32x2*)(x1 + (size_t)mn * D) + lane;
#pragma unroll
          for (int j = 0; j < 4; ++j) nxv[j] = xr[64 * j]; }
        const float r = __builtin_amdgcn_rsqf(wave_sum(s) * (1.f / D) + EPS);
        u32x2* o8 = (u32x2*)(H + (size_t)m * D) + lane;
        u32x2 hp[4];
#pragma unroll
        for (int j = 0; j < 4; ++j) {
            v[j] = v[j] * r * ga[j] + sha[j];
            u32x2 o; o.x = cvtpk(v[j].x, v[j].y); o.y = cvtpk(v[j].z, v[j].w); o8[64 * j] = o; asm("" : "+v"(o.x), "+v"(o.y)); hp[j] = o; }
        asm volatile("" ::: "memory");
        float lg[4];
#pragma unroll
        for (int e = 0; e < 4; ++e) { float acc = 0.f;
#pragma unroll
            for (int j = 0; j < 4; ++j) { const u32x2 wv = *(const LAS u32x2*)(lds + RT_W + (e * 1024 + 256 * j + 4 * lane) * 2);
                acc = dot2bf(wv.x, hp[j].x, acc); acc = dot2bf(wv.y, hp[j].y, acc); }
            lg[e] = wave_sum(acc) + bg[e]; }
        int gi = 0; float gm = lg[0];
#pragma unroll
        for (int i = 1; i < 4; ++i) if (lg[i] > gm) { gm = lg[i]; gi = i; }
        gi = __builtin_amdgcn_readfirstlane(gi);
        float gs = 0.f;
#pragma unroll
        for (int i = 0; i < 4; ++i) gs += __expf(lg[i] - gm);
        const float gate = 1.f / gs;
        float pe[8];
        { const LAS unsigned char* wb_ = lds + RT_W + (size_t)(4 + gi * 8) * 2048;
#pragma unroll
          for (int e = 0; e < 8; ++e) { float acc = 0.f;
#pragma unroll
              for (int j = 0; j < 4; ++j) { const u32x2 wv = *(const LAS u32x2*)(wb_ + (e * 1024 + 256 * j + 4 * lane) * 2);
                  acc = dot2bf(wv.x, hp[j].x, acc); acc = dot2bf(wv.y, hp[j].y, acc); }
              pe[e] = acc; } }
        float t4[4], t2[2], t1;
#pragma unroll
        for (int i = 0; i < 4; ++i) t4[i] = sum_x32(pe[i], pe[i + 4]);
#pragma unroll
        for (int i = 0; i < 2; ++i) t2[i] = sum_x16(t4[i], t4[i + 2]);
        { const bool up = (lane & 8) != 0; const float keep = up ? t2[1] : t2[0], send = up ? t2[0] : t2[1]; t1 = keep + dppf<0x128>(send); }
        t1 += dppf<0xB1>(t1); t1 += dppf<0x4E>(t1); t1 += dppf<0x141>(t1);
        float el[8];
#pragma unroll
        for (int i = 0; i < 8; ++i) el[i] = __builtin_bit_cast(float, __builtin_amdgcn_readlane(__builtin_bit_cast(int, t1), 8 * ((i & 1) + 2 * ((i >> 1) & 1) + 4 * ((i >> 2) & 1)))) + be[gi * 8 + i];
        int ia = 0; float va = el[0];
#pragma unroll
        for (int i = 1; i < 8; ++i) if (el[i] > va) { va = el[i]; ia = i; }
        int ib = -1; float vb = -INFINITY;
#pragma unroll
        for (int i = 0; i < 8; ++i) if (i != ia && el[i] > vb) { vb = el[i]; ib = i; }
        const float wa = gate / (1.f + __expf(vb - va)), wb = gate - wa;
        if (lane == it) { my_tok = m; my_e0 = gi * 8 + ia; my_e1 = gi * 8 + ib; my_w0 = wa; my_w1 = wb; }
      }
      s0 = e1;
    }
    LAS unsigned* hist = (LAS unsigned*)(lds + RT_HIST); LAS unsigned* base = (LAS unsigned*)(lds + RT_BASE);
    unsigned r0 = 0, r1 = 0;
    if (my_tok >= 0) { r0 = atomicAdd((unsigned*)hist + my_e0, 1u); r1 = atomicAdd((unsigned*)hist + my_e1, 1u); }
    __syncthreads();
    unsigned* cnt = (unsigned*)(a.ws + WS_CTL) + CW_CNT;
    if (F.tid < 32) { const unsigned hv = hist[F.tid]; base[F.tid] = hv ? __hip_atomic_fetch_add(cnt + F.tid, hv, __ATOMIC_RELAXED, __HIP_MEMORY_SCOPE_AGENT) : 0u; }
    __syncthreads();
    if (my_tok >= 0) {
        int* list = (int*)(a.ws + WS_LIST); float* tw = (float*)(a.ws + WS_TOKW);
        const int p0_ = (int)(base[my_e0] + r0), p1_ = (int)(base[my_e1] + r1);
        list[(size_t)my_e0 * NTOK + p0_] = my_tok * 2;
        list[(size_t)my_e1 * NTOK + p1_] = my_tok * 2 + 1;
        tw[my_tok * 2] = my_w0; tw[my_tok * 2 + 1] = my_w1;
        int* toks = (int*)(a.ws + WS_TOKS);
        toks[my_tok * 2] = (my_e0 << 20) | p0_; toks[my_tok * 2 + 1] = (my_e1 << 20) | p1_;
    }
}

constexpr int MOE_CNTL = MISC_OFF + 256, MOE_LTOK = MISC_OFF + 4096, MOE_MAXU = 12;
struct MoeOrder {
    const LAS int* pre; const LAS int* cntl; const LAS int* ltok; const int* list; int G, c, lane; bool gather;
    __device__ __forceinline__ bool next(int i, pg8::Unit& u) const {
        const int total = pre[32];
        int rt, pn;
        if (G == 256) {
            rt = (i * 8 + (c & 7)) * 8 + ((c >> 3) & 7); pn = c >> 6;
            if (rt >= total) return false;
        } else { const long L = (long)i * G + c; if (L >= (long)total * 4) return false; rt = (int)(L >> 2); pn = (int)(L & 3); }
        const int e = __builtin_popcountll(__ballot(pre[(lane & 31) + 1] <= rt) & 0xffffffffull);
        u.e = e; u.pm = rt; u.pn = e * 4 + pn; u.r0 = (rt - pre[e]) * 256; const int n = cntl[e] - u.r0; u.nrows = n < 256 ? n : 256; u.slot = i; return true;
    }
    __device__ __forceinline__ int arow(const pg8::Unit& u, int r) const {
        if (!gather) return u.pm * 256 + r;
        if (u.slot < MOE_MAXU) return ltok[u.slot * 256 + r];
        return r < u.nrows ? (list[(size_t)u.e * NTOK + u.r0 + r] >> 1) : 0;
    }
};
struct EpiSwiGLU {
    static constexpr bool PERM = true;
    static constexpr int NST = 8;
    bf16* act;
    LAS unsigned char* scr;
    __device__ __forceinline__ void operator()(const f32x4 (&acc)[2][2][4][2], const pg8::Unit& u, int wr, int wc, int fr, int fq) const {
        LAS unsigned char* ws_ = scr + (wr * 4 + wc) * 2048;
        const int l = fr + 16 * fq, r8 = l >> 3, c8 = l & 7;
        bf16* base = act + (size_t)(u.pm * 256 + wr * 64 + (c8 >> 2) * 16 + r8) * FF + (u.pn & 3) * 128 + wc * 32 + 8 * (c8 & 3);
        u32x4 rq[2][2];
#pragma unroll
        for (int it = 0; it <= 4; ++it) {
            if (it < 4) { const int ai = it >> 1, m2 = it & 1; u32x4 w[2];
#pragma unroll
                for (int q = 0; q < 2; ++q) { const int m = 2 * m2 + q; const f32x4 a0 = acc[ai][0][m][0], a1 = acc[ai][0][m][1], b0 = acc[ai][1][m][0], b1 = acc[ai][1][m][1];
                    w[q].x = cvtpk(siluf_(a0.x) * b0.x, siluf_(a0.y) * b0.y); w[q].y = cvtpk(siluf_(a0.z) * b0.z, siluf_(a0.w) * b0.w);
                    w[q].z = cvtpk(siluf_(a1.x) * b1.x, siluf_(a1.y) * b1.y); w[q].w = cvtpk(siluf_(a1.z) * b1.z, siluf_(a1.w) * b1.w); }
                pg8::xpose128(ws_, fr, fq, w[0], w[1], rq[it & 1][0], rq[it & 1][1]); }
            if (it > 0) { const int ai = (it - 1) >> 1, m2 = (it - 1) & 1;
                bf16* rowp = base + (size_t)(ai * 128 + m2 * 32) * FF;
                *(u32x4*)rowp = rq[(it - 1) & 1][0]; *(u32x4*)(rowp + (size_t)8 * FF) = rq[(it - 1) & 1][1]; } }
    }
};
struct EpiScatter {
    static constexpr bool PERM = true;
    static constexpr int NST = 16;
    bf16* ybuf;
    LAS unsigned char* scr;
    __device__ __forceinline__ void operator()(const f32x4 (&acc)[2][2][4][2], const pg8::Unit& u, int wr, int wc, int fr, int fq) const {
        LAS unsigned char* ws_ = scr + (wr * 4 + wc) * 2048;
        const int l = fr + 16 * fq, r8 = l >> 3, c8 = l & 7;
        bf16* base = ybuf + (size_t)(u.pm * 256 + wr * 64 + r8) * D + (u.pn & 3) * 256 + wc * 64 + 8 * c8;
        u32x4 rq[2][2];
#pragma unroll
        for (int it = 0; it <= 8; ++it) {
            if (it < 8) { const int ai = it >> 2, m = it & 3; u32x4 w[2];
#pragma unroll
                for (int bj = 0; bj < 2; ++bj) { const f32x4 v0 = acc[ai][bj][m][0], v1 = acc[ai][bj][m][1];
                    w[bj].x = cvtpk(v0.x, v0.y); w[bj].y = cvtpk(v0.z, v0.w); w[bj].z = cvtpk(v1.x, v1.y); w[bj].w = cvtpk(v1.z, v1.w); }
                pg8::xpose128(ws_, fr, fq, w[0], w[1], rq[it & 1][0], rq[it & 1][1]); }
            if (it > 0) { const int ai = (it - 1) >> 2, m = (it - 1) & 3;
                bf16* rowp = base + (size_t)(ai * 128 + m * 16) * D;
                *(u32x4*)rowp = rq[(it - 1) & 1][0]; *(u32x4*)(rowp + (size_t)8 * D) = rq[(it - 1) & 1][1]; } }
    }
};

__device__ __forceinline__ void p7_final(const Frame& F, const Args& a) {
    float* out = a.out; const float* fg = a.in[23]; const float* mod = (const float*)(a.ws + WS_MOD);
    const bf16* yb = (const bf16*)(a.ws + WS_YBUF); const float* tw = (const float*)(a.ws + WS_TOKW); const int* toks = (const int*)(a.ws + WS_TOKS); const bf16* x1b = (const bf16*)(a.ws + WS_X1B);
    const int gw = F.vcu * NWAVES + F.wave, NGW = F.G * NWAVES, lane = F.lane;
    const int per = (NTOK + NGW - 1) / NGW;
    const int m0 = gw * per, m1 = (m0 + per < NTOK) ? m0 + per : NTOK;
    if (m0 >= NTOK) return;
    const int prev = ((const LAS int*)(F.lds + MISC_OFF))[lane & 31];
    u32x4 nx[2], ny0[2], ny1[2];
#define P7_ROW(sv) (__builtin_amdgcn_readlane(prev, (sv) >> 20) * 256 + ((sv) & 0xFFFFF))
#define P7_LOAD(mm, ra, rb) do { _Pragma("unroll") for (int j = 0; j < 2; ++j) { nx[j] = *((const u32x4*)(x1b + (size_t)(mm) * D) + lane + 64 * j); \
        ny0[j] = *((const u32x4*)(yb + (size_t)(ra) * D) + lane + 64 * j); ny1[j] = *((const u32x4*)(yb + (size_t)(rb) * D) + lane + 64 * j); } } while (0)
    f32x4 fgr[2][2];
#pragma unroll
    for (int j = 0; j < 2; ++j) { const f32x4* gp = (const f32x4*)(fg + 512 * j) + 2 * lane; fgr[j][0] = gp[0]; fgr[j][1] = gp[1]; }
    for (int s0 = m0; s0 < m1; ) {
        const int b = s0 >> 13; int e1 = ((b + 1) << 13) < m1 ? ((b + 1) << 13) : m1; if (e1 > s0 + 32) e1 = s0 + 32;
        const int nrow = e1 - s0;
        const int tv = (lane < 2 * nrow) ? toks[2 * s0 + lane] : 0; const float wv = (lane < 2 * nrow) ? tw[2 * s0 + lane] : 0.f;
        f32x4 g2r[2][2];
#pragma unroll
        for (int j = 0; j < 2; ++j) { const f32x4* g2p = (const f32x4*)(mod + b * 6144 + 5120 + 512 * j) + 2 * lane; g2r[j][0] = g2p[0]; g2r[j][1] = g2p[1]; }
        { const int sa = __builtin_amdgcn_readlane(tv, 0), sb = __builtin_amdgcn_readlane(tv, 1); P7_LOAD(s0, P7_ROW(sa), P7_ROW(sb)); }
        for (int i = 0; i < nrow; ++i) { const int m = s0 + i;
            u32x4 cx[2], cy0[2], cy1[2];
#pragma unroll
            for (int j = 0; j < 2; ++j) { cx[j] = nx[j]; cy0[j] = ny0[j]; cy1[j] = ny1[j]; }
            { const int in_ = (i + 1 < nrow) ? i + 1 : i; const int sa = __builtin_amdgcn_readlane(tv, 2 * in_), sb = __builtin_amdgcn_readlane(tv, 2 * in_ + 1); P7_LOAD(s0 + in_, P7_ROW(sa), P7_ROW(sb)); }
            const float w0 = __builtin_bit_cast(float, __builtin_amdgcn_readlane(__builtin_bit_cast(int, wv), 2 * i)), w1 = __builtin_bit_cast(float, __builtin_amdgcn_readlane(__builtin_bit_cast(int, wv), 2 * i + 1));
            float v[2][8]; float s = 0.f;
#pragma unroll
            for (int j = 0; j < 2; ++j) { const f32x4 ga = g2r[j][0], gb = g2r[j][1];
                const float g2[8] = {ga.x, ga.y, ga.z, ga.w, gb.x, gb.y, gb.z, gb.w};
                const unsigned xw[4] = {cx[j].x, cx[j].y, cx[j].z, cx[j].w}, aw[4] = {cy0[j].x, cy0[j].y, cy0[j].z, cy0[j].w}, bw[4] = {cy1[j].x, cy1[j].y, cy1[j].z, cy1[j].w};
#pragma unroll
                for (int k = 0; k < 4; ++k) { const float mm0 = w0 * bflo(aw[k]) + w1 * bflo(bw[k]), mm1 = w0 * bfhi(aw[k]) + w1 * bfhi(bw[k]);
                    v[j][2 * k] = bflo(xw[k]) + g2[2 * k] * mm0; v[j][2 * k + 1] = bfhi(xw[k]) + g2[2 * k + 1] * mm1;
                    s += v[j][2 * k] * v[j][2 * k] + v[j][2 * k + 1] * v[j][2 * k + 1]; } }
            const float r = __builtin_amdgcn_rsqf(wave_sum(s) * (1.f / D) + EPS);
#pragma unroll
            for (int j = 0; j < 2; ++j) { const f32x4 ga = fgr[j][0], gb = fgr[j][1];
                f32x4* op = (f32x4*)(out + (size_t)m * D + 512 * j) + 2 * lane;
                op[0] = (f32x4){v[j][0] * r * ga.x, v[j][1] * r * ga.y, v[j][2] * r * ga.z, v[j][3] * r * ga.w};
                op[1] = (f32x4){v[j][4] * r * gb.x, v[j][5] * r * gb.y, v[j][6] * r * gb.z, v[j][7] * r * gb.w}; }
        }
        s0 = e1;
    }
#undef P7_LOAD
#undef P7_ROW
}

constexpr unsigned long long P1_CPERM = 0x0ull | (0ull << 0) | (1ull << 4) | (2ull << 8) | (3ull << 12) | (4ull << 16) | (5ull << 20) | (10ull << 24) | (11ull << 28)
                                       | (6ull << 32) | (7ull << 36) | (12ull << 40) | (13ull << 44) | (8ull << 48) | (9ull << 52) | (15ull << 60);
#define LOAD_ARGS(la) Args la; { const __attribute__((address_space(4))) Args* ap_ = (const __attribute__((address_space(4))) Args*)__builtin_amdgcn_kernarg_segment_ptr(); asm volatile("" : "+s"(ap_)); la = *(const Args*)ap_; }
__global__ void __launch_bounds__(NTHREADS, 2) fwd_megakernel(Args args_unused) {
    extern __shared__ __attribute__((aligned(16))) unsigned char lds_raw[];
    cg::grid_group grid = cg::this_grid();
    Frame F;
    F.lds = (LAS unsigned char*)lds_raw;
    F.tid = threadIdx.x; F.lane = F.tid & 63; F.wave = __builtin_amdgcn_readfirstlane(F.tid >> 6);
    F.G = gridDim.x; { const int bx = blockIdx.x; F.vcu = (F.G % 8 == 0) ? (bx % 8) * (F.G / 8) + bx / 8 : bx; }
#define REFRAME() do { int l_; asm volatile("v_mbcnt_lo_u32_b32 %0, -1, 0\n\tv_mbcnt_hi_u32_b32 %0, -1, %0" : "=v"(l_)); F.lane = l_; F.tid = F.wave * 64 + l_; } while (0)
    for (int u = F.tid; u < (LDS_BYTES - MISC_OFF) / 4; u += NTHREADS) ((LAS unsigned*)(F.lds + MISC_OFF))[u] = 0u;
    __syncthreads();
    XcdBarrier xbar;
    { LOAD_ARGS(args0); xbar = xcd_barrier_post((unsigned*)(args0.ws + WS_CTL) + CW_BAR, (volatile LAS unsigned*)(F.lds + MISC_OFF + 1024)); }
#define GRID_BAR() xcd_barrier(xbar)

    { REFRAME(); LOAD_ARGS(args); p0_prologue(F, args); }
    grid.sync();
    { REFRAME(); LOAD_ARGS(args); p0b_norm1(F, args); }
    GRID_BAR();
    {
        REFRAME(); LOAD_ARGS(args); unsigned char* ws = args.ws;
        pg8::Gemm g{(const bf16*)(ws + WS_H), (const bf16*)(ws + WS_WIN), 1024}; pg8::DenseOrder S; S.init(NTOK, INW, F.G, (int)blockIdx.x, P1_CPERM);
        EpiProj E{(bf16*)(ws + WS_PROJ), args.in[13], (bf16*)(ws + WS_QC), (bf16*)(ws + WS_KV), F.lds + EPI_SCR};
        pg8::gemm_phase<EpiProj, pg8::DenseOrder>(F.lds, g, S, E, F.tid);
    }
    GRID_BAR();
    { REFRAME(); LOAD_ARGS(args); p2_mixers(F, args); }
    GRID_BAR();
    {
        REFRAME(); LOAD_ARGS(args); unsigned char* ws = args.ws;
        pg8::Gemm g{(const bf16*)(ws + WS_Y), (const bf16*)(ws + WS_WOUT), 1024}; pg8::DenseOrder S; S.init(NTOK, D, F.G, (int)blockIdx.x);
        EpiRes1 E{args.in[0], (bf16*)(ws + WS_X1B), (const float*)(ws + WS_MOD), F.lds + EPI_SCR};
        pg8::gemm_phase<EpiRes1, pg8::DenseOrder>(F.lds, g, S, E, F.tid);
    }
    GRID_BAR();
    { REFRAME(); LOAD_ARGS(args); p4_router(F, args); }
    GRID_BAR();
    {
        LAS int* pre = (LAS int*)(F.lds + MISC_OFF);
        { LOAD_ARGS(args);
          const unsigned* cnt = (const unsigned*)(args.ws + WS_CTL) + CW_CNT;
          if (F.tid < 64) {
              const int lane = F.tid; const int cv_ = (int)__hip_atomic_load(cnt + (lane & 31), __ATOMIC_RELAXED, __HIP_MEMORY_SCOPE_AGENT); const int tl = lane < 32 ? ((cv_ + 255) >> 8) : 0;
              if (lane < 32) ((LAS int*)(F.lds + MOE_CNTL))[lane] = cv_;
              int inc = tl;
#pragma unroll
              for (int o = 1; o < 32; o <<= 1) { const int t = __shfl_up(inc, o); if (lane >= o) inc += t; }
              if (lane < 32) pre[lane] = inc - tl;
              if (lane == 31) pre[32] = inc; } }
        __syncthreads();
        {
            REFRAME(); LOAD_ARGS(args); unsigned char* ws = args.ws;
            pg8::Gemm g{(const bf16*)(ws + WS_H), (const bf16*)(ws + WS_W13), 1024};
            MoeOrder S{pre, (const LAS int*)(F.lds + MOE_CNTL), (const LAS int*)(F.lds + MOE_LTOK), (const int*)(ws + WS_LIST), F.G, (int)blockIdx.x, F.lane, true};
            {
                const int* list = (const int*)(ws + WS_LIST); int tv[MOE_MAXU];
#pragma unroll
                for (int i = 0; i < MOE_MAXU; ++i) { pg8::Unit u; tv[i] = 0;
                    if (F.tid < 256 && S.next(i, u) && F.tid < u.nrows) tv[i] = list[(size_t)u.e * NTOK + u.r0 + F.tid] >> 1; }
#pragma unroll
                for (int i = 0; i < MOE_MAXU; ++i) if (F.tid < 256) ((LAS int*)(F.lds + MOE_LTOK))[i * 256 + F.tid] = tv[i];
                __syncthreads();
            }
            EpiSwiGLU E{(bf16*)(ws + WS_ACT), F.lds + EPI_SCR};
            pg8::gemm_phase<EpiSwiGLU, MoeOrder>(F.lds, g, S, E, F.tid);
        }
        GRID_BAR();
        {
            REFRAME(); LOAD_ARGS(args); unsigned char* ws = args.ws;
            pg8::Gemm g{(const bf16*)(ws + WS_ACT), (const bf16*)(ws + WS_W2), 512};
            MoeOrder S{pre, (const LAS int*)(F.lds + MOE_CNTL), (const LAS int*)(F.lds + MOE_LTOK), (const int*)(ws + WS_LIST), F.G, (int)blockIdx.x, F.lane, false};
            EpiScatter E{(bf16*)(ws + WS_YBUF), F.lds + EPI_SCR};
            pg8::gemm_phase<EpiScatter, MoeOrder>(F.lds, g, S, E, F.tid);
        }
    }
    GRID_BAR();
    { REFRAME(); LOAD_ARGS(args); p7_final(F, args); }
}

extern "C" void kernel_launch(void* const* d_in, const int* in_sizes, int n_in, void* d_out, int out_size, void* d_ws, size_t ws_size, hipStream_t stream) {
    static int grid = 0;
    if (grid == 0) {
        if (n_in != 24 || out_size != NTOK * D || ws_size < WS_END) { fprintf(stderr, "kernel_launch: unexpected problem (n_in %d out %d ws %zu)\n", n_in, out_size, ws_size); grid = -1; return; }
        int dev = 0, cus = 0, per_cu = 0;
        hipGetDevice(&dev);
        hipDeviceGetAttribute(&cus, hipDeviceAttributeMultiprocessorCount, dev);
        hipFuncSetAttribute((const void*)fwd_megakernel, hipFuncAttributeMaxDynamicSharedMemorySize, LDS_BYTES);
        hipOccupancyMaxActiveBlocksPerMultiprocessor(&per_cu, (const void*)fwd_megakernel, NTHREADS, LDS_BYTES);
        if (per_cu < 1) { fprintf(stderr, "kernel_launch: occupancy query says %d blocks per CU\n", per_cu); per_cu = 1; }
        grid = cus;
        (void)hipGetLastError();
    }
    if (grid < 0) return;
    hipMemsetAsync((char*)d_ws + WS_CTL, 0, CTL_ZERO_BYTES, stream);
    Args a{};
    for (int i = 0; i < 24; ++i) a.in[i] = (const float*)d_in[i];
    a.out = (float*)d_out; a.ws = (unsigned char*)d_ws;
    void* kargs[] = {&a};
    hipError_t e = hipLaunchCooperativeKernel((const void*)fwd_megakernel, dim3(grid), dim3(NTHREADS), kargs, LDS_BYTES, stream);
    if (e != hipSuccess) fprintf(stderr, "cooperative launch failed: %s (grid %d)\n", hipGetErrorString(e), grid);
}
```

```cpp
#include <hip/hip_runtime.h>
#include <hip/hip_cooperative_groups.h>
#include <cstdint>
#include <cstdio>
namespace cg = cooperative_groups;

#define LAS __attribute__((address_space(3)))
#define GAS __attribute__((address_space(1)))
typedef unsigned short bf16;
typedef short bf16x8 __attribute__((ext_vector_type(8)));
typedef short s16x4 __attribute__((ext_vector_type(4)));
typedef float f32x2 __attribute__((ext_vector_type(2)));
typedef float f32x4 __attribute__((ext_vector_type(4)));
typedef float f32x16 __attribute__((ext_vector_type(16)));
typedef unsigned u32x2 __attribute__((ext_vector_type(2)));
typedef unsigned u32x4 __attribute__((ext_vector_type(4)));
typedef __bf16 bf16x2_t __attribute__((ext_vector_type(2)));

constexpr int D = 1024, BATCH = 8, SEQ = 8192, NTOK = BATCH * SEQ;
constexpr int INW = 3584;
constexpr int COL_QA = 0, COL_KA = 512, COL_VA = 1024, COL_QR = 1536, COL_FR = 2048, COL_IR = 2560, COL_GR = 3072;
constexpr int NEXP = 32, FF = 512;
constexpr float EPS = 1e-6f;
constexpr float LOG2E = 1.4426950408889634f;
constexpr float QSCALE = 0.125f * LOG2E;
constexpr int NWAVES = 8, NTHREADS = 512;

constexpr size_t MiB = 1u << 20;
constexpr size_t WS_CTL = 0, CTL_ZERO_BYTES = 64 * 1024;
constexpr size_t WS_MOD = 1 * MiB;
constexpr size_t WS_WIN = 2 * MiB;
constexpr size_t WS_WOUT = 9 * MiB;
constexpr size_t WS_W13 = 11 * MiB;
constexpr size_t WS_W2 = 75 * MiB;
constexpr size_t WS_LIST = 107 * MiB;
constexpr size_t WS_TOKW = 115 * MiB;
constexpr size_t WS_TOKS = 115 * MiB + 512 * 1024;
constexpr size_t WS_H = 116 * MiB;
constexpr size_t WS_Y = 244 * MiB;
constexpr size_t WS_PROJ = 372 * MiB;
constexpr size_t WS_ACT = 372 * MiB;
constexpr size_t WS_YBUF = 508 * MiB;
constexpr size_t WS_QC = 820 * MiB;
constexpr size_t WS_KV = 884 * MiB;
constexpr size_t WS_X1B = 884 * MiB;
constexpr size_t WS_END = 1012 * MiB;
constexpr int CW_CNT = 0;
constexpr int CW_Q = 64;
constexpr int CW_BAR = 8192;

constexpr int RING_BYTES = 131072;
constexpr int MISC_OFF = RING_BYTES;
constexpr int EPI_SCR = MISC_OFF + 16384;
constexpr int LDS_BYTES = 163840;

__device__ __forceinline__ unsigned cvtpk(float lo, float hi) { f32x2 v = {lo, hi}; bf16x2_t b = __builtin_convertvector(v, bf16x2_t); return __builtin_bit_cast(unsigned, b); }
__device__ __forceinline__ float dot2bf(unsigned a, unsigned b, float acc) {
    asm("" : "+v"(a));
    return __builtin_amdgcn_fdot2_f32_bf16(__builtin_bit_cast(bf16x2_t, a), __builtin_bit_cast(bf16x2_t, b), acc, false); }
__device__ __forceinline__ float bf2f(unsigned short x) { return __uint_as_float(((unsigned)x) << 16); }
__device__ __forceinline__ float bflo(unsigned x) { return __uint_as_float(x << 16); }
__device__ __forceinline__ float bfhi(unsigned x) { return __uint_as_float(x & 0xffff0000u); }
template <int CTRL> __device__ __forceinline__ float dppf(float x) { return __builtin_bit_cast(float, __builtin_amdgcn_update_dpp(0, __builtin_bit_cast(int, x), CTRL, 0xf, 0xf, false)); }
__device__ __forceinline__ void swap32(float a, float b, float& r0, float& r1) { auto r = __builtin_amdgcn_permlane32_swap(__builtin_bit_cast(unsigned, a), __builtin_bit_cast(unsigned, b), false, false);
    unsigned u0 = r[0], u1 = r[1]; asm("" : "+v"(u0), "+v"(u1)); r0 = __builtin_bit_cast(float, u0); r1 = __builtin_bit_cast(float, u1); }
__device__ __forceinline__ void swap16(float a, float b, float& r0, float& r1) { auto r = __builtin_amdgcn_permlane16_swap(__builtin_bit_cast(unsigned, a), __builtin_bit_cast(unsigned, b), false, false);
    unsigned u0 = r[0], u1 = r[1]; asm("" : "+v"(u0), "+v"(u1)); r0 = __builtin_bit_cast(float, u0); r1 = __builtin_bit_cast(float, u1); }
__device__ __forceinline__ float sum_x32(float a, float b) { float r0, r1; swap32(a, b, r0, r1); return r0 + r1; }
__device__ __forceinline__ float sum_x16(float a, float b) { float r0, r1; swap16(a, b, r0, r1); return r0 + r1; }
__device__ __forceinline__ float row_sum(float v) { v += dppf<0xB1>(v); v += dppf<0x4E>(v); v += dppf<0x141>(v); v += dppf<0x140>(v); return v; }
__device__ __forceinline__ float wave_sum(float v) { v = row_sum(v); v = sum_x16(v, v); return sum_x32(v, v); }
__device__ __forceinline__ float fast_exp2(float x) { return __builtin_amdgcn_exp2f(x); }
__device__ __forceinline__ float fast_rcp(float x) { return __builtin_amdgcn_rcpf(x); }
__device__ __forceinline__ float sigmoidf_(float x) { return fast_rcp(1.f + fast_exp2(-x * LOG2E)); }
__device__ __forceinline__ float siluf_(float x) { return x * sigmoidf_(x); }

namespace pg8 {
constexpr int BM = 256, BK = 64, HALF = 128, HTB = HALF * BK * 2, STAGE_BYTES = 8 * HTB;
__host__ __device__ __forceinline__ int lds_byte(int r, int c) { const int st = (r >> 4) * 2 + (c >> 5), rr = r & 15, cc = c & 31, ob = rr * 64 + cc * 2; return st * 1024 + (ob ^ (((ob >> 9) & 1) << 5)); }
__host__ __device__ __forceinline__ void stage_rc(int b, int& R, int& C) { const int st = b / 1024, sb = b % 1024, swz = sb ^ (((sb >> 9) & 1) << 5); R = (st >> 1) * 16 + swz / 64; C = (st & 1) * 32 + (swz % 64) / 2; }
__host__ __device__ __forceinline__ int perm32(int rho) { const int n = rho >> 4, i = rho & 15; return 8 * (i >> 2) + 4 * n + (i & 3); }

template <int STRICT, int LAX> __device__ __forceinline__ void wait_v_sel(int sel) {
    asm volatile("s_cmp_lg_u32 %0, 0\n\ts_cbranch_scc1 1f\n\ts_waitcnt vmcnt(%1)\n1:\n\ts_waitcnt vmcnt(%2)" :: "s"(sel), "n"(STRICT), "n"(LAX) : "scc", "memory"); }
template <int N> __device__ __forceinline__ void wait_v() { asm volatile("s_waitcnt vmcnt(%0)" :: "n"(N) : "memory"); }
struct Unit { int pm, pn, e, r0, nrows, slot; };
struct Gemm { const bf16* A; const bf16* Bt; int K; };

template <class Epi, class Sched>
__device__ __forceinline__ void gemm_phase(LAS unsigned char* lds, const Gemm g, const Sched& S, const Epi& E, const int tid) {
    const int  wid = __builtin_amdgcn_readfirstlane(tid >> 6), lane = tid & 63, wr = wid >> 2, wc = wid & 3, fr = lane & 15, fq = lane >> 4;
    const int K = g.K, nt = K / BK;
    int RA[2], CA[2]; unsigned voffB[2];
#pragma unroll
    for (int i = 0; i < 2; ++i) { int R, C; stage_rc(tid * 16 + i * 8192, R, C); const int Rb = Epi::PERM ? (64 * (R >> 5) + perm32(R & 31)) : R;
        RA[i] = R; CA[i] = C; voffB[i] = (unsigned)(Rb * K + C) * 2u; }
    const size_t kstep = (size_t)(BK * 2);
    const size_t hstep = (size_t)(Epi::PERM ? 32 : HALF) * K * 2;
    const size_t tstep = (size_t)BM * K * 2;
    const unsigned ldsw = (unsigned)wid * 1024u;
    const int aoff = lds_byte(wr * 64 + fr, fq * 8), boff = lds_byte(wc * 32 + fr, fq * 8);
#define PG8_SA(b, h) (((b) * 2 + (h)) * HTB)
#define PG8_SB(b, h) ((4 + (b) * 2 + (h)) * HTB)
#define PG8_STAGE(bufoff, gbase, voff) do { _Pragma("unroll") for (int _i = 0; _i < 2; ++_i) \
        __builtin_amdgcn_global_load_lds((const unsigned*)((const char*)(gbase) + (voff)[_i]), (LAS unsigned*)(lds + (bufoff) + ldsw + _i * 8192), 16, 0, 0); } while (0)
#define PG8_LDA(dst, b, h) do { _Pragma("unroll") for (int m = 0; m < 4; ++m) _Pragma("unroll") for (int k = 0; k < 2; ++k) dst[m][k] = *(const LAS bf16x8*)(lds + PG8_SA(b, h) + aoff + m * 2048 + k * 1024); } while (0)
#define PG8_LDB(dst, b, h) do { _Pragma("unroll") for (int n = 0; n < 2; ++n) _Pragma("unroll") for (int k = 0; k < 2; ++k) dst[n][k] = *(const LAS bf16x8*)(lds + PG8_SB(b, h) + boff + n * 2048 + k * 1024); } while (0)
#define PG8_MMA(ai, bj, At, Bt) do { __builtin_amdgcn_s_setprio(1); _Pragma("unroll") for (int m = 0; m < 4; ++m) _Pragma("unroll") for (int n = 0; n < 2; ++n) _Pragma("unroll") for (int k = 0; k < 2; ++k) \
        acc[ai][bj][m][n] = __builtin_amdgcn_mfma_f32_16x16x32_bf16(Bt[n][k], At[m][k], acc[ai][bj][m][n], 0, 0, 0); __builtin_amdgcn_s_setprio(0); } while (0)
#define PG8_WAIT_V(n) asm volatile("s_waitcnt vmcnt(" #n ")" ::: "memory")
#define PG8_WAIT_L(n) asm volatile("s_waitcnt lgkmcnt(" #n ")" ::: "memory")
#define PG8_BAR __builtin_amdgcn_s_barrier()
#define PG8_SCHED __builtin_amdgcn_sched_barrier(0)
#define PG8_AOFF(dst, u) do { _Pragma("unroll") for (int _h = 0; _h < 2; ++_h) _Pragma("unroll") for (int _i = 0; _i < 2; ++_i) \
        dst[_h][_i] = ((unsigned)S.arow(u, _h * HALF + RA[_i]) * (unsigned)K + (unsigned)CA[_i]) * 2u; } while (0)
    Unit cur, nxt; int ui = 0;
    if (!S.next(0, cur)) return;
    f32x4 acc[2][2][4][2];
#pragma unroll
    for (int a = 0; a < 2; ++a)
#pragma unroll
        for (int b = 0; b < 2; ++b)
#pragma unroll
            for (int m = 0; m < 4; ++m)
#pragma unroll
                for (int n = 0; n < 2; ++n) acc[a][b][m][n] = (f32x4){0.f, 0.f, 0.f, 0.f};
    bf16x8 At[4][2], B0[2][2], B1[2][2];
    unsigned cv[2][2], nv[2][2];
    PG8_AOFF(cv, cur);
    const char* Ab = (const char*)g.A;
    const char* cB = (const char*)g.Bt + (size_t)cur.pn * tstep;
    {
        PG8_STAGE(PG8_SB(0, 0), cB, voffB); PG8_STAGE(PG8_SB(0, 1), cB + hstep, voffB); PG8_STAGE(PG8_SA(0, 0), Ab, cv[0]); PG8_STAGE(PG8_SA(0, 1), Ab, cv[1]);
        if (wr == 1) PG8_BAR;
        PG8_WAIT_V(2); PG8_BAR;
        PG8_STAGE(PG8_SB(1, 0), cB + kstep, voffB); PG8_STAGE(PG8_SA(1, 0), Ab + kstep, cv[0]); PG8_STAGE(PG8_SB(1, 1), cB + hstep + kstep, voffB);
        PG8_WAIT_V(6); PG8_BAR;
    }
    for (;;) {
        const bool has_next = S.next(ui + 1, nxt);
        if (has_next) { PG8_AOFF(nv, nxt); } else {
#pragma unroll
            for (int _h = 0; _h < 2; ++_h)
#pragma unroll
                for (int _i = 0; _i < 2; ++_i) nv[_h][_i] = cv[_h][_i]; }
        const char* nB = has_next ? (const char*)g.Bt + (size_t)nxt.pn * tstep : cB;
        for (int t = 0; t < nt; t += 2) {
            const bool last = (t == nt - 2);
            const int relax = __builtin_amdgcn_readfirstlane(((t == 0) && (ui > 0)) ? 1 : 0);
            const char* a1 = Ab + (size_t)(t + 1) * kstep;
            const char* a2 = last ? Ab : Ab + (size_t)(t + 2) * kstep; const char* b2 = last ? nB : cB + (size_t)(t + 2) * kstep;
            const char* a3 = a2 + kstep; const char* b3 = b2 + kstep;
            unsigned o2[2][2];
#pragma unroll
            for (int _h = 0; _h < 2; ++_h)
#pragma unroll
                for (int _i = 0; _i < 2; ++_i) o2[_h][_i] = last ? nv[_h][_i] : cv[_h][_i];
            PG8_LDB(B0, 0, 0); PG8_LDB(B1, 0, 1); PG8_SCHED; PG8_LDA(At, 0, 0); PG8_STAGE(PG8_SA(1, 1), a1, cv[1]);
            wait_v_sel<8, 8 + Epi::NST>(relax);
            PG8_WAIT_L(0); PG8_BAR; PG8_MMA(0, 0, At, B0); PG8_MMA(0, 1, At, B1); PG8_BAR; PG8_SCHED;
            PG8_LDA(At, 0, 1); PG8_STAGE(PG8_SB(0, 0), b2, voffB); PG8_STAGE(PG8_SB(0, 1), b2 + hstep, voffB); PG8_STAGE(PG8_SA(0, 0), a2, o2[0]);
            wait_v_sel<8, 8 + Epi::NST>(relax);
            PG8_WAIT_L(0); PG8_BAR; PG8_MMA(1, 0, At, B0); PG8_MMA(1, 1, At, B1); PG8_BAR; PG8_SCHED;
            PG8_LDB(B0, 1, 0); PG8_LDB(B1, 1, 1); PG8_SCHED; PG8_LDA(At, 1, 0); PG8_STAGE(PG8_SA(0, 1), a2, o2[1]);
            PG8_WAIT_V(8); PG8_WAIT_L(0); PG8_BAR; PG8_MMA(0, 0, At, B0); PG8_MMA(0, 1, At, B1); PG8_BAR; PG8_SCHED;
            PG8_LDA(At, 1, 1); PG8_STAGE(PG8_SB(1, 0), b3, voffB); PG8_STAGE(PG8_SB(1, 1), b3 + hstep, voffB); PG8_STAGE(PG8_SA(1, 0), a3, o2[0]);
            PG8_WAIT_V(8); PG8_WAIT_L(0); PG8_BAR; PG8_MMA(1, 0, At, B0); PG8_MMA(1, 1, At, B1); PG8_BAR; PG8_SCHED;
        }
        if (wr == 0) PG8_BAR;
        { int le; asm volatile("v_mbcnt_lo_u32_b32 %0, -1, 0\n\tv_mbcnt_hi_u32_b32 %0, -1, %0" : "=v"(le));
          E(acc, cur, wr, wc, le & 15, le >> 4); }
        if (!has_next) break;
#pragma unroll
        for (int a = 0; a < 2; ++a)
#pragma unroll
            for (int b = 0; b < 2; ++b)
#pragma unroll
                for (int m = 0; m < 4; ++m)
#pragma unroll
                    for (int n = 0; n < 2; ++n) acc[a][b][m][n] = (f32x4){0.f, 0.f, 0.f, 0.f};
        cur = nxt; cB = nB; ++ui;
#pragma unroll
        for (int _h = 0; _h < 2; ++_h)
#pragma unroll
            for (int _i = 0; _i < 2; ++_i) cv[_h][_i] = nv[_h][_i];
        if (wr == 1) PG8_BAR;
    }
    PG8_WAIT_V(0);
    PG8_BAR;
#undef PG8_SA
#undef PG8_SB
#undef PG8_STAGE
#undef PG8_LDA
#undef PG8_LDB
#undef PG8_MMA
#undef PG8_WAIT_V
#undef PG8_WAIT_L
#undef PG8_BAR
#undef PG8_SCHED
#undef PG8_AOFF
}

struct DenseOrder {
    int nM, nN, nwg, G, c; unsigned long long cperm, cperm1;
    __device__ void init(int M, int N, int G_, int c_, unsigned long long cperm_ = 0ull, unsigned long long cperm1_ = 0ull) { nM = M / BM; nN = N / BM; nwg = nM * nN; G = G_; c = c_; cperm = cperm_; cperm1 = cperm1_; }
    __device__ __forceinline__ bool next(int i, Unit& u) const {
        const long L = (long)i * G + c; if (L >= nwg) return false;
        int wgid = (int)L; { const int q = nwg / 8, r = nwg % 8, xcd = wgid % 8, off = wgid / 8; wgid = (xcd < r ? xcd * (q + 1) : r * (q + 1) + (xcd - r) * q) + off; }
        const int nig = 8 * nN, gid = wgid / nig, fm = gid * 8, gsz = (nM - fm) < 8 ? (nM - fm) : 8;
        u.pm = fm + ((wgid % nig) % gsz); u.pn = (wgid % nig) / gsz; if (cperm) u.pn = (int)((((gid & 1) ? cperm1 : cperm) >> (4 * u.pn)) & 15ull);
        u.e = 0; u.r0 = 0; u.nrows = BM; u.slot = 0; return true;
    }
    __device__ __forceinline__ int arow(const Unit& u, int r) const { return u.pm * BM + r; }
};
__device__ __forceinline__ void xpose128(LAS unsigned char* scr, int fr, int fq, const u32x4& w0, const u32x4& w1, u32x4& rA, u32x4& rB) {
    const int sw = fr & 7;
    *(LAS u32x4*)(scr + fr * 128 + ((fq ^ sw) << 4)) = w0;
    *(LAS u32x4*)(scr + fr * 128 + (((4 + fq) ^ sw) << 4)) = w1;
    asm volatile("" ::: "memory");
    const int l = fr + 16 * fq, r = l >> 3, c = l & 7;
    rA = *(const LAS u32x4*)(scr + r * 128 + ((c ^ r) << 4));
    rB = *(const LAS u32x4*)(scr + 1024 + r * 128 + ((c ^ r) << 4));
    asm volatile("" ::: "memory");
}
}

#define XB_TMO      128
#define XB_XCNT(j)  (256  + 64 * (j))
#define XB_XSUB(j)  (1280 + 64 * (j))
#define XB_XGEN(j)  (2304 + 64 * (j))
#define XB_TOP      3328
#define XB_TOPGEN   3392
#define XCD_BAR_WORDS 3456
#define XB_SPIN_CAP (1u << 18)
__device__ __forceinline__ unsigned xb_ld(unsigned* p)              { return __hip_atomic_load(p, __ATOMIC_RELAXED, __HIP_MEMORY_SCOPE_AGENT); }
__device__ __forceinline__ unsigned xb_add(unsigned* p, unsigned v) { return __hip_atomic_fetch_add(p, v, __ATOMIC_RELAXED, __HIP_MEMORY_SCOPE_AGENT); }
__device__ __forceinline__ unsigned xb_xcc_id() { return (unsigned)__builtin_amdgcn_s_getreg((3 << 11) | 20) & 0xFu; }
#define XB_SPIN(cond, bar) do { unsigned _sp = 0; while (cond) { __builtin_amdgcn_s_sleep(1); \
    if ((++_sp & 255u) == 0u) { if (xb_ld(&(bar)[XB_TMO])) break; if (_sp > XB_SPIN_CAP) { atomicAdd(&(bar)[XB_TMO], 1u); break; } } } } while (0)
struct XcdBarrier { unsigned* bar; unsigned x; volatile LAS unsigned* st; };
__device__ __forceinline__ XcdBarrier xcd_barrier_post(unsigned* bar, volatile LAS unsigned* st) {
    XcdBarrier b; b.bar = bar; b.x = xb_xcc_id(); b.st = st;
    if (threadIdx.x == 0) (void)xb_add(&bar[XB_XCNT(b.x)], 1u);
    return b;
}
__device__ __forceinline__ void xcd_barrier_complete(unsigned* bar, unsigned x, unsigned& nloc, unsigned& nx) {
    const unsigned G = gridDim.x * gridDim.y * gridDim.z;
    unsigned sum, cnt, mine, sp = 0u;
    for (;;) {
        sum = 0u; cnt = 0u; mine = 0u;
#pragma unroll
        for (unsigned j = 0; j < 16; ++j) { const unsigned c = xb_ld(&bar[XB_XCNT(j)]); sum += c; cnt += (c > 0u) ? 1u : 0u; mine = (j == x) ? c : mine; }
        if (sum == G) break;
        __builtin_amdgcn_s_sleep(1);
        if ((++sp & 255u) == 0u) { if (xb_ld(&bar[XB_TMO])) break; if (sp > XB_SPIN_CAP) { atomicAdd(&bar[XB_TMO], 1u); break; } }
    }
    nloc = mine > 0u ? mine : 1u; nx = cnt > 0u ? cnt : 1u;
}
__device__ __forceinline__ void xcd_barrier(const XcdBarrier& b) {
    asm volatile("s_waitcnt vmcnt(0)" ::: "memory");
    __syncthreads();
    if (threadIdx.x == 0) {
        unsigned* bar = b.bar;
        __builtin_amdgcn_s_waitcnt(0);
        unsigned nloc = b.st[0], nx = b.st[1];
        if (nloc == 0u) { xcd_barrier_complete(bar, b.x, nloc, nx); b.st[0] = nloc; b.st[1] = nx; }
        const unsigned old = xb_add(&bar[XB_XSUB(b.x)], 1u);
        const unsigned gen = old / nloc;
        if (old + 1u == (gen + 1u) * nloc) {
            __builtin_amdgcn_fence(__ATOMIC_RELEASE, "agent");
            asm volatile("s_waitcnt vmcnt(0)" ::: "memory");
            const unsigned og = xb_add(&bar[XB_TOP], 1u);
            const unsigned tg = og / nx;
            if (og + 1u == (tg + 1u) * nx) xb_add(&bar[XB_TOPGEN], 1u);
            else XB_SPIN(xb_ld(&bar[XB_TOPGEN]) == tg, bar);
            __builtin_amdgcn_fence(__ATOMIC_ACQUIRE, "agent");
            xb_add(&bar[XB_XGEN(b.x)], 1u);
            asm volatile("s_waitcnt vmcnt(0)" ::: "memory");
        } else {
            XB_SPIN(xb_ld(&bar[XB_XGEN(b.x)]) == gen, bar);
            __builtin_amdgcn_fence(__ATOMIC_ACQUIRE, "agent");
            asm volatile("s_waitcnt vmcnt(0)" ::: "memory");
        }
    }
    __syncthreads();
}

struct Args { const float* in[24]; float* out; unsigned char* ws; };
struct Frame {
    LAS unsigned char* lds;
    int tid, lane, wave, vcu, G;
};

template <int MODE>
__device__ __forceinline__ void p0_transpose_item(const float* W, int K, int N, bf16* WT, LAS float* scr, int item, int lane) {
    const int nblk = N / 32, kb = item / nblk, nb = item % nblk, k0 = 64 * kb, n0 = 32 * nb;
    f32x4 v[8];
#pragma unroll
    for (int i = 0; i < 8; ++i) v[i] = *(const f32x4*)(W + (size_t)(k0 + 8 * i + (lane >> 3)) * N + n0 + 4 * (lane & 7));
#pragma unroll
    for (int i = 0; i < 8; ++i) { LAS float* d = scr + (8 * i + (lane >> 3)) * 33 + 4 * (lane & 7); d[0] = v[i].x; d[1] = v[i].y; d[2] = v[i].z; d[3] = v[i].w; }
    asm volatile("s_waitcnt lgkmcnt(0)" ::: "memory");
    const int c = lane & 7;
#pragma unroll
    for (int j = 0; j < 4; ++j) { const int n = (lane >> 3) + 8 * j; const LAS float* s = scr + (8 * c) * 33 + n;
        u32x4 o; o.x = cvtpk(s[0 * 33], s[1 * 33]); o.y = cvtpk(s[2 * 33], s[3 * 33]); o.z = cvtpk(s[4 * 33], s[5 * 33]); o.w = cvtpk(s[6 * 33], s[7 * 33]);
        const int f = n0 + n; int row = f;
        if (MODE == 1) row = ((f >> 7) << 8) + (((f >> 5) & 3) << 6) + (f & 31);
        if (MODE == 2) row = ((f >> 7) << 8) + (((f >> 5) & 3) << 6) + 32 + (f & 31);
        *(u32x4*)(WT + (size_t)row * K + k0 + 8 * c) = o; }
    asm volatile("s_waitcnt lgkmcnt(0)" ::: "memory");
}

__device__ __forceinline__ void p0_prologue(const Frame& F, const Args& a) {
    unsigned char* ws = a.ws;
    if (F.vcu < 96) {
        LAS float* cact = (LAS float*)F.lds;
        LAS float* red = (LAS float*)(F.lds + 32768);
        const float* c = a.in[1];
        for (int i = F.tid; i < 8192; i += NTHREADS) { const int b = i >> 10, k = i & 1023; cact[k * 8 + b] = siluf_(c[i]); }
        __syncthreads();
        const int j = F.vcu * 64 + F.lane;
        const float* w = a.in[2] + (size_t)(128 * F.wave) * 6144 + j;
        float acc[8];
#pragma unroll
        for (int b = 0; b < 8; ++b) acc[b] = 0.f;
#pragma unroll 16
        for (int k = 0; k < 128; ++k) { const float wv = w[(size_t)k * 6144]; const LAS float* cp = cact + (128 * F.wave + k) * 8; const f32x4 c0 = *(const LAS f32x4*)cp, c1 = *(const LAS f32x4*)(cp + 4);
            acc[0] += c0.x * wv; acc[1] += c0.y * wv; acc[2] += c0.z * wv; acc[3] += c0.w * wv; acc[4] += c1.x * wv; acc[5] += c1.y * wv; acc[6] += c1.z * wv; acc[7] += c1.w * wv; }
#pragma unroll
        for (int b = 0; b < 8; ++b) red[(F.wave * 8 + b) * 64 + F.lane] = acc[b];
        __syncthreads();
        { const int b = F.tid >> 6; float s = 0.f;
#pragma unroll
          for (int ww = 0; ww < 8; ++ww) s += red[(ww * 8 + b) * 64 + F.lane];
          ((float*)(ws + WS_MOD))[b * 6144 + j] = s + a.in[3][j]; }
        __syncthreads();
    }
    LAS float* scr = (LAS float*)(F.lds + F.wave * 16384);
    const int gw = F.vcu * NWAVES + F.wave, NGW = F.G * NWAVES;
    constexpr int I_IN = 16 * 112, I_OUT = 16 * 32;
    constexpr int NITEMS = I_IN + I_OUT;
    bf16* win = (bf16*)(ws + WS_WIN); bf16* wout = (bf16*)(ws + WS_WOUT);
    for (int it = NITEMS - 1 - gw; it >= 0; it -= NGW) {
        int r = it;
        if (r < I_IN) { p0_transpose_item<0>(a.in[6], 1024, INW, win, scr, r, F.lane); continue; } r -= I_IN;
        p0_transpose_item<0>(a.in[15], 1024, 1024, wout, scr, r, F.lane);
    }
}

__device__ __forceinline__ void p0b_norm1(const Frame& F, const Args& a) {
    const float* x = a.in[0]; const float* ng = a.in[4]; const float* mod = (const float*)(a.ws + WS_MOD);
    bf16* H = (bf16*)(a.ws + WS_H);
    const int gw = F.vcu * NWAVES + F.wave, NGW = F.G * NWAVES;
    const int per = (NTOK + NGW - 1) / NGW;
    const int m0 = gw * per, m1 = (m0 + per < NTOK) ? m0 + per : NTOK;
    if (m0 >= NTOK) return;
    for (int s0 = m0; s0 < m1; ) {
        const int b = s0 >> 13, e1 = ((b + 1) << 13) < m1 ? ((b + 1) << 13) : m1;
        f32x4 ga[4], sha[4];
        { const f32x4* gp = (const f32x4*)ng + F.lane; const f32x4* shp = (const f32x4*)(mod + b * 6144) + F.lane; const f32x4* scp = (const f32x4*)(mod + b * 6144 + 1024) + F.lane;
#pragma unroll
          for (int j = 0; j < 4; ++j) { ga[j] = gp[64 * j] * (scp[64 * j] + 1.f); sha[j] = shp[64 * j]; } }
        f32x4 nx[4];
        { const f32x4* xr = (const f32x4*)(x + (size_t)s0 * D) + F.lane;
#pragma unroll
          for (int j = 0; j < 4; ++j) nx[j] = xr[64 * j]; }
        for (int m = s0; m < e1; ++m) {
            f32x4 v[4];
#pragma unroll
            for (int j = 0; j < 4; ++j) v[j] = nx[j];
            { const int mn = (m + 1 < e1) ? m + 1 : m; const f32x4* xr = (const f32x4*)(x + (size_t)mn * D) + F.lane;
#pragma unroll
              for (int j = 0; j < 4; ++j) nx[j] = xr[64 * j]; }
            float s = 0.f;
#pragma unroll
            for (int j = 0; j < 4; ++j) s += (v[j].x * v[j].x + v[j].y * v[j].y) + (v[j].z * v[j].z + v[j].w * v[j].w);
            const float r = __builtin_amdgcn_rsqf(wave_sum(s) * (1.f / D) + EPS);
            u32x2* o8 = (u32x2*)(H + (size_t)m * D) + F.lane;
#pragma unroll
            for (int j = 0; j < 4; ++j) { const f32x4 y = v[j] * r * ga[j] + sha[j];
                u32x2 o; o.x = cvtpk(y.x, y.y); o.y = cvtpk(y.z, y.w); o8[64 * j] = o; }
        }
        s0 = e1;
    }
}

struct EpiProj {
    static constexpr bool PERM = true;
    static constexpr int NST = 16;
    bf16* O; const float* lbraw;
    bf16* QC; bf16* KV;
    LAS unsigned char* scr;
    __device__ __forceinline__ void operator()(const f32x4 (&acc)[2][2][4][2], const pg8::Unit& u, int wr, int wc, int fr, int fq) const {
        const int seg = u.pn >> 1;
        const int col0 = u.pn * 256 + wc * 64 + 8 * fq;
        float lb[2][8];
        if (seg == 4) {
#pragma unroll
            for (int bj = 0; bj < 2; ++bj)
#pragma unroll
                for (int i = 0; i < 8; ++i) { const int k = col0 + bj * 32 + i - COL_FR; const float r0 = lbraw[k], r1 = lbraw[512 + k]; lb[bj][i] = fast_rcp(1.f + fast_exp2((r1 - r0) * LOG2E)); }
        }
        LAS unsigned char* ws_ = scr + (wr * 4 + wc) * 2048;
        const int l = fr + 16 * fq, r8 = l >> 3, c8 = l & 7;
        const int colT = u.pn * 256 + wc * 64 + 8 * c8, rowT = u.pm * 256 + wr * 64 + r8;
        u32x4 rq[2][2];
#pragma unroll
        for (int it = 0; it <= 8; ++it) {
            if (it < 8) { const int ai = it >> 2, m = it & 3; u32x4 w[2];
#pragma unroll
                for (int bj = 0; bj < 2; ++bj) { float v[8];
#pragma unroll
                    for (int i = 0; i < 4; ++i) { v[i] = acc[ai][bj][m][0][i]; v[4 + i] = acc[ai][bj][m][1][i]; }
                    if (seg == 0) {
#pragma unroll
                        for (int i = 0; i < 8; ++i) v[i] *= QSCALE;
                    } else if (seg == 3 || seg == 6) {
#pragma unroll
                        for (int i = 0; i < 8; ++i) v[i] = siluf_(v[i]);
                    } else if (seg == 4) {
#pragma unroll
                        for (int i = 0; i < 8; ++i) { const float lw = lb[bj][i]; v[i] = __builtin_amdgcn_logf(lw + (1.f - lw) * sigmoidf_(v[i])) * 0.6931471805599453f; }
                    }
                    w[bj].x = cvtpk(v[0], v[1]); w[bj].y = cvtpk(v[2], v[3]); w[bj].z = cvtpk(v[4], v[5]); w[bj].w = cvtpk(v[6], v[7]); }
                pg8::xpose128(ws_, fr, fq, w[0], w[1], rq[it & 1][0], rq[it & 1][1]); }
            if (it > 0) { const int ai = (it - 1) >> 2, m = (it - 1) & 3; const u32x4 rA = rq[(it - 1) & 1][0], rB = rq[(it - 1) & 1][1];
                const int row = rowT + ai * 128 + m * 16;
                if (seg < 3) {
                    const int c = colT & 511, hh = c >> 7, e = c & 127; const size_t tokrow = (size_t)((row >> 13) * 4 + hh) * SEQ + (row & (SEQ - 1));
                    if (seg == 0) { bf16* dst = QC + tokrow * 128 + e; *(u32x4*)dst = rA; *(u32x4*)(dst + 8 * 128) = rB; }
                    else { bf16* dst = KV + tokrow * 256 + (seg == 2 ? 128 : 0) + e; *(u32x4*)dst = rA; *(u32x4*)(dst + 8 * 256) = rB; }
                } else { bf16* rowp = O + (size_t)row * INW + colT; *(u32x4*)rowp = rA; *(u32x4*)(rowp + (size_t)8 * INW) = rB; } } }
    }
};

struct EpiRes1 {
    static constexpr bool PERM = true;
    static constexpr int NST = 16;
    const float* x; bf16* x1b; const float* mod;
    LAS unsigned char* scr;
    __device__ __forceinline__ void operator()(const f32x4 (&acc)[2][2][4][2], const pg8::Unit& u, int wr, int wc, int fr, int fq) const {
        const int b = (u.pm * 256) >> 13;
        const int col0 = u.pn * 256 + wc * 64 + 8 * fq;
        f32x4 gv[2][2];
#pragma unroll
        for (int bj = 0; bj < 2; ++bj)
#pragma unroll
            for (int n = 0; n < 2; ++n) gv[bj][n] = *(const f32x4*)(mod + b * 6144 + 2048 + col0 + bj * 32 + n * 4);
        LAS unsigned char* ws_ = scr + (wr * 4 + wc) * 2048;
        const int l = fr + 16 * fq, r8 = l >> 3, c8 = l & 7;
        const int colT = u.pn * 256 + wc * 64 + 8 * c8, rowT = u.pm * 256 + wr * 64 + r8;
        f32x4 xb[3][4];
#define RES1_LOAD(it) do { const size_t o_ = (size_t)(rowT + ((it) >> 2) * 128 + ((it) & 3) * 16) * D + colT; \
            xb[(it) % 3][0] = *(const f32x4*)(x + o_); xb[(it) % 3][1] = *(const f32x4*)(x + o_ + 4); xb[(it) % 3][2] = *(const f32x4*)(x + o_ + 8 * D); xb[(it) % 3][3] = *(const f32x4*)(x + o_ + 8 * D + 4); } while (0)
        RES1_LOAD(0); RES1_LOAD(1);
#pragma unroll
        for (int it = 0; it < 8; ++it) { const int ai = it >> 2, m = it & 3; const size_t off = (size_t)(rowT + ai * 128 + m * 16) * D + colT;
            if (it + 2 < 8) RES1_LOAD(it + 2);
            u32x4 w[2];
#pragma unroll
            for (int bj = 0; bj < 2; ++bj) { const f32x4 t0 = gv[bj][0] * acc[ai][bj][m][0], t1 = gv[bj][1] * acc[ai][bj][m][1];
                w[bj].x = cvtpk(t0.x, t0.y); w[bj].y = cvtpk(t0.z, t0.w); w[bj].z = cvtpk(t1.x, t1.y); w[bj].w = cvtpk(t1.z, t1.w); }
            u32x4 rA, rB; pg8::xpose128(ws_, fr, fq, w[0], w[1], rA, rB);
            const f32x4 xa0 = xb[it % 3][0], xa1 = xb[it % 3][1], xb0 = xb[it % 3][2], xb1 = xb[it % 3][3];
            u32x4 o;
            o.x = cvtpk(xa0.x + bflo(rA.x), xa0.y + bfhi(rA.x)); o.y = cvtpk(xa0.z + bflo(rA.y), xa0.w + bfhi(rA.y));
            o.z = cvtpk(xa1.x + bflo(rA.z), xa1.y + bfhi(rA.z)); o.w = cvtpk(xa1.z + bflo(rA.w), xa1.w + bfhi(rA.w));
            *(u32x4*)(x1b + off) = o;
            o.x = cvtpk(xb0.x + bflo(rB.x), xb0.y + bfhi(rB.x)); o.y = cvtpk(xb0.z + bflo(rB.y), xb0.w + bfhi(rB.y));
            o.z = cvtpk(xb1.x + bflo(rB.z), xb1.y + bfhi(rB.z)); o.w = cvtpk(xb1.z + bflo(rB.w), xb1.w + bfhi(rB.w));
            *(u32x4*)(x1b + off + 8 * D) = o; }
#undef RES1_LOAD
    }
};

constexpr int WC_ITEMS = 3 * 32 * 256, WC_CHUNKS = WC_ITEMS / (32 * 8);
typedef const __attribute__((address_space(1))) f32x4* gcf4p;
typedef __attribute__((address_space(1))) u32x4* gu4p;
__device__ __forceinline__ void wconv_load(const Args& a, f32x4 (&v)[8], int it, int lane) {
    const int m = it >> 13, r = it & 8191, e = r >> 8, blk = r & 255;
    const int N = m < 2 ? 512 : 1024, nb = m < 2 ? (blk & 15) : (blk & 31), kb = m < 2 ? (blk >> 4) : (blk >> 5);
    const float* p1 = a.in[20]; const float* p3 = a.in[21]; const float* p2 = a.in[22]; asm volatile("" : "+s"(p1), "+s"(p3), "+s"(p2));
    const float* W = (m == 0 ? p1 : m == 1 ? p3 : p2) + (size_t)e * (1024 * 512) + (size_t)(64 * kb + 8 * (lane >> 3)) * N + 32 * nb + 4 * (lane & 7);
#pragma unroll
    for (int i = 0; i < 8; ++i) v[i] = *(gcf4p)(W + (size_t)i * N);
}
__device__ __forceinline__ void wconv_store(const Args& a, const f32x4 (&v)[8], int it, int lane, LAS unsigned char* scr) {
    const int m = it >> 13, r = it & 8191, e = r >> 8, blk = r & 255;
    const int K = m < 2 ? 1024 : 512, nb = m < 2 ? (blk & 15) : (blk & 31), kb = m < 2 ? (blk >> 4) : (blk >> 5);
    bf16* q13 = (bf16*)(a.ws + WS_W13); bf16* q2 = (bf16*)(a.ws + WS_W2); asm volatile("" : "+s"(q13), "+s"(q2));
    bf16* WT = (m < 2 ? q13 + (size_t)e * (1024 * 1024) : q2 + (size_t)e * (1024 * 512)) + 64 * kb;
    const int kk = lane >> 3, nn = lane & 7;
#pragma unroll
    for (int h = 0; h < 2; ++h) {
#pragma unroll
        for (int jj = 0; jj < 2; ++jj) { const int j = 2 * h + jj;
            u32x4 o; o.x = cvtpk(v[0][j], v[1][j]); o.y = cvtpk(v[2][j], v[3][j]); o.z = cvtpk(v[4][j], v[5][j]); o.w = cvtpk(v[6][j], v[7][j]);
            *(LAS u32x4*)(scr + (8 * jj + nn) * 128 + ((kk ^ nn) << 4)) = o; }
        asm volatile("" ::: "memory");
#pragma unroll
        for (int p = 0; p < 2; ++p) { const int f = 32 * nb + 4 * kk + 2 * h + p;
            const u32x4 o = *(const LAS u32x4*)(scr + (8 * p + kk) * 128 + ((nn ^ kk) << 4));
            const int row = m < 2 ? ((f >> 7) << 8) + (((f >> 5) & 3) << 6) + (m == 1 ? 32 : 0) + (f & 31) : f;
            *(gu4p)(WT + (size_t)row * K + 8 * nn) = o; }
        asm volatile("" ::: "memory");
    }
}

constexpr int HG_RS_ = 272, HG_SCS = 144, HG_ARR = 64 * HG_RS_;
constexpr int HG_RAW = 0, HG_QT = 3 * HG_ARR, HG_KT = HG_QT + HG_ARR, HG_SC = HG_KT + HG_ARR, HG_SEG = HG_SC + 64 * HG_SCS, HG_EL = HG_SEG + 4096, HG_OUT = HG_EL + 512, HG_END = HG_OUT + HG_ARR;
static_assert(HG_END <= RING_BYTES, "hgrn LDS map");
__device__ __forceinline__ s16x4 tr16(const LAS unsigned char* p) { return __builtin_bit_cast(s16x4, __builtin_amdgcn_ds_read_tr16_b64_v4i16((LAS s16x4*)p)); }

__device__ __forceinline__ void hgrn_stream(const Frame& F, const Args& a, int bh) {
    const int b = bh >> 2, h = bh & 3;
    const bf16* P = (const bf16*)(a.ws + WS_PROJ) + (size_t)b * SEQ * INW;
    bf16* Y = (bf16*)(a.ws + WS_Y) + (size_t)b * SEQ * D + 512 + h * 128;
    LAS unsigned char* lds = F.lds;
    const int tid = F.tid, lane = F.lane, w = F.wave, l15 = lane & 15, g = lane >> 4;
    u32x4 pre[4][2], gsr[2];
    const __amdgpu_buffer_rsrc_t prs = __builtin_amdgcn_make_buffer_rsrc((void*)P, (short)0, SEQ * INW * 2, 0x00020000);
    const unsigned hg_voff = (unsigned)((tid >> 4) * INW + COL_QR + h * 128 + (tid & 15) * 8) * 2u;
#define HG_LOAD(c) do { _Pragma("unroll") for (int ar = 0; ar < 4; ++ar) _Pragma("unroll") for (int i = 0; i < 2; ++i) { \
        pre[ar][i] = __builtin_bit_cast(u32x4, __builtin_amdgcn_raw_buffer_load_b128(prs, hg_voff, (unsigned)((((c) * 64 + 32 * i) * INW + 512 * ar) * 2), 0)); } } while (0)
#define HG_STORE() do { _Pragma("unroll") for (int ar = 0; ar < 3; ++ar) _Pragma("unroll") for (int i = 0; i < 2; ++i) { const int q = tid + 512 * i, row = q >> 4, ch = q & 15; \
        *(LAS u32x4*)(lds + HG_RAW + ar * HG_ARR + row * HG_RS_ + ch * 16) = pre[ar][i]; } gsr[0] = pre[3][0]; gsr[1] = pre[3][1]; } while (0)
    f32x4 S[8];
#pragma unroll
    for (int kb = 0; kb < 8; ++kb) S[kb] = (f32x4){0.f, 0.f, 0.f, 0.f};
    float ngc[8];
    { const float* ngp = a.in[14] + h * 128 + (tid & 15) * 8;
#pragma unroll
      for (int i = 0; i < 8; ++i) ngc[i] = ngp[i]; }
    HG_LOAD(0);
    HG_STORE();
    for (int c = 0; c < SEQ / 64; ++c) {
        __syncthreads();
        if (c + 1 < SEQ / 64) HG_LOAD(c + 1);
        const bool wdo = c < WC_CHUNKS; const int wit = (c * 32 + bh) * 8 + w;
        f32x4 wv[8];
        if (wdo) wconv_load(a, wv, wit, lane);
        else {
#pragma unroll
            for (int i = 0; i < 8; ++i) wv[i] = (f32x4){0.f, 0.f, 0.f, 0.f}; }
        float bl[8][2];
        {
            float run0 = 0.f, run1 = 0.f;
#pragma unroll
            for (int i = 0; i < 8; ++i) { const unsigned v = *(const LAS unsigned*)(lds + HG_RAW + HG_ARR + (8 * w + i) * HG_RS_ + 4 * lane);
                run0 += bflo(v); run1 += bfhi(v); bl[i][0] = run0; bl[i][1] = run1; }
            *(LAS f32x2*)(lds + HG_SEG + (w * 128 + 2 * lane) * 4) = (f32x2){run0, run1};
        }
        __syncthreads();
        {
            float off0 = 0.f, off1 = 0.f, tot0 = 0.f, tot1 = 0.f;
#pragma unroll
            for (int s = 0; s < 8; ++s) { const f32x2 v = *(const LAS f32x2*)(lds + HG_SEG + (s * 128 + 2 * lane) * 4); if (s < w) { off0 += v.x; off1 += v.y; } tot0 += v.x; tot1 += v.y; }
            if (w == 0) *(LAS f32x2*)(lds + HG_EL + 2 * lane * 4) = (f32x2){fast_exp2(tot0 * LOG2E), fast_exp2(tot1 * LOG2E)};
#pragma unroll
            for (int i = 0; i < 8; ++i) { const int t = 8 * w + i;
                const unsigned lfv = *(const LAS unsigned*)(lds + HG_RAW + HG_ARR + t * HG_RS_ + 4 * lane);
                const unsigned qv = *(const LAS unsigned*)(lds + HG_RAW + t * HG_RS_ + 4 * lane);
                const float b0 = bl[i][0] + off0, b1 = bl[i][1] + off1;
                const float e0 = fast_exp2(b0 * LOG2E), e1 = fast_exp2(b1 * LOG2E);
                const float k0 = 1.f - fast_exp2(bflo(lfv) * LOG2E), k1 = 1.f - fast_exp2(bfhi(lfv) * LOG2E);
                *(LAS unsigned*)(lds + HG_QT + t * HG_RS_ + 4 * lane) = cvtpk(bflo(qv) * e0, bfhi(qv) * e1);
                *(LAS unsigned*)(lds + HG_KT + t * HG_RS_ + 4 * lane) = cvtpk(k0 * fast_rcp(e0), k1 * fast_rcp(e1)); }
        }
        __syncthreads();
#pragma unroll
        for (int i = 0; i < 2; ++i) { const int tile = 2 * w + i, tb = tile >> 2, sb = tile & 3;
            f32x4 sc = (f32x4){0.f, 0.f, 0.f, 0.f};
#pragma unroll
            for (int ks = 0; ks < 4; ++ks) { const bf16x8 af = *(const LAS bf16x8*)(lds + HG_QT + (16 * tb + l15) * HG_RS_ + (32 * ks + 8 * g) * 2);
                const bf16x8 bfr = *(const LAS bf16x8*)(lds + HG_KT + (16 * sb + l15) * HG_RS_ + (32 * ks + 8 * g) * 2);
                sc = __builtin_amdgcn_mfma_f32_16x16x32_bf16(af, bfr, sc, 0, 0, 0); }
#pragma unroll
            for (int r = 0; r < 4; ++r) { const int t = 16 * tb + 4 * g + r, s = 16 * sb + l15; const float v = (s <= t) ? sc[r] : 0.f;
                *(LAS unsigned short*)(lds + HG_SC + t * HG_SCS + s * 2) = (unsigned short)(cvtpk(v, 0.f) & 0xffffu); } }
        __syncthreads();
        bf16x8 vf[2];
#pragma unroll
        for (int ss = 0; ss < 2; ++ss) { const LAS unsigned char* vp = lds + HG_RAW + 2 * HG_ARR + (32 * ss + 8 * g + (l15 >> 2)) * HG_RS_ + (16 * w + 4 * (l15 & 3)) * 2;
            const s16x4 lo = tr16(vp), hi = tr16(vp + 4 * HG_RS_); vf[ss] = (bf16x8){lo[0], lo[1], lo[2], lo[3], hi[0], hi[1], hi[2], hi[3]}; }
        f32x4 o[4];
        {
            bf16x8 sf[4];
#pragma unroll
            for (int ks = 0; ks < 4; ++ks) { u32x4 t4; t4.x = cvtpk(S[2 * ks][0], S[2 * ks][1]); t4.y = cvtpk(S[2 * ks][2], S[2 * ks][3]); t4.z = cvtpk(S[2 * ks + 1][0], S[2 * ks + 1][1]); t4.w = cvtpk(S[2 * ks + 1][2], S[2 * ks + 1][3]);
                sf[ks] = __builtin_bit_cast(bf16x8, t4); }
#pragma unroll
            for (int tb = 0; tb < 4; ++tb) { f32x4 acc = (f32x4){0.f, 0.f, 0.f, 0.f};
#pragma unroll
                for (int ks = 0; ks < 4; ++ks) { const LAS unsigned char* qp = lds + HG_QT + (16 * tb + l15) * HG_RS_ + (32 * ks + 4 * g) * 2;
                    const u32x2 q0 = *(const LAS u32x2*)qp, q1 = *(const LAS u32x2*)(qp + 32);
                    const u32x4 q4 = (u32x4){q0.x, q0.y, q1.x, q1.y};
                    acc = __builtin_amdgcn_mfma_f32_16x16x32_bf16(__builtin_bit_cast(bf16x8, q4), sf[ks], acc, 0, 0, 0); }
#pragma unroll
                for (int ss = 0; ss < 2; ++ss) { const bf16x8 af = *(const LAS bf16x8*)(lds + HG_SC + (16 * tb + l15) * HG_SCS + (32 * ss + 8 * g) * 2);
                    acc = __builtin_amdgcn_mfma_f32_16x16x32_bf16(af, vf[ss], acc, 0, 0, 0); }
                o[tb] = acc; }
        }
#pragma unroll
        for (int kb = 0; kb < 8; ++kb) {
#pragma unroll
            for (int ss = 0; ss < 2; ++ss) { const LAS unsigned char* kp = lds + HG_KT + (32 * ss + 8 * g + (l15 >> 2)) * HG_RS_ + (16 * kb + 4 * (l15 & 3)) * 2;
                const s16x4 lo = tr16(kp), hi = tr16(kp + 4 * HG_RS_); const bf16x8 af = (bf16x8){lo[0], lo[1], lo[2], lo[3], hi[0], hi[1], hi[2], hi[3]};
                S[kb] = __builtin_amdgcn_mfma_f32_16x16x32_bf16(af, vf[ss], S[kb], 0, 0, 0); }
            const f32x4 el = *(const LAS f32x4*)(lds + HG_EL + (16 * kb + 4 * g) * 4);
            S[kb] = S[kb] * el; }
#pragma unroll
        for (int tb = 0; tb < 4; ++tb)
#pragma unroll
            for (int r = 0; r < 4; ++r) *(LAS unsigned short*)(lds + HG_OUT + (16 * tb + 4 * g + r) * HG_RS_ + (16 * w + l15) * 2) = (unsigned short)(cvtpk(o[tb][r], 0.f) & 0xffffu);
        __syncthreads();
#pragma unroll
        for (int i = 0; i < 2; ++i) { const int q = tid + 512 * i, row = q >> 4, ch = q & 15;
            const u32x4 ov = *(const LAS u32x4*)(lds + HG_OUT + row * HG_RS_ + ch * 16);
            float x[8]; x[0] = bflo(ov.x); x[1] = bfhi(ov.x); x[2] = bflo(ov.y); x[3] = bfhi(ov.y); x[4] = bflo(ov.z); x[5] = bfhi(ov.z); x[6] = bflo(ov.w); x[7] = bfhi(ov.w);
            float ss = 0.f;
#pragma unroll
            for (int j = 0; j < 8; ++j) ss += x[j] * x[j];
            ss = row_sum(ss);
            const float rr = __builtin_amdgcn_rsqf(ss * (1.f / 128.f) + EPS);
            const u32x4 gv = gsr[i];
            u32x4 yo;
            yo.x = cvtpk(x[0] * rr * ngc[0] * bflo(gv.x), x[1] * rr * ngc[1] * bfhi(gv.x)); yo.y = cvtpk(x[2] * rr * ngc[2] * bflo(gv.y), x[3] * rr * ngc[3] * bfhi(gv.y));
            yo.z = cvtpk(x[4] * rr * ngc[4] * bflo(gv.z), x[5] * rr * ngc[5] * bfhi(gv.z)); yo.w = cvtpk(x[6] * rr * ngc[6] * bflo(gv.w), x[7] * rr * ngc[7] * bfhi(gv.w));
            *(u32x4*)(Y + (size_t)(c * 64 + row) * D + ch * 8) = yo; }
        if (c + 1 < SEQ / 64) HG_STORE();
        if (wdo) wconv_store(a, wv, wit, lane, lds + EPI_SCR + w * 2048);
    }
    __syncthreads();
#undef HG_LOAD
#undef HG_STORE
}

constexpr int AT_BUF = 32768, AT_LUT = MISC_OFF + 4096, AT_WS = MISC_OFF + 6144, AT_TKT = MISC_OFF + 8192;
__device__ __forceinline__ int crow(int r, int hi) { return (r & 3) + 8 * (r >> 2) + 4 * hi; }
__device__ __forceinline__ int t5_bucket(int n) {
    if (n < 16) return n;
    int b = 16;
    b += (n >= 19); b += (n >= 21); b += (n >= 24); b += (n >= 27); b += (n >= 31); b += (n >= 35); b += (n >= 40); b += (n >= 46);
    b += (n >= 52); b += (n >= 59); b += (n >= 67); b += (n >= 77); b += (n >= 87); b += (n >= 99); b += (n >= 113);
    return b;
}
__device__ __forceinline__ float fmax_nc(float x, float y) { return __builtin_amdgcn_fmed3f(x, y, INFINITY); }
#define AT_SB() __builtin_amdgcn_sched_barrier(0)

__device__ __forceinline__ void at_qk(f32x16& p0, f32x16& p1, const LAS unsigned char* kb, const bf16x8 (&qf)[4]) {
    bf16x8 kf[8];
#pragma unroll
    for (int d0 = 0; d0 < 4; ++d0) { kf[2 * d0] = *(const LAS bf16x8*)(kb + d0 * 2048); kf[2 * d0 + 1] = *(const LAS bf16x8*)(kb + d0 * 2048 + 512); }
#pragma unroll
    for (int r = 0; r < 16; ++r) { p0[r] = 0.f; p1[r] = 0.f; }
#pragma unroll
    for (int d0 = 0; d0 < 4; ++d0) { p0 = __builtin_amdgcn_mfma_f32_32x32x16_bf16(kf[2 * d0], qf[d0], p0, 0, 0, 0); p1 = __builtin_amdgcn_mfma_f32_32x32x16_bf16(kf[2 * d0 + 1], qf[d0], p1, 0, 0, 0); }
}
__device__ __forceinline__ bf16x8 at_vfrag(const LAS unsigned char* vb, int db, int ks) {
    const s16x4 lo = tr16(vb + db * 4096 + ks * 1024), hh = tr16(vb + db * 4096 + ks * 1024 + 512);
    return (bf16x8){lo[0], lo[1], lo[2], lo[3], hh[0], hh[1], hh[2], hh[3]};
}
__device__ __forceinline__ bf16x8 at_kfrag(const LAS unsigned char* kb, int i) { return *(const LAS bf16x8*)(kb + (i >> 1) * 2048 + (i & 1) * 512); }
__device__ __forceinline__ float at_rowmax(const f32x16& c0, const f32x16& c1) {
    float a, b2;
    asm volatile("s_nop 15\n\ts_nop 7\n\tv_max3_f32 %0, %1, %2, %3" : "=v"(a) : "v"(c0[0]), "v"(c0[1]), "v"(c1[0]));
    asm volatile("v_max3_f32 %0, %1, %2, %3" : "=v"(b2) : "v"(c0[2]), "v"(c0[3]), "v"(c1[1]));
    asm volatile("v_max3_f32 %0, %1, %2, %3" : "=v"(a) : "v"(a), "v"(c1[2]), "v"(c1[3]));
#pragma unroll
    for (int r = 4; r < 16; r += 4) {
        asm volatile("v_max3_f32 %0, %1, %2, %3" : "=v"(a) : "v"(a), "v"(c0[r]), "v"(c0[r + 1]));
        asm volatile("v_max3_f32 %0, %1, %2, %3" : "=v"(b2) : "v"(b2), "v"(c0[r + 2]), "v"(c0[r + 3]));
        asm volatile("v_max3_f32 %0, %1, %2, %3" : "=v"(a) : "v"(a), "v"(c1[r]), "v"(c1[r + 1]));
        asm volatile("v_max3_f32 %0, %1, %2, %3" : "=v"(b2) : "v"(b2), "v"(c1[r + 2]), "v"(c1[r + 3]));
    }
    float m;
    asm volatile("v_max_f32_e32 %0, %1, %2" : "=v"(m) : "v"(a), "v"(b2));
    return fmaxf(m, __shfl_xor(m, 32));
}
constexpr float AT_THR = 6.0f;
#define AT_PK2(P, i) cvtpk(P[i], P[i + 1])

__device__ __forceinline__ void at_step(f32x16& C0, f32x16& C1, const f32x16& P0, const f32x16& P1, f32x16 (&O)[4], const bf16x8 (&qf)[4],
                                        const __amdgpu_buffer_rsrc_t prs, const unsigned k_voff, const unsigned v_voff, const unsigned so0, u32x4 (&pk)[2], u32x4 (&pv)[2],
                                        const LAS unsigned char* kb, const LAS unsigned char* vbp, const LAS unsigned char* kbn,
                                        float& mhat, float& l_reg, bool& resc, const LAS float* lut, bool band, LAS float* wsf, int r32, int hi) {
    bf16x8 va[4], vb[4];
    u32x4 pw0, pw1, pw2, pw3;
    float sacc = 0.f;
    f32x16 z16;
#pragma unroll
    for (int r = 0; r < 16; ++r) z16[r] = 0.f;
    bf16x8 k0 = at_kfrag(kb, 0), k1 = at_kfrag(kb, 1);
    __builtin_amdgcn_s_setprio(1);
    C0 = __builtin_amdgcn_mfma_f32_32x32x16_bf16(k0, qf[0], z16, 0, 0, 0); k0 = at_kfrag(kb, 2); va[0] = at_vfrag(vbp, 0, 0);
    sacc += (P0[0] + P0[1]) + (P0[2] + P0[3]); pw0.x = AT_PK2(P0, 0); pw0.y = AT_PK2(P0, 2); AT_SB();
    C1 = __builtin_amdgcn_mfma_f32_32x32x16_bf16(k1, qf[0], z16, 0, 0, 0); k1 = at_kfrag(kb, 3); va[1] = at_vfrag(vbp, 0, 1);
    sacc += (P0[4] + P0[5]) + (P0[6] + P0[7]); pw0.z = AT_PK2(P0, 4); pw0.w = AT_PK2(P0, 6); AT_SB();
    C0 = __builtin_amdgcn_mfma_f32_32x32x16_bf16(k0, qf[1], C0, 0, 0, 0); k0 = at_kfrag(kb, 4); va[2] = at_vfrag(vbp, 0, 2);
    sacc += (P0[8] + P0[9]) + (P0[10] + P0[11]); pw1.x = AT_PK2(P0, 8); pw1.y = AT_PK2(P0, 10); AT_SB();
    C1 = __builtin_amdgcn_mfma_f32_32x32x16_bf16(k1, qf[1], C1, 0, 0, 0); k1 = at_kfrag(kb, 5); va[3] = at_vfrag(vbp, 0, 3);
    sacc += (P0[12] + P0[13]) + (P0[14] + P0[15]); pw1.z = AT_PK2(P0, 12); pw1.w = AT_PK2(P0, 14); AT_SB();
    C0 = __builtin_amdgcn_mfma_f32_32x32x16_bf16(k0, qf[2], C0, 0, 0, 0); k0 = at_kfrag(kb, 6);
    sacc += (P1[0] + P1[1]) + (P1[2] + P1[3]); pw2.x = AT_PK2(P1, 0); pw2.y = AT_PK2(P1, 2); AT_SB();
    C1 = __builtin_amdgcn_mfma_f32_32x32x16_bf16(k1, qf[2], C1, 0, 0, 0); k1 = at_kfrag(kb, 7);
    sacc += (P1[4] + P1[5]) + (P1[6] + P1[7]); pw2.z = AT_PK2(P1, 4); pw2.w = AT_PK2(P1, 6); AT_SB();
    C0 = __builtin_amdgcn_mfma_f32_32x32x16_bf16(k0, qf[3], C0, 0, 0, 0);
    sacc += (P1[8] + P1[9]) + (P1[10] + P1[11]); pw3.x = AT_PK2(P1, 8); pw3.y = AT_PK2(P1, 10); AT_SB();
    C1 = __builtin_amdgcn_mfma_f32_32x32x16_bf16(k1, qf[3], C1, 0, 0, 0);
    sacc += (P1[12] + P1[13]) + (P1[14] + P1[15]); pw3.z = AT_PK2(P1, 12); pw3.w = AT_PK2(P1, 14); AT_SB();
    { bf16x8 kone, qneg;
      { u32x4 t4 = (u32x4){0u, 0u, 0u, 0u}; if (hi == 0) t4.x = 0x3F80u; kone = __builtin_bit_cast(bf16x8, t4);
        t4.x = 0u; if (hi == 0) t4.x = cvtpk(-mhat, 0.f) & 0xffffu; qneg = __builtin_bit_cast(bf16x8, t4); }
      C0 = __builtin_amdgcn_mfma_f32_32x32x16_bf16(kone, qneg, C0, 0, 0, 0);
      C1 = __builtin_amdgcn_mfma_f32_32x32x16_bf16(kone, qneg, C1, 0, 0, 0); } AT_SB();
    pk[0] = __builtin_bit_cast(u32x4, __builtin_amdgcn_raw_buffer_load_b128(prs, k_voff, so0, 0)); pv[0] = __builtin_bit_cast(u32x4, __builtin_amdgcn_raw_buffer_load_b128(prs, v_voff, so0, 0));
    pk[1] = __builtin_bit_cast(u32x4, __builtin_amdgcn_raw_buffer_load_b128(prs, k_voff, so0 + 32u * 512u, 0)); pv[1] = __builtin_bit_cast(u32x4, __builtin_amdgcn_raw_buffer_load_b128(prs, v_voff, so0 + 32u * 512u, 0));
    l_reg += sacc;
    __builtin_amdgcn_s_setprio(0);
    if (band) {
#pragma unroll
        for (int r = 0; r < 16; ++r) { const int ko = (r & 3) + 8 * (r >> 2); C0[r] += lut[-ko]; C1[r] += lut[-ko - 32]; }
    }
    const float rm = at_rowmax(C0, C1);
    resc = false;
    if (__any(rm > AT_THR)) {
        const float m_new = bf2f((unsigned short)(cvtpk(mhat + fmaxf(rm, 0.f), 0.f) & 0xffffu));
        const float dl = m_new - mhat;
        const float f = fast_exp2(-dl);
        l_reg *= f; if (hi == 0) wsf[r32] = f; mhat = m_new; resc = true;
#pragma unroll
        for (int r = 0; r < 16; ++r) { C0[r] -= dl; C1[r] -= dl; }
    }
    AT_SB();
    __builtin_amdgcn_s_setprio(1);
    const bf16x8 pa0 = __builtin_bit_cast(bf16x8, pw0), pa1 = __builtin_bit_cast(bf16x8, pw1), pa2 = __builtin_bit_cast(bf16x8, pw2), pa3 = __builtin_bit_cast(bf16x8, pw3);
#define AT_EX2(X, i) do { X[i] = fast_exp2(X[i]); X[i + 1] = fast_exp2(X[i + 1]); } while (0)
    O[0] = __builtin_amdgcn_mfma_f32_32x32x16_bf16(pa0, va[0], O[0], 0, 0, 0); vb[0] = at_vfrag(vbp, 1, 0); AT_EX2(C0, 0); AT_SB();
    O[0] = __builtin_amdgcn_mfma_f32_32x32x16_bf16(pa1, va[1], O[0], 0, 0, 0); vb[1] = at_vfrag(vbp, 1, 1); AT_EX2(C0, 2); AT_SB();
    O[0] = __builtin_amdgcn_mfma_f32_32x32x16_bf16(pa2, va[2], O[0], 0, 0, 0); vb[2] = at_vfrag(vbp, 1, 2); AT_EX2(C0, 4); AT_SB();
    O[0] = __builtin_amdgcn_mfma_f32_32x32x16_bf16(pa3, va[3], O[0], 0, 0, 0); vb[3] = at_vfrag(vbp, 1, 3); AT_EX2(C0, 6); AT_SB();
    O[1] = __builtin_amdgcn_mfma_f32_32x32x16_bf16(pa0, vb[0], O[1], 0, 0, 0); va[0] = at_vfrag(vbp, 2, 0); AT_EX2(C0, 8); AT_SB();
    O[1] = __builtin_amdgcn_mfma_f32_32x32x16_bf16(pa1, vb[1], O[1], 0, 0, 0); va[1] = at_vfrag(vbp, 2, 1); AT_EX2(C0, 10); AT_SB();
    O[1] = __builtin_amdgcn_mfma_f32_32x32x16_bf16(pa2, vb[2], O[1], 0, 0, 0); va[2] = at_vfrag(vbp, 2, 2); AT_EX2(C0, 12); AT_SB();
    O[1] = __builtin_amdgcn_mfma_f32_32x32x16_bf16(pa3, vb[3], O[1], 0, 0, 0); va[3] = at_vfrag(vbp, 2, 3); AT_EX2(C0, 14); AT_SB();
    O[2] = __builtin_amdgcn_mfma_f32_32x32x16_bf16(pa0, va[0], O[2], 0, 0, 0); vb[0] = at_vfrag(vbp, 3, 0); AT_EX2(C1, 0); AT_SB();
    O[2] = __builtin_amdgcn_mfma_f32_32x32x16_bf16(pa1, va[1], O[2], 0, 0, 0); vb[1] = at_vfrag(vbp, 3, 1); AT_EX2(C1, 2); AT_SB();
    O[2] = __builtin_amdgcn_mfma_f32_32x32x16_bf16(pa2, va[2], O[2], 0, 0, 0); vb[2] = at_vfrag(vbp, 3, 2); AT_EX2(C1, 4); AT_SB();
    O[2] = __builtin_amdgcn_mfma_f32_32x32x16_bf16(pa3, va[3], O[2], 0, 0, 0); vb[3] = at_vfrag(vbp, 3, 3); AT_EX2(C1, 6); AT_SB();
    O[3] = __builtin_amdgcn_mfma_f32_32x32x16_bf16(pa0, vb[0], O[3], 0, 0, 0); AT_EX2(C1, 8); AT_SB();
    O[3] = __builtin_amdgcn_mfma_f32_32x32x16_bf16(pa1, vb[1], O[3], 0, 0, 0); AT_EX2(C1, 10); AT_SB();
    O[3] = __builtin_amdgcn_mfma_f32_32x32x16_bf16(pa2, vb[2], O[3], 0, 0, 0); AT_EX2(C1, 12); AT_SB();
    O[3] = __builtin_amdgcn_mfma_f32_32x32x16_bf16(pa3, vb[3], O[3], 0, 0, 0); AT_EX2(C1, 14); AT_SB();
    __builtin_amdgcn_s_setprio(0);
#undef AT_EX2
}
__device__ __forceinline__ void at_rescale(f32x16 (&O)[4], const LAS float* wsf, int hi) {
#pragma unroll
    for (int gq = 0; gq < 4; ++gq) { const f32x4 al = *(const LAS f32x4*)(wsf + 8 * gq + 4 * hi);
#pragma unroll
        for (int db = 0; db < 4; ++db) { O[db][4 * gq + 0] *= al.x; O[db][4 * gq + 1] *= al.y; O[db][4 * gq + 2] *= al.z; O[db][4 * gq + 3] *= al.w; } }
}

__device__ __forceinline__ void attn_unit(const Frame& F, const Args& a, int bh, int qb, float lam) {
    const int b = bh >> 2, h = bh & 3;
    const bf16* KVb = (const bf16*)(a.ws + WS_KV) + (size_t)bh * SEQ * 256;
    const bf16* QCb = (const bf16*)(a.ws + WS_QC) + (size_t)bh * SEQ * 128;
    LAS unsigned char* lds = F.lds;
    int tid = F.tid; asm volatile("" : "+v"(tid));
    const int lane = tid & 63, w = F.wave, wq = w & 3, mc = w >> 2, r32 = lane & 31, hi = lane >> 5;
    const int q0 = qb * 128, NT = 2 * qb + 2;
    LAS float* wsf = (LAS float*)(lds + AT_WS + 256 * w);
    const int k_kv = ((tid >> 7) << 3) + (tid & 7), k_ch = (tid >> 3) & 15;
    const int k_lds = (k_ch >> 3) * 8192 + (k_ch & 7) * 1024 + k_kv * 16;
    const unsigned k_voff = (unsigned)(k_kv * 256 + k_ch * 8) * 2u;
    const int v_kv = (((tid >> 5) & 15) << 1) + ((tid >> 2) & 1), v_ch = (((tid >> 3) & 3) << 2) + (tid & 3);
    const int v_lds = 16384 + (v_ch >> 2) * 4096 + v_kv * 64 + (v_ch & 3) * 16;
    const unsigned v_voff = (unsigned)(v_kv * 256 + 128 + v_ch * 8) * 2u;
    const __amdgpu_buffer_rsrc_t prs = __builtin_amdgcn_make_buffer_rsrc((void*)KVb, (short)0, SEQ * 512, 0x00020000);
    u32x4 pk[2], pv[2];
#define AT_LOAD(j) do { _Pragma("unroll") for (int i = 0; i < 2; ++i) { const unsigned so = (unsigned)(((j) * 64 + 32 * i) * 512); \
        pk[i] = __builtin_bit_cast(u32x4, __builtin_amdgcn_raw_buffer_load_b128(prs, k_voff, so, 0)); pv[i] = __builtin_bit_cast(u32x4, __builtin_amdgcn_raw_buffer_load_b128(prs, v_voff, so, 0)); } } while (0)
#define AT_STORE(bufo) do { _Pragma("unroll") for (int i = 0; i < 2; ++i) { *(LAS u32x4*)(lds + (bufo) + k_lds + 32 * 16 * i) = pk[i]; *(LAS u32x4*)(lds + (bufo) + v_lds + 32 * 64 * i) = pv[i]; } } while (0)
    bf16x8 qf[4];
    { const bf16* qp = QCb + (size_t)(q0 + 32 * wq + r32) * 128 + mc * 64 + 8 * hi;
#pragma unroll
      for (int d0 = 0; d0 < 4; ++d0) qf[d0] = *(const bf16x8*)(qp + 16 * d0); }
    f32x16 O[4];
#pragma unroll
    for (int db = 0; db < 4; ++db)
#pragma unroll
        for (int r = 0; r < 16; ++r) O[db][r] = 0.f;
    float mhat = -INFINITY, l_reg = 0.f;
    {
        u32x4 qk[3][2], qv[3][2]; const int j2 = NT > 2 ? 2 : 1;
#pragma unroll
        for (int tl = 0; tl < 3; ++tl) { const int jt = tl < 2 ? tl : j2;
#pragma unroll
            for (int i = 0; i < 2; ++i) { const unsigned so = (unsigned)((jt * 64 + 32 * i) * 512);
                qk[tl][i] = __builtin_bit_cast(u32x4, __builtin_amdgcn_raw_buffer_load_b128(prs, k_voff, so, 0)); qv[tl][i] = __builtin_bit_cast(u32x4, __builtin_amdgcn_raw_buffer_load_b128(prs, v_voff, so, 0)); } }
#pragma unroll
        for (int tl = 0; tl < 3; ++tl)
#pragma unroll
            for (int i = 0; i < 2; ++i) { *(LAS u32x4*)(lds + tl * AT_BUF + k_lds + 32 * 16 * i) = qk[tl][i]; *(LAS u32x4*)(lds + tl * AT_BUF + v_lds + 32 * 64 * i) = qv[tl][i]; }
    }
    __syncthreads();
    const int koff = mc * 8192 + hi * 1024 + r32 * 16;
    const int voff = 16384 + ((lane >> 4) & 1) * 32 + (lane & 3) * 8 + (4 * hi + ((lane & 15) >> 2)) * 64;
    const LAS float* lutp = (const LAS float*)(lds + AT_LUT) + (q0 + 32 * wq + r32 + 127 - 4 * hi);
    f32x16 pA0, pA1, pB0, pB1;
    at_qk(pA0, pA1, lds + koff, qf);
    if (0 >= NT - 4) {
#pragma unroll
        for (int r = 0; r < 16; ++r) { const int ko = (r & 3) + 8 * (r >> 2); pA0[r] += lutp[-ko]; pA1[r] += lutp[-ko - 32]; }
    }
    mhat = bf2f((unsigned short)(cvtpk(at_rowmax(pA0, pA1), 0.f) & 0xffffu));
#pragma unroll
    for (int r = 0; r < 16; ++r) { pA0[r] = fast_exp2(pA0[r] - mhat); pA1[r] = fast_exp2(pA1[r] - mhat); }
    bool resc = false;
#define AT_SLOT(t) (((t) & 3) * AT_BUF)
#define AT_STEP(CA, CB, PA, PB, t) do { const int jl_ = ((t) + 2 < NT) ? (t) + 2 : NT - 1; \
        at_step(CA, CB, PA, PB, O, qf, prs, k_voff, v_voff, (unsigned)(jl_ * 64 * 512), pk, pv, lds + AT_SLOT(t) + koff, lds + AT_SLOT((t) - 1) + voff, lds + AT_SLOT((t) + 1) + koff, mhat, l_reg, resc, lutp - 64 * (t), (t) >= NT - 4, wsf, r32, hi); \
        AT_STORE(AT_SLOT((t) + 2)); __syncthreads(); if (resc) at_rescale(O, wsf, hi); } while (0)
    int t = 1;
    for (; t + 1 < NT; t += 2) { AT_STEP(pB0, pB1, pA0, pA1, t); AT_STEP(pA0, pA1, pB0, pB1, t + 1); }
    AT_STEP(pB0, pB1, pA0, pA1, t);
    {
        float sacc = 0.f;
#pragma unroll
        for (int r = 0; r < 16; ++r) sacc += pB0[r] + pB1[r];
        l_reg += sacc;
        u32x4 q4; bf16x8 pa[4];
        q4.x = AT_PK2(pB0, 0); q4.y = AT_PK2(pB0, 2); q4.z = AT_PK2(pB0, 4); q4.w = AT_PK2(pB0, 6); pa[0] = __builtin_bit_cast(bf16x8, q4);
        q4.x = AT_PK2(pB0, 8); q4.y = AT_PK2(pB0, 10); q4.z = AT_PK2(pB0, 12); q4.w = AT_PK2(pB0, 14); pa[1] = __builtin_bit_cast(bf16x8, q4);
        q4.x = AT_PK2(pB1, 0); q4.y = AT_PK2(pB1, 2); q4.z = AT_PK2(pB1, 4); q4.w = AT_PK2(pB1, 6); pa[2] = __builtin_bit_cast(bf16x8, q4);
        q4.x = AT_PK2(pB1, 8); q4.y = AT_PK2(pB1, 10); q4.z = AT_PK2(pB1, 12); q4.w = AT_PK2(pB1, 14); pa[3] = __builtin_bit_cast(bf16x8, q4);
        const LAS unsigned char* vbp = lds + AT_SLOT(NT - 1) + voff;
#pragma unroll
        for (int db = 0; db < 4; ++db)
#pragma unroll
            for (int ks = 0; ks < 4; ++ks) O[db] = __builtin_amdgcn_mfma_f32_32x32x16_bf16(pa[ks], at_vfrag(vbp, db, ks), O[db], 0, 0, 0);
    }
    __syncthreads();
    l_reg = sum_x32(l_reg, l_reg);
    { const float sc = (mc == 0 ? 1.f : lam) * fast_rcp(l_reg);
      if (hi == 0) wsf[r32] = sc;
      at_rescale(O, wsf, hi); }
    LAS float* ex = (LAS float*)lds + (mc * 4 + wq) * 4096;
#pragma unroll
    for (int db = 0; db < 4; ++db)
#pragma unroll
        for (int r = 0; r < 16; ++r) ex[crow(r, hi) * 128 + 32 * db + r32] = O[db][r];
    __syncthreads();
    {
        const int l15 = lane & 15, lr = lane >> 4;
        float gv[8];
        { const float* sg = a.in[11] + 8 * l15;
#pragma unroll
          for (int i = 0; i < 8; ++i) gv[i] = sg[i] * 0.8f; }
        bf16* Y = (bf16*)(a.ws + WS_Y) + (size_t)(b * SEQ + q0) * D + h * 128 + 8 * l15;
#pragma unroll
        for (int p = 0; p < 4; ++p) { const int R = 16 * w + 4 * p + lr;
            const LAS float* pa = (const LAS float*)lds + (R >> 5) * 4096 + (R & 31) * 128 + 8 * l15; const LAS float* pb = pa + 4 * 4096;
            const f32x4 a0 = *(const LAS f32x4*)pa, a1 = *(const LAS f32x4*)(pa + 4), b0 = *(const LAS f32x4*)pb, b1 = *(const LAS f32x4*)(pb + 4);
            const f32x4 o0 = a0 - b0, o1 = a1 - b1;
            float ss = (o0.x * o0.x + o0.y * o0.y) + (o0.z * o0.z + o0.w * o0.w) + (o1.x * o1.x + o1.y * o1.y) + (o1.z * o1.z + o1.w * o1.w);
            ss = row_sum(ss);
            const float rr = __builtin_amdgcn_rsqf(ss * (1.f / 128.f) + EPS);
            u32x4 yo;
            yo.x = cvtpk(o0.x * rr * gv[0], o0.y * rr * gv[1]); yo.y = cvtpk(o0.z * rr * gv[2], o0.w * rr * gv[3]);
            yo.z = cvtpk(o1.x * rr * gv[4], o1.y * rr * gv[5]); yo.w = cvtpk(o1.z * rr * gv[6], o1.w * rr * gv[7]);
            *(u32x4*)(Y + (size_t)R * D) = yo; }
    }
    __syncthreads();
#undef AT_LOAD
#undef AT_STORE
#undef AT_SLOT
#undef AT_STEP
}

__device__ __forceinline__ void p2_mixers(const Frame& F, const Args& a) {
    float lam;
    { const float v1 = a.in[7][F.lane] * a.in[8][F.lane], v2 = a.in[9][F.lane] * a.in[10][F.lane];
      lam = __expf(wave_sum(v1)) - __expf(wave_sum(v2)) + 0.2f; }
    const int per = F.G / 32;
    if (per < 1) return;
    const int bh = F.vcu / per, s = F.vcu % per;
    if (bh >= 32) return;
    { const int h = bh & 3; const float* tab = a.in[12]; const float t31 = tab[31 * 4 + h];
      for (int i = F.tid; i < 384; i += NTHREADS) { const int dist = i - 127; ((LAS float*)(F.lds + AT_LUT))[i] = dist < 0 ? -INFINITY : (tab[t5_bucket(dist) * 4 + h] - t31) * LOG2E; } }
    if (s == 0) hgrn_stream(F, a, bh);
    constexpr int NDYN = 14;
    if (s >= 1) {
        const int na = per - 1;
        for (int k = 0; k * na < 64 - NDYN; ++k) {
            const int idx = k * na + ((k & 1) ? (na - s) : (s - 1));
            if (idx < 64 - NDYN) attn_unit(F, a, bh, 63 - idx, lam);
        }
    }
    {
        unsigned* qhead = (unsigned*)(a.ws + WS_CTL) + CW_Q + 64 * bh;
        LAS unsigned* tk = (LAS unsigned*)(F.lds + AT_TKT);
        for (;;) {
            if (F.tid == 0) *tk = __hip_atomic_fetch_add(qhead, 1u, __ATOMIC_RELAXED, __HIP_MEMORY_SCOPE_AGENT);
            __syncthreads();
            const unsigned t = *tk;
            __syncthreads();
            if (t >= (unsigned)NDYN) break;
            attn_unit(F, a, bh, NDYN - 1 - (int)t, lam);
        }
    }
}

constexpr int RT_W = 0, RT_HIST = 73728, RT_BASE = 73856;
__device__ __forceinline__ void p4_router(const Frame& F, const Args& a) {
    LAS unsigned char* lds = F.lds;
    const float* wg = a.in[16]; const float* bg = a.in[17]; const float* we = a.in[18]; const float* be = a.in[19];
    for (int i = F.tid; i < 4 * 1024; i += NTHREADS) { const int d = i >> 2, e = i & 3;
        ((LAS unsigned short*)(lds + RT_W))[e * 1024 + d] = (unsigned short)(cvtpk(wg[i], 0.f) & 0xffffu); }
    for (int i = F.tid; i < 32 * 1024; i += NTHREADS) { const int d = i >> 5, e = i & 31;
        ((LAS unsigned short*)(lds + RT_W))[(4 + e) * 1024 + d] = (unsigned short)(cvtpk(we[i], 0.f) & 0xffffu); }
    if (F.tid < 32) ((LAS unsigned*)(lds + RT_HIST))[F.tid] = 0u;
    __syncthreads();
    const bf16* x1 = (const bf16*)(a.ws + WS_X1B); const float* ng = a.in[5]; const float* mod = (const float*)(a.ws + WS_MOD);
    bf16* H = (bf16*)(a.ws + WS_H);
    const int gw = F.vcu * NWAVES + F.wave, NGW = F.G * NWAVES, lane = F.lane;
    int my_tok = -1, my_e0 = 0, my_e1 = 0; float my_w0 = 0.f, my_w1 = 0.f;
    const int per = (NTOK + NGW - 1) / NGW;
    const int m0 = gw * per, m1 = (m0 + per < NTOK) ? m0 + per : NTOK;
    int it = 0;
    for (int s0 = m0; s0 < m1; ) {
      const int b = s0 >> 13, e1 = ((b + 1) << 13) < m1 ? ((b + 1) << 13) : m1;
      f32x4 ga[4], sha[4];
      { const f32x4* gp = (const f32x4*)ng + lane; const f32x4* shp = (const f32x4*)(mod + b * 6144 + 3072) + lane; const f32x4* scp = (const f32x4*)(mod + b * 6144 + 4096) + lane;
#pragma unroll
        for (int j = 0; j < 4; ++j) { ga[j] = gp[64 * j] * (scp[64 * j] + 1.f); sha[j] = shp[64 * j]; } }
      u32x2 nxv[4];
      { const u32x2* xr = (const u32x2*)(x1 + (size_t)s0 * D) + lane;
#pragma unroll
        for (int j = 0; j < 4; ++j) nxv[j] = xr[64 * j]; }
      for (int m = s0; m < e1; ++m, ++it) {
        f32x4 v[4]; float s = 0.f;
#pragma unroll
        for (int j = 0; j < 4; ++j) { const u32x2 xv = nxv[j]; v[j] = (f32x4){bflo(xv.x), bfhi(xv.x), bflo(xv.y), bfhi(xv.y)}; s += (v[j].x * v[j].x + v[j].y * v[j].y) + (v[j].z * v[j].z + v[j].w * v[j].w); }
        { const int mn = (m + 1 < e1) ? m + 1 : m; const u32x2* xr = (const u32x2*)(x1 + (size_t)mn * D) + lane;
#pragma unroll
          for (int j = 0; j < 4; ++j) nxv[j] = xr[64 * j]; }
        const float r = __builtin_amdgcn_rsqf(wave_sum(s) * (1.f / D) + EPS);
        u32x2* o8 = (u32x2*)(H + (size_t)m * D) + lane;
        u32x2 hp[4];
#pragma unroll
        for (int j = 0; j < 4; ++j) {
            v[j] = v[j] * r * ga[j] + sha[j];
            u32x2 o; o.x = cvtpk(v[j].x, v[j].y); o.y = cvtpk(v[j].z, v[j].w); o8[64 * j] = o; asm("" : "+v"(o.x), "+v"(o.y)); hp[j] = o; }
        asm volatile("" ::: "memory");
        float lg[4];
#pragma unroll
        for (int e = 0; e < 4; ++e) { float acc = 0.f;
#pragma unroll
            for (int j = 0; j < 4; ++j) { const u32x2 wv = *(const LAS u32x2*)(lds + RT_W + (e * 1024 + 256 * j + 4 * lane) * 2);
                acc = dot2bf(wv.x, hp[j].x, acc); acc = dot2bf(wv.y, hp[j].y, acc); }
            lg[e] = wave_sum(acc) + bg[e]; }
        int gi = 0; float gm = lg[0];
#pragma unroll
        for (int i = 1; i < 4; ++i) if (lg[i] > gm) { gm = lg[i]; gi = i; }
        gi = __builtin_amdgcn_readfirstlane(gi);
        float gs = 0.f;
#pragma unroll
        for (int i = 0; i < 4; ++i) gs += __expf(lg[i] - gm);
        const float gate = 1.f / gs;
        float pe[8];
        { const LAS unsigned char* wb_ = lds + RT_W + (size_t)(4 + gi * 8) * 2048;
#pragma unroll
          for (int e = 0; e < 8; ++e) { float acc = 0.f;
#pragma unroll
              for (int j = 0; j < 4; ++j) { const u32x2 wv = *(const LAS u32x2*)(wb_ + (e * 1024 + 256 * j + 4 * lane) * 2);
                  acc = dot2bf(wv.x, hp[j].x, acc); acc = dot2bf(wv.y, hp[j].y, acc); }
              pe[e] = acc; } }
        float t4[4], t2[2], t1;
#pragma unroll
        for (int i = 0; i < 4; ++i) t4[i] = sum_x32(pe[i], pe[i + 4]);
#pragma unroll
        for (int i = 0; i < 2; ++i) t2[i] = sum_x16(t4[i], t4[i + 2]);
        { const bool up = (lane & 8) != 0; const float keep = up ? t2[1] : t2[0], send = up ? t2[0] : t2[1]; t1 = keep + dppf<0x128>(send); }
        t1 += dppf<0xB1>(t1); t1 += dppf<0x4E>(t1); t1 += dppf<0x141>(t1);
        float el[8];
#pragma unroll
        for (int i = 0; i < 8; ++i) el[i] = __builtin_bit_cast(float, __builtin_amdgcn_readlane(__builtin_bit_cast(int, t1), 8 * ((i & 1) + 2 * ((i >> 1) & 1) + 4 * ((i >> 2) & 1)))) + be[gi * 8 + i];
        int ia = 0; float va = el[0];
#pragma unroll
        for (int i = 1; i < 8; ++i) if (el[i] > va) { va = el[i]; ia = i; }
        int ib = -1; float vb = -INFINITY;
#pragma unroll
        for (int i = 0; i < 8; ++i) if (i != ia && el[i] > vb) { vb = el[i]; ib = i; }
        const float wa = gate / (1.f + __expf(vb - va)), wb = gate - wa;
        if (lane == it) { my_tok = m; my_e0 = gi * 8 + ia; my_e1 = gi * 8 + ib; my_w0 = wa; my_w1 = wb; }
      }
      s0 = e1;
    }
    LAS unsigned* hist = (LAS unsigned*)(lds + RT_HIST); LAS unsigned* base = (LAS unsigned*)(lds + RT_BASE);
    unsigned r0 = 0, r1 = 0;
    if (my_tok >= 0) { r0 = atomicAdd((unsigned*)hist + my_e0, 1u); r1 = atomicAdd((unsigned*)hist + my_e1, 1u); }
    __syncthreads();
    unsigned* cnt = (unsigned*)(a.ws + WS_CTL) + CW_CNT;
    if (F.tid < 32) { const unsigned hv = hist[F.tid]; base[F.tid] = hv ? __hip_atomic_fetch_add(cnt + F.tid, hv, __ATOMIC_RELAXED, __HIP_MEMORY_SCOPE_AGENT) : 0u; }
    __syncthreads();
    if (my_tok >= 0) {
        int* list = (int*)(a.ws + WS_LIST); float* tw = (float*)(a.ws + WS_TOKW);
        const int p0_ = (int)(base[my_e0] + r0), p1_ = (int)(base[my_e1] + r1);
        list[(size_t)my_e0 * NTOK + p0_] = my_tok * 2;
        list[(size_t)my_e1 * NTOK + p1_] = my_tok * 2 + 1;
        tw[my_tok * 2] = my_w0; tw[my_tok * 2 + 1] = my_w1;
        int* toks = (int*)(a.ws + WS_TOKS);
        toks[my_tok * 2] = (my_e0 << 20) | p0_; toks[my_tok * 2 + 1] = (my_e1 << 20) | p1_;
    }
}

constexpr int MOE_CNTL = MISC_OFF + 256, MOE_LTOK = MISC_OFF + 4096, MOE_MAXU = 12;
struct MoeOrder {
    const LAS int* pre; const LAS int* cntl; const LAS int* ltok; const int* list; int G, c, lane; bool gather;
    __device__ __forceinline__ bool next(int i, pg8::Unit& u) const {
        const int total = pre[32];
        int rt, pn;
        if (G == 256) {
            rt = (i * 8 + (c & 7)) * 8 + ((c >> 3) & 7); pn = c >> 6;
            if (rt >= total) return false;
        } else { const long L = (long)i * G + c; if (L >= (long)total * 4) return false; rt = (int)(L >> 2); pn = (int)(L & 3); }
        const int e = __builtin_popcountll(__ballot(pre[(lane & 31) + 1] <= rt) & 0xffffffffull);
        u.e = e; u.pm = rt; u.pn = e * 4 + pn; u.r0 = (rt - pre[e]) * 256; const int n = cntl[e] - u.r0; u.nrows = n < 256 ? n : 256; u.slot = i; return true;
    }
    __device__ __forceinline__ int arow(const pg8::Unit& u, int r) const {
        if (!gather) return u.pm * 256 + r;
        if (u.slot < MOE_MAXU) return ltok[u.slot * 256 + r];
        return r < u.nrows ? (list[(size_t)u.e * NTOK + u.r0 + r] >> 1) : 0;
    }
};
struct EpiSwiGLU {
    static constexpr bool PERM = true;
    static constexpr int NST = 8;
    bf16* act;
    LAS unsigned char* scr;
    __device__ __forceinline__ void operator()(const f32x4 (&acc)[2][2][4][2], const pg8::Unit& u, int wr, int wc, int fr, int fq) const {
        LAS unsigned char* ws_ = scr + (wr * 4 + wc) * 2048;
        const int l = fr + 16 * fq, r8 = l >> 3, c8 = l & 7;
        bf16* base = act + (size_t)(u.pm * 256 + wr * 64 + (c8 >> 2) * 16 + r8) * FF + (u.pn & 3) * 128 + wc * 32 + 8 * (c8 & 3);
        u32x4 rq[2][2];
#pragma unroll
        for (int it = 0; it <= 4; ++it) {
            if (it < 4) { const int ai = it >> 1, m2 = it & 1; u32x4 w[2];
#pragma unroll
                for (int q = 0; q < 2; ++q) { const int m = 2 * m2 + q; const f32x4 a0 = acc[ai][0][m][0], a1 = acc[ai][0][m][1], b0 = acc[ai][1][m][0], b1 = acc[ai][1][m][1];
                    w[q].x = cvtpk(siluf_(a0.x) * b0.x, siluf_(a0.y) * b0.y); w[q].y = cvtpk(siluf_(a0.z) * b0.z, siluf_(a0.w) * b0.w);
                    w[q].z = cvtpk(siluf_(a1.x) * b1.x, siluf_(a1.y) * b1.y); w[q].w = cvtpk(siluf_(a1.z) * b1.z, siluf_(a1.w) * b1.w); }
                pg8::xpose128(ws_, fr, fq, w[0], w[1], rq[it & 1][0], rq[it & 1][1]); }
            if (it > 0) { const int ai = (it - 1) >> 1, m2 = (it - 1) & 1;
                bf16* rowp = base + (size_t)(ai * 128 + m2 * 32) * FF;
                *(u32x4*)rowp = rq[(it - 1) & 1][0]; *(u32x4*)(rowp + (size_t)8 * FF) = rq[(it - 1) & 1][1]; } }
    }
};
struct EpiScatter {
    static constexpr bool PERM = true;
    static constexpr int NST = 16;
    bf16* ybuf;
    LAS unsigned char* scr;
    __device__ __forceinline__ void operator()(const f32x4 (&acc)[2][2][4][2], const pg8::Unit& u, int wr, int wc, int fr, int fq) const {
        LAS unsigned char* ws_ = scr + (wr * 4 + wc) * 2048;
        const int l = fr + 16 * fq, r8 = l >> 3, c8 = l & 7;
        bf16* base = ybuf + (size_t)(u.pm * 256 + wr * 64 + r8) * D + (u.pn & 3) * 256 + wc * 64 + 8 * c8;
        u32x4 rq[2][2];
#pragma unroll
        for (int it = 0; it <= 8; ++it) {
            if (it < 8) { const int ai = it >> 2, m = it & 3; u32x4 w[2];
#pragma unroll
                for (int bj = 0; bj < 2; ++bj) { const f32x4 v0 = acc[ai][bj][m][0], v1 = acc[ai][bj][m][1];
                    w[bj].x = cvtpk(v0.x, v0.y); w[bj].y = cvtpk(v0.z, v0.w); w[bj].z = cvtpk(v1.x, v1.y); w[bj].w = cvtpk(v1.z, v1.w); }
                pg8::xpose128(ws_, fr, fq, w[0], w[1], rq[it & 1][0], rq[it & 1][1]); }
            if (it > 0) { const int ai = (it - 1) >> 2, m = (it - 1) & 3;
                bf16* rowp = base + (size_t)(ai * 128 + m * 16) * D;
                *(u32x4*)rowp = rq[(it - 1) & 1][0]; *(u32x4*)(rowp + (size_t)8 * D) = rq[(it - 1) & 1][1]; } }
    }
};

__device__ __forceinline__ void p7_final(const Frame& F, const Args& a) {
    float* out = a.out; const float* fg = a.in[23]; const float* mod = (const float*)(a.ws + WS_MOD);
    const bf16* yb = (const bf16*)(a.ws + WS_YBUF); const float* tw = (const float*)(a.ws + WS_TOKW); const int* toks = (const int*)(a.ws + WS_TOKS); const bf16* x1b = (const bf16*)(a.ws + WS_X1B);
    const int gw = F.vcu * NWAVES + F.wave, NGW = F.G * NWAVES, lane = F.lane;
    const int per = (NTOK + NGW - 1) / NGW;
    const int m0 = gw * per, m1 = (m0 + per < NTOK) ? m0 + per : NTOK;
    if (m0 >= NTOK) return;
    const int prev = ((const LAS int*)(F.lds + MISC_OFF))[lane & 31];
    u32x4 nx[2], ny0[2], ny1[2];
#define P7_ROW(sv) (__builtin_amdgcn_readlane(prev, (sv) >> 20) * 256 + ((sv) & 0xFFFFF))
#define P7_LOAD(mm, ra, rb) do { _Pragma("unroll") for (int j = 0; j < 2; ++j) { nx[j] = *((const u32x4*)(x1b + (size_t)(mm) * D) + lane + 64 * j); \
        ny0[j] = *((const u32x4*)(yb + (size_t)(ra) * D) + lane + 64 * j); ny1[j] = *((const u32x4*)(yb + (size_t)(rb) * D) + lane + 64 * j); } } while (0)
    f32x4 fgr[2][2];
#pragma unroll
    for (int j = 0; j < 2; ++j) { const f32x4* gp = (const f32x4*)(fg + 512 * j) + 2 * lane; fgr[j][0] = gp[0]; fgr[j][1] = gp[1]; }
    for (int s0 = m0; s0 < m1; ) {
        const int b = s0 >> 13; int e1 = ((b + 1) << 13) < m1 ? ((b + 1) << 13) : m1; if (e1 > s0 + 32) e1 = s0 + 32;
        const int nrow = e1 - s0;
        const int tv = (lane < 2 * nrow) ? toks[2 * s0 + lane] : 0; const float wv = (lane < 2 * nrow) ? tw[2 * s0 + lane] : 0.f;
        f32x4 g2r[2][2];
#pragma unroll
        for (int j = 0; j < 2; ++j) { const f32x4* g2p = (const f32x4*)(mod + b * 6144 + 5120 + 512 * j) + 2 * lane; g2r[j][0] = g2p[0]; g2r[j][1] = g2p[1]; }
        { const int sa = __builtin_amdgcn_readlane(tv, 0), sb = __builtin_amdgcn_readlane(tv, 1); P7_LOAD(s0, P7_ROW(sa), P7_ROW(sb)); }
        for (int i = 0; i < nrow; ++i) { const int m = s0 + i;
            u32x4 cx[2], cy0[2], cy1[2];
#pragma unroll
            for (int j = 0; j < 2; ++j) { cx[j] = nx[j]; cy0[j] = ny0[j]; cy1[j] = ny1[j]; }
            { const int in_ = (i + 1 < nrow) ? i + 1 : i; const int sa = __builtin_amdgcn_readlane(tv, 2 * in_), sb = __builtin_amdgcn_readlane(tv, 2 * in_ + 1); P7_LOAD(s0 + in_, P7_ROW(sa), P7_ROW(sb)); }
            const float w0 = __builtin_bit_cast(float, __builtin_amdgcn_readlane(__builtin_bit_cast(int, wv), 2 * i)), w1 = __builtin_bit_cast(float, __builtin_amdgcn_readlane(__builtin_bit_cast(int, wv), 2 * i + 1));
            float v[2][8]; float s = 0.f;
#pragma unroll
            for (int j = 0; j < 2; ++j) { const f32x4 ga = g2r[j][0], gb = g2r[j][1];
                const float g2[8] = {ga.x, ga.y, ga.z, ga.w, gb.x, gb.y, gb.z, gb.w};
                const unsigned xw[4] = {cx[j].x, cx[j].y, cx[j].z, cx[j].w}, aw[4] = {cy0[j].x, cy0[j].y, cy0[j].z, cy0[j].w}, bw[4] = {cy1[j].x, cy1[j].y, cy1[j].z, cy1[j].w};
#pragma unroll
                for (int k = 0; k < 4; ++k) { const float mm0 = w0 * bflo(aw[k]) + w1 * bflo(bw[k]), mm1 = w0 * bfhi(aw[k]) + w1 * bfhi(bw[k]);
                    v[j][2 * k] = bflo(xw[k]) + g2[2 * k] * mm0; v[j][2 * k + 1] = bfhi(xw[k]) + g2[2 * k + 1] * mm1;
                    s += v[j][2 * k] * v[j][2 * k] + v[j][2 * k + 1] * v[j][2 * k + 1]; } }
            const float r = __builtin_amdgcn_rsqf(wave_sum(s) * (1.f / D) + EPS);
#pragma unroll
            for (int j = 0; j < 2; ++j) { const f32x4 ga = fgr[j][0], gb = fgr[j][1];
                f32x4* op = (f32x4*)(out + (size_t)m * D + 512 * j) + 2 * lane;
                op[0] = (f32x4){v[j][0] * r * ga.x, v[j][1] * r * ga.y, v[j][2] * r * ga.z, v[j][3] * r * ga.w};
                op[1] = (f32x4){v[j][4] * r * gb.x, v[j][5] * r * gb.y, v[j][6] * r * gb.z, v[j][7] * r * gb.w}; }
        }
        s0 = e1;
    }
#undef P7_LOAD
#undef P7_ROW
}

constexpr unsigned long long P1_CPERM = 0x0ull | (0ull << 0) | (1ull << 4) | (2ull << 8) | (3ull << 12) | (4ull << 16) | (5ull << 20) | (10ull << 24) | (11ull << 28)
                                       | (6ull << 32) | (7ull << 36) | (12ull << 40) | (13ull << 44) | (8ull << 48) | (9ull << 52) | (15ull << 60);
constexpr unsigned long long P1_CPERM1 = (8ull << 0) | (9ull << 4) | (0ull << 8) | (1ull << 12) | (2ull << 16) | (3ull << 20) | (4ull << 24) | (5ull << 28)
                                        | (10ull << 32) | (11ull << 36) | (6ull << 40) | (7ull << 44) | (12ull << 48) | (13ull << 52) | (15ull << 60);
#define LOAD_ARGS(la) Args la; { const __attribute__((address_space(4))) Args* ap_ = (const __attribute__((address_space(4))) Args*)__builtin_amdgcn_kernarg_segment_ptr(); asm volatile("" : "+s"(ap_)); la = *(const Args*)ap_; }
__global__ void __launch_bounds__(NTHREADS, 2) fwd_megakernel(Args args_unused) {
    extern __shared__ __attribute__((aligned(16))) unsigned char lds_raw[];
    cg::grid_group grid = cg::this_grid();
    Frame F;
    F.lds = (LAS unsigned char*)lds_raw;
    F.tid = threadIdx.x; F.lane = F.tid & 63; F.wave = __builtin_amdgcn_readfirstlane(F.tid >> 6);
    F.G = gridDim.x; { const int bx = blockIdx.x; F.vcu = (F.G % 8 == 0) ? (bx % 8) * (F.G / 8) + bx / 8 : bx; }
#define REFRAME() do { int l_; asm volatile("v_mbcnt_lo_u32_b32 %0, -1, 0\n\tv_mbcnt_hi_u32_b32 %0, -1, %0" : "=v"(l_)); F.lane = l_; F.tid = F.wave * 64 + l_; } while (0)
    for (int u = F.tid; u < (LDS_BYTES - MISC_OFF) / 4; u += NTHREADS) ((LAS unsigned*)(F.lds + MISC_OFF))[u] = 0u;
    __syncthreads();
    XcdBarrier xbar;
    { LOAD_ARGS(args0); xbar = xcd_barrier_post((unsigned*)(args0.ws + WS_CTL) + CW_BAR, (volatile LAS unsigned*)(F.lds + MISC_OFF + 1024)); }
#define GRID_BAR() xcd_barrier(xbar)

    { REFRAME(); LOAD_ARGS(args); p0_prologue(F, args); }
    grid.sync();
    { REFRAME(); LOAD_ARGS(args); p0b_norm1(F, args); }
    GRID_BAR();
    {
        REFRAME(); LOAD_ARGS(args); unsigned char* ws = args.ws;
        pg8::Gemm g{(const bf16*)(ws + WS_H), (const bf16*)(ws + WS_WIN), 1024}; pg8::DenseOrder S; S.init(NTOK, INW, F.G, (int)blockIdx.x, P1_CPERM, P1_CPERM1);
        EpiProj E{(bf16*)(ws + WS_PROJ), args.in[13], (bf16*)(ws + WS_QC), (bf16*)(ws + WS_KV), F.lds + EPI_SCR};
        pg8::gemm_phase<EpiProj, pg8::DenseOrder>(F.lds, g, S, E, F.tid);
    }
    GRID_BAR();
    { REFRAME(); LOAD_ARGS(args); p2_mixers(F, args); }
    GRID_BAR();
    {
        REFRAME(); LOAD_ARGS(args); unsigned char* ws = args.ws;
        pg8::Gemm g{(const bf16*)(ws + WS_Y), (const bf16*)(ws + WS_WOUT), 1024}; pg8::DenseOrder S; S.init(NTOK, D, F.G, (int)blockIdx.x);
        EpiRes1 E{args.in[0], (bf16*)(ws + WS_X1B), (const float*)(ws + WS_MOD), F.lds + EPI_SCR};
        pg8::gemm_phase<EpiRes1, pg8::DenseOrder>(F.lds, g, S, E, F.tid);
    }
    GRID_BAR();
    { REFRAME(); LOAD_ARGS(args); p4_router(F, args); }
    GRID_BAR();
    {
        LAS int* pre = (LAS int*)(F.lds + MISC_OFF);
        { LOAD_ARGS(args);
          const unsigned* cnt = (const unsigned*)(args.ws + WS_CTL) + CW_CNT;
          if (F.tid < 64) {
              const int lane = F.tid; const int cv_ = (int)__hip_atomic_load(cnt + (lane & 31), __ATOMIC_RELAXED, __HIP_MEMORY_SCOPE_AGENT); const int tl = lane < 32 ? ((cv_ + 255) >> 8) : 0;
              if (lane < 32) ((LAS int*)(F.lds + MOE_CNTL))[lane] = cv_;
              int inc = tl;
#pragma unroll
              for (int o = 1; o < 32; o <<= 1) { const int t = __shfl_up(inc, o); if (lane >= o) inc += t; }
              if (lane < 32) pre[lane] = inc - tl;
              if (lane == 31) pre[32] = inc; } }
        __syncthreads();
        {
            REFRAME(); LOAD_ARGS(args); unsigned char* ws = args.ws;
            pg8::Gemm g{(const bf16*)(ws + WS_H), (const bf16*)(ws + WS_W13), 1024};
            MoeOrder S{pre, (const LAS int*)(F.lds + MOE_CNTL), (const LAS int*)(F.lds + MOE_LTOK), (const int*)(ws + WS_LIST), F.G, (int)blockIdx.x, F.lane, true};
            {
                const int* list = (const int*)(ws + WS_LIST); int tv[MOE_MAXU];
#pragma unroll
                for (int i = 0; i < MOE_MAXU; ++i) { pg8::Unit u; tv[i] = 0;
                    if (F.tid < 256 && S.next(i, u) && F.tid < u.nrows) tv[i] = list[(size_t)u.e * NTOK + u.r0 + F.tid] >> 1; }
#pragma unroll
                for (int i = 0; i < MOE_MAXU; ++i) if (F.tid < 256) ((LAS int*)(F.lds + MOE_LTOK))[i * 256 + F.tid] = tv[i];
                __syncthreads();
            }
            EpiSwiGLU E{(bf16*)(ws + WS_ACT), F.lds + EPI_SCR};
            pg8::gemm_phase<EpiSwiGLU, MoeOrder>(F.lds, g, S, E, F.tid);
        }
        GRID_BAR();
        {
            REFRAME(); LOAD_ARGS(args); unsigned char* ws = args.ws;
            pg8::Gemm g{(const bf16*)(ws + WS_ACT), (const bf16*)(ws + WS_W2), 512};
            MoeOrder S{pre, (const LAS int*)(F.lds + MOE_CNTL), (const LAS int*)(F.lds + MOE_LTOK), (const int*)(ws + WS_LIST), F.G, (int)blockIdx.x, F.lane, false};
            EpiScatter E{(bf16*)(ws + WS_YBUF), F.lds + EPI_SCR};
            pg8::gemm_phase<EpiScatter, MoeOrder>(F.lds, g, S, E, F.tid);
        }
    }
    GRID_BAR();
    { REFRAME(); LOAD_ARGS(args); p7_final(F, args); }
}

extern "C" void kernel_launch(void* const* d_in, const int* in_sizes, int n_in, void* d_out, int out_size, void* d_ws, size_t ws_size, hipStream_t stream) {
    static int grid = 0;
    if (grid == 0) {
        if (n_in != 24 || out_size != NTOK * D || ws_size < WS_END) { fprintf(stderr, "kernel_launch: unexpected problem (n_in %d out %d ws %zu)\n", n_in, out_size, ws_size); grid = -1; return; }
        int dev = 0, cus = 0, per_cu = 0;
        hipGetDevice(&dev);
        hipDeviceGetAttribute(&cus, hipDeviceAttributeMultiprocessorCount, dev);
        hipFuncSetAttribute((const void*)fwd_megakernel, hipFuncAttributeMaxDynamicSharedMemorySize, LDS_BYTES);
        hipOccupancyMaxActiveBlocksPerMultiprocessor(&per_cu, (const void*)fwd_megakernel, NTHREADS, LDS_BYTES);
        if (per_cu < 1) { fprintf(stderr, "kernel_launch: occupancy query says %d blocks per CU\n", per_cu); per_cu = 1; }
        grid = cus;
        (void)hipGetLastError();
    }
    if (grid < 0) return;
    hipMemsetAsync((char*)d_ws + WS_CTL, 0, CTL_ZERO_BYTES, stream);
    Args a{};
    for (int i = 0; i < 24; ++i) a.in[i] = (const float*)d_in[i];
    a.out = (float*)d_out; a.ws = (unsigned char*)d_ws;
    void* kargs[] = {&a};
    hipError_t e = hipLaunchCooperativeKernel((const void*)fwd_megakernel, dim3(grid), dim3(NTHREADS), kargs, LDS_BYTES, stream);
    if (e != hipSuccess) fprintf(stderr, "cooperative launch failed: %s (grid %d)\n", hipGetErrorString(e), grid);
}
```

```cpp
#include <hip/hip_runtime.h>
#include <hip/hip_cooperative_groups.h>
#include <cstdint>
#include <cstdio>
namespace cg = cooperative_groups;

#define LAS __attribute__((address_space(3)))
#define GAS __attribute__((address_space(1)))
typedef unsigned short bf16;
typedef short bf16x8 __attribute__((ext_vector_type(8)));
typedef short s16x4 __attribute__((ext_vector_type(4)));
typedef float f32x2 __attribute__((ext_vector_type(2)));
typedef float f32x4 __attribute__((ext_vector_type(4)));
typedef float f32x16 __attribute__((ext_vector_type(16)));
typedef unsigned u32x2 __attribute__((ext_vector_type(2)));
typedef unsigned u32x4 __attribute__((ext_vector_type(4)));
typedef __bf16 bf16x2_t __attribute__((ext_vector_type(2)));

constexpr int D = 1024, BATCH = 8, SEQ = 8192, NTOK = BATCH * SEQ;
constexpr int INW = 3584;
constexpr int COL_QA = 0, COL_KA = 512, COL_VA = 1024, COL_QR = 1536, COL_FR = 2048, COL_IR = 2560, COL_GR = 3072;
constexpr int NEXP = 32, FF = 512;
constexpr float EPS = 1e-6f;
constexpr float LOG2E = 1.4426950408889634f;
constexpr float QSCALE = 0.125f * LOG2E;
constexpr int NWAVES = 8, NTHREADS = 512;

constexpr size_t MiB = 1u << 20;
constexpr size_t WS_CTL = 0, CTL_ZERO_BYTES = 64 * 1024;
constexpr size_t WS_MOD = 1 * MiB;
constexpr size_t WS_WIN = 2 * MiB;
constexpr size_t WS_WOUT = 9 * MiB;
constexpr size_t WS_W13 = 11 * MiB;
constexpr size_t WS_W2 = 75 * MiB;
constexpr size_t WS_LIST = 107 * MiB;
constexpr size_t WS_TOKW = 115 * MiB;
constexpr size_t WS_TOKS = 115 * MiB + 512 * 1024;
constexpr size_t WS_H = 116 * MiB;
constexpr size_t WS_Y = 244 * MiB;
constexpr size_t WS_PROJ = 372 * MiB;
constexpr size_t WS_ACT = 372 * MiB;
constexpr size_t WS_YBUF = 508 * MiB;
constexpr size_t WS_QC = 820 * MiB;
constexpr size_t WS_KV = 884 * MiB;
constexpr size_t WS_X1B = 884 * MiB;
constexpr size_t WS_END = 1012 * MiB;
constexpr int CW_CNT = 0;
constexpr int CW_Q = 64;
constexpr int CW_BAR = 8192;

constexpr int RING_BYTES = 131072;
constexpr int MISC_OFF = RING_BYTES;
constexpr int EPI_SCR = MISC_OFF + 16384;
constexpr int LDS_BYTES = 163840;

__device__ __forceinline__ unsigned cvtpk(float lo, float hi) { f32x2 v = {lo, hi}; bf16x2_t b = __builtin_convertvector(v, bf16x2_t); return __builtin_bit_cast(unsigned, b); }
__device__ __forceinline__ float dot2bf(unsigned a, unsigned b, float acc) {
    asm("" : "+v"(a));
    return __builtin_amdgcn_fdot2_f32_bf16(__builtin_bit_cast(bf16x2_t, a), __builtin_bit_cast(bf16x2_t, b), acc, false); }
__device__ __forceinline__ float bf2f(unsigned short x) { return __uint_as_float(((unsigned)x) << 16); }
__device__ __forceinline__ float bflo(unsigned x) { return __uint_as_float(x << 16); }
__device__ __forceinline__ float bfhi(unsigned x) { return __uint_as_float(x & 0xffff0000u); }
template <int CTRL> __device__ __forceinline__ float dppf(float x) { return __builtin_bit_cast(float, __builtin_amdgcn_update_dpp(0, __builtin_bit_cast(int, x), CTRL, 0xf, 0xf, false)); }
__device__ __forceinline__ void swap32(float a, float b, float& r0, float& r1) { auto r = __builtin_amdgcn_permlane32_swap(__builtin_bit_cast(unsigned, a), __builtin_bit_cast(unsigned, b), false, false);
    unsigned u0 = r[0], u1 = r[1]; asm("" : "+v"(u0), "+v"(u1)); r0 = __builtin_bit_cast(float, u0); r1 = __builtin_bit_cast(float, u1); }
__device__ __forceinline__ void swap16(float a, float b, float& r0, float& r1) { auto r = __builtin_amdgcn_permlane16_swap(__builtin_bit_cast(unsigned, a), __builtin_bit_cast(unsigned, b), false, false);
    unsigned u0 = r[0], u1 = r[1]; asm("" : "+v"(u0), "+v"(u1)); r0 = __builtin_bit_cast(float, u0); r1 = __builtin_bit_cast(float, u1); }
__device__ __forceinline__ float sum_x32(float a, float b) { float r0, r1; swap32(a, b, r0, r1); return r0 + r1; }
__device__ __forceinline__ float sum_x16(float a, float b) { float r0, r1; swap16(a, b, r0, r1); return r0 + r1; }
__device__ __forceinline__ float row_sum(float v) { v += dppf<0xB1>(v); v += dppf<0x4E>(v); v += dppf<0x141>(v); v += dppf<0x140>(v); return v; }
__device__ __forceinline__ float wave_sum(float v) { v = row_sum(v); v = sum_x16(v, v); return sum_x32(v, v); }
__device__ __forceinline__ float fast_exp2(float x) { return __builtin_amdgcn_exp2f(x); }
__device__ __forceinline__ float fast_rcp(float x) { return __builtin_amdgcn_rcpf(x); }
__device__ __forceinline__ float sigmoidf_(float x) { return fast_rcp(1.f + fast_exp2(-x * LOG2E)); }
__device__ __forceinline__ float siluf_(float x) { return x * sigmoidf_(x); }

namespace pg8 {
constexpr int BM = 256, BK = 64, HALF = 128, HTB = HALF * BK * 2, STAGE_BYTES = 8 * HTB;
__host__ __device__ __forceinline__ int lds_byte(int r, int c) { const int st = (r >> 4) * 2 + (c >> 5), rr = r & 15, cc = c & 31, ob = rr * 64 + cc * 2; return st * 1024 + (ob ^ (((ob >> 9) & 1) << 5)); }
__host__ __device__ __forceinline__ void stage_rc(int b, int& R, int& C) { const int st = b / 1024, sb = b % 1024, swz = sb ^ (((sb >> 9) & 1) << 5); R = (st >> 1) * 16 + swz / 64; C = (st & 1) * 32 + (swz % 64) / 2; }
__host__ __device__ __forceinline__ int perm32(int rho) { const int n = rho >> 4, i = rho & 15; return 8 * (i >> 2) + 4 * n + (i & 3); }

template <int STRICT, int LAX> __device__ __forceinline__ void wait_v_sel(int sel) {
    asm volatile("s_cmp_lg_u32 %0, 0\n\ts_cbranch_scc1 1f\n\ts_waitcnt vmcnt(%1)\n1:\n\ts_waitcnt vmcnt(%2)" :: "s"(sel), "n"(STRICT), "n"(LAX) : "scc", "memory"); }
template <int N> __device__ __forceinline__ void wait_v() { asm volatile("s_waitcnt vmcnt(%0)" :: "n"(N) : "memory"); }
struct Unit { int pm, pn, e, r0, nrows, slot; };
struct Gemm { const bf16* A; const bf16* Bt; int K; };

template <class Epi, class Sched>
__device__ __forceinline__ void gemm_phase(LAS unsigned char* lds, const Gemm g, const Sched& S, const Epi& E, const int tid) {
    const int  wid = __builtin_amdgcn_readfirstlane(tid >> 6), lane = tid & 63, wr = wid >> 2, wc = wid & 3, fr = lane & 15, fq = lane >> 4;
    const int K = g.K, nt = K / BK;
    int RA[2], CA[2]; unsigned voffB[2];
#pragma unroll
    for (int i = 0; i < 2; ++i) { int R, C; stage_rc(tid * 16 + i * 8192, R, C); const int Rb = Epi::PERM ? (64 * (R >> 5) + perm32(R & 31)) : R;
        RA[i] = R; CA[i] = C; voffB[i] = (unsigned)(Rb * K + C) * 2u; }
    const size_t kstep = (size_t)(BK * 2);
    const size_t hstep = (size_t)(Epi::PERM ? 32 : HALF) * K * 2;
    const size_t tstep = (size_t)BM * K * 2;
    const unsigned ldsw = (unsigned)wid * 1024u;
    const int aoff = lds_byte(wr * 64 + fr, fq * 8), boff = lds_byte(wc * 32 + fr, fq * 8);
#define PG8_SA(b, h) (((b) * 2 + (h)) * HTB)
#define PG8_SB(b, h) ((4 + (b) * 2 + (h)) * HTB)
#define PG8_STAGE(bufoff, gbase, voff) do { _Pragma("unroll") for (int _i = 0; _i < 2; ++_i) \
        __builtin_amdgcn_global_load_lds((const unsigned*)((const char*)(gbase) + (voff)[_i]), (LAS unsigned*)(lds + (bufoff) + ldsw + _i * 8192), 16, 0, 0); } while (0)
#define PG8_LDA(dst, b, h) do { _Pragma("unroll") for (int m = 0; m < 4; ++m) _Pragma("unroll") for (int k = 0; k < 2; ++k) dst[m][k] = *(const LAS bf16x8*)(lds + PG8_SA(b, h) + aoff + m * 2048 + k * 1024); } while (0)
#define PG8_LDB(dst, b, h) do { _Pragma("unroll") for (int n = 0; n < 2; ++n) _Pragma("unroll") for (int k = 0; k < 2; ++k) dst[n][k] = *(const LAS bf16x8*)(lds + PG8_SB(b, h) + boff + n * 2048 + k * 1024); } while (0)
#define PG8_MMA(ai, bj, At, Bt) do { __builtin_amdgcn_s_setprio(1); _Pragma("unroll") for (int m = 0; m < 4; ++m) _Pragma("unroll") for (int n = 0; n < 2; ++n) _Pragma("unroll") for (int k = 0; k < 2; ++k) \
        acc[ai][bj][m][n] = __builtin_amdgcn_mfma_f32_16x16x32_bf16(Bt[n][k], At[m][k], acc[ai][bj][m][n], 0, 0, 0); __builtin_amdgcn_s_setprio(0); } while (0)
#define PG8_WAIT_V(n) asm volatile("s_waitcnt vmcnt(" #n ")" ::: "memory")
#define PG8_WAIT_L(n) asm volatile("s_waitcnt lgkmcnt(" #n ")" ::: "memory")
#define PG8_BAR __builtin_amdgcn_s_barrier()
#define PG8_SCHED __builtin_amdgcn_sched_barrier(0)
#define PG8_AOFF(dst, u) do { _Pragma("unroll") for (int _h = 0; _h < 2; ++_h) _Pragma("unroll") for (int _i = 0; _i < 2; ++_i) \
        dst[_h][_i] = ((unsigned)S.arow(u, _h * HALF + RA[_i]) * (unsigned)K + (unsigned)CA[_i]) * 2u; } while (0)
    Unit cur, nxt; int ui = 0;
    if (!S.next(0, cur)) return;
    f32x4 acc[2][2][4][2];
#pragma unroll
    for (int a = 0; a < 2; ++a)
#pragma unroll
        for (int b = 0; b < 2; ++b)
#pragma unroll
            for (int m = 0; m < 4; ++m)
#pragma unroll
                for (int n = 0; n < 2; ++n) acc[a][b][m][n] = (f32x4){0.f, 0.f, 0.f, 0.f};
    bf16x8 At[4][2], B0[2][2], B1[2][2];
    unsigned cv[2][2], nv[2][2];
    PG8_AOFF(cv, cur);
    const char* Ab = (const char*)g.A;
    const char* cB = (const char*)g.Bt + (size_t)cur.pn * tstep;
    {
        PG8_STAGE(PG8_SB(0, 0), cB, voffB); PG8_STAGE(PG8_SB(0, 1), cB + hstep, voffB); PG8_STAGE(PG8_SA(0, 0), Ab, cv[0]); PG8_STAGE(PG8_SA(0, 1), Ab, cv[1]);
        if (wr == 1) PG8_BAR;
        PG8_WAIT_V(2); PG8_BAR;
        PG8_STAGE(PG8_SB(1, 0), cB + kstep, voffB); PG8_STAGE(PG8_SA(1, 0), Ab + kstep, cv[0]); PG8_STAGE(PG8_SB(1, 1), cB + hstep + kstep, voffB);
        PG8_WAIT_V(6); PG8_BAR;
    }
    for (;;) {
        const bool has_next = S.next(ui + 1, nxt);
        if (has_next) { PG8_AOFF(nv, nxt); } else {
#pragma unroll
            for (int _h = 0; _h < 2; ++_h)
#pragma unroll
                for (int _i = 0; _i < 2; ++_i) nv[_h][_i] = cv[_h][_i]; }
        const char* nB = has_next ? (const char*)g.Bt + (size_t)nxt.pn * tstep : cB;
        for (int t = 0; t < nt; t += 2) {
            const bool last = (t == nt - 2);
            const int relax = __builtin_amdgcn_readfirstlane(((t == 0) && (ui > 0)) ? 1 : 0);
            const char* a1 = Ab + (size_t)(t + 1) * kstep;
            const char* a2 = last ? Ab : Ab + (size_t)(t + 2) * kstep; const char* b2 = last ? nB : cB + (size_t)(t + 2) * kstep;
            const char* a3 = a2 + kstep; const char* b3 = b2 + kstep;
            unsigned o2[2][2];
#pragma unroll
            for (int _h = 0; _h < 2; ++_h)
#pragma unroll
                for (int _i = 0; _i < 2; ++_i) o2[_h][_i] = last ? nv[_h][_i] : cv[_h][_i];
            PG8_LDB(B0, 0, 0); PG8_LDB(B1, 0, 1); PG8_SCHED; PG8_LDA(At, 0, 0); PG8_STAGE(PG8_SA(1, 1), a1, cv[1]);
            wait_v_sel<8, 8 + Epi::NST>(relax);
            PG8_WAIT_L(0); PG8_BAR; PG8_MMA(0, 0, At, B0); PG8_MMA(0, 1, At, B1); PG8_BAR; PG8_SCHED;
            PG8_LDA(At, 0, 1); PG8_STAGE(PG8_SB(0, 0), b2, voffB); PG8_STAGE(PG8_SB(0, 1), b2 + hstep, voffB); PG8_STAGE(PG8_SA(0, 0), a2, o2[0]);
            wait_v_sel<8, 8 + Epi::NST>(relax);
            PG8_WAIT_L(0); PG8_BAR; PG8_MMA(1, 0, At, B0); PG8_MMA(1, 1, At, B1); PG8_BAR; PG8_SCHED;
            PG8_LDB(B0, 1, 0); PG8_LDB(B1, 1, 1); PG8_SCHED; PG8_LDA(At, 1, 0); PG8_STAGE(PG8_SA(0, 1), a2, o2[1]);
            PG8_WAIT_V(8); PG8_WAIT_L(0); PG8_BAR; PG8_MMA(0, 0, At, B0); PG8_MMA(0, 1, At, B1); PG8_BAR; PG8_SCHED;
            PG8_LDA(At, 1, 1); PG8_STAGE(PG8_SB(1, 0), b3, voffB); PG8_STAGE(PG8_SB(1, 1), b3 + hstep, voffB); PG8_STAGE(PG8_SA(1, 0), a3, o2[0]);
            PG8_WAIT_V(8); PG8_WAIT_L(0); PG8_BAR; PG8_MMA(1, 0, At, B0); PG8_MMA(1, 1, At, B1); PG8_BAR; PG8_SCHED;
        }
        if (wr == 0) PG8_BAR;
        { int le; asm volatile("v_mbcnt_lo_u32_b32 %0, -1, 0\n\tv_mbcnt_hi_u32_b32 %0, -1, %0" : "=v"(le));
          E(acc, cur, wr, wc, le & 15, le >> 4); }
        if (!has_next) break;
#pragma unroll
        for (int a = 0; a < 2; ++a)
#pragma unroll
            for (int b = 0; b < 2; ++b)
#pragma unroll
                for (int m = 0; m < 4; ++m)
#pragma unroll
                    for (int n = 0; n < 2; ++n) acc[a][b][m][n] = (f32x4){0.f, 0.f, 0.f, 0.f};
        cur = nxt; cB = nB; ++ui;
#pragma unroll
        for (int _h = 0; _h < 2; ++_h)
#pragma unroll
            for (int _i = 0; _i < 2; ++_i) cv[_h][_i] = nv[_h][_i];
        if (wr == 1) PG8_BAR;
    }
    PG8_WAIT_V(0);
    PG8_BAR;
#undef PG8_SA
#undef PG8_SB
#undef PG8_STAGE
#undef PG8_LDA
#undef PG8_LDB
#undef PG8_MMA
#undef PG8_WAIT_V
#undef PG8_WAIT_L
#undef PG8_BAR
#undef PG8_SCHED
#undef PG8_AOFF
}

struct DenseOrder {
    int nM, nN, nwg, G, c; unsigned long long cperm;
    int W = 8;
    __device__ void init(int M, int N, int G_, int c_, unsigned long long cperm_ = 0ull, int W_ = 8) { nM = M / BM; nN = N / BM; nwg = nM * nN; G = G_; c = c_; cperm = cperm_; W = W_; }
    __device__ __forceinline__ bool next(int i, Unit& u) const {
        const long L = (long)i * G + c; if (L >= nwg) return false;
        int wgid = (int)L; { const int q = nwg / 8, r = nwg % 8, xcd = wgid % 8, off = wgid / 8; wgid = (xcd < r ? xcd * (q + 1) : r * (q + 1) + (xcd - r) * q) + off; }
        const int nig = W * nN, gid = wgid / nig, fm = gid * W, gsz = (nM - fm) < W ? (nM - fm) : W;
        u.pm = fm + ((wgid % nig) % gsz); u.pn = (wgid % nig) / gsz; if (cperm) u.pn = (int)((cperm >> (4 * u.pn)) & 15ull);
        u.e = 0; u.r0 = 0; u.nrows = BM; u.slot = 0; return true;
    }
    __device__ __forceinline__ int arow(const Unit& u, int r) const { return u.pm * BM + r; }
};
__device__ __forceinline__ void xpose128(LAS unsigned char* scr, int fr, int fq, const u32x4& w0, const u32x4& w1, u32x4& rA, u32x4& rB) {
    const int sw = fr & 7;
    *(LAS u32x4*)(scr + fr * 128 + ((fq ^ sw) << 4)) = w0;
    *(LAS u32x4*)(scr + fr * 128 + (((4 + fq) ^ sw) << 4)) = w1;
    asm volatile("" ::: "memory");
    const int l = fr + 16 * fq, r = l >> 3, c = l & 7;
    rA = *(const LAS u32x4*)(scr + r * 128 + ((c ^ r) << 4));
    rB = *(const LAS u32x4*)(scr + 1024 + r * 128 + ((c ^ r) << 4));
    asm volatile("" ::: "memory");
}
}

#define XB_TMO      128
#define XB_XCNT(j)  (256  + 64 * (j))
#define XB_XSUB(j)  (1280 + 64 * (j))
#define XB_XGEN(j)  (2304 + 64 * (j))
#define XB_TOP      3328
#define XB_TOPGEN   3392
#define XCD_BAR_WORDS 3456
#define XB_SPIN_CAP (1u << 18)
__device__ __forceinline__ unsigned xb_ld(unsigned* p)              { return __hip_atomic_load(p, __ATOMIC_RELAXED, __HIP_MEMORY_SCOPE_AGENT); }
__device__ __forceinline__ unsigned xb_add(unsigned* p, unsigned v) { return __hip_atomic_fetch_add(p, v, __ATOMIC_RELAXED, __HIP_MEMORY_SCOPE_AGENT); }
__device__ __forceinline__ unsigned xb_xcc_id() { return (unsigned)__builtin_amdgcn_s_getreg((3 << 11) | 20) & 0xFu; }
#define XB_SPIN(cond, bar) do { unsigned _sp = 0; while (cond) { __builtin_amdgcn_s_sleep(1); \
    if ((++_sp & 255u) == 0u) { if (xb_ld(&(bar)[XB_TMO])) break; if (_sp > XB_SPIN_CAP) { atomicAdd(&(bar)[XB_TMO], 1u); break; } } } } while (0)
struct XcdBarrier { unsigned* bar; unsigned x; volatile LAS unsigned* st; };
__device__ __forceinline__ XcdBarrier xcd_barrier_post(unsigned* bar, volatile LAS unsigned* st) {
    XcdBarrier b; b.bar = bar; b.x = xb_xcc_id(); b.st = st;
    if (threadIdx.x == 0) (void)xb_add(&bar[XB_XCNT(b.x)], 1u);
    return b;
}
__device__ __forceinline__ void xcd_barrier_complete(unsigned* bar, unsigned x, unsigned& nloc, unsigned& nx) {
    const unsigned G = gridDim.x * gridDim.y * gridDim.z;
    unsigned sum, cnt, mine, sp = 0u;
    for (;;) {
        sum = 0u; cnt = 0u; mine = 0u;
#pragma unroll
        for (unsigned j = 0; j < 16; ++j) { const unsigned c = xb_ld(&bar[XB_XCNT(j)]); sum += c; cnt += (c > 0u) ? 1u : 0u; mine = (j == x) ? c : mine; }
        if (sum == G) break;
        __builtin_amdgcn_s_sleep(1);
        if ((++sp & 255u) == 0u) { if (xb_ld(&bar[XB_TMO])) break; if (sp > XB_SPIN_CAP) { atomicAdd(&bar[XB_TMO], 1u); break; } }
    }
    nloc = mine > 0u ? mine : 1u; nx = cnt > 0u ? cnt : 1u;
}
__device__ __forceinline__ void xcd_barrier(const XcdBarrier& b) {
    asm volatile("s_waitcnt vmcnt(0)" ::: "memory");
    __syncthreads();
    if (threadIdx.x == 0) {
        unsigned* bar = b.bar;
        __builtin_amdgcn_s_waitcnt(0);
        unsigned nloc = b.st[0], nx = b.st[1];
        if (nloc == 0u) { xcd_barrier_complete(bar, b.x, nloc, nx); b.st[0] = nloc; b.st[1] = nx; }
        const unsigned old = xb_add(&bar[XB_XSUB(b.x)], 1u);
        const unsigned gen = old / nloc;
        if (old + 1u == (gen + 1u) * nloc) {
            __builtin_amdgcn_fence(__ATOMIC_RELEASE, "agent");
            asm volatile("s_waitcnt vmcnt(0)" ::: "memory");
            const unsigned og = xb_add(&bar[XB_TOP], 1u);
            const unsigned tg = og / nx;
            if (og + 1u == (tg + 1u) * nx) xb_add(&bar[XB_TOPGEN], 1u);
            else XB_SPIN(xb_ld(&bar[XB_TOPGEN]) == tg, bar);
            __builtin_amdgcn_fence(__ATOMIC_ACQUIRE, "agent");
            xb_add(&bar[XB_XGEN(b.x)], 1u);
            asm volatile("s_waitcnt vmcnt(0)" ::: "memory");
        } else {
            XB_SPIN(xb_ld(&bar[XB_XGEN(b.x)]) == gen, bar);
            __builtin_amdgcn_fence(__ATOMIC_ACQUIRE, "agent");
            asm volatile("s_waitcnt vmcnt(0)" ::: "memory");
        }
    }
    __syncthreads();
}

struct Args { const float* in[24]; float* out; unsigned char* ws; };
struct Frame {
    LAS unsigned char* lds;
    int tid, lane, wave, vcu, G;
};

template <int MODE>
__device__ __forceinline__ void p0_transpose_item(const float* W, int K, int N, bf16* WT, LAS float* scr, int item, int lane) {
    const int nblk = N / 32, kb = item / nblk, nb = item % nblk, k0 = 64 * kb, n0 = 32 * nb;
    f32x4 v[8];
#pragma unroll
    for (int i = 0; i < 8; ++i) v[i] = *(const f32x4*)(W + (size_t)(k0 + 8 * i + (lane >> 3)) * N + n0 + 4 * (lane & 7));
#pragma unroll
    for (int i = 0; i < 8; ++i) { LAS float* d = scr + (8 * i + (lane >> 3)) * 33 + 4 * (lane & 7); d[0] = v[i].x; d[1] = v[i].y; d[2] = v[i].z; d[3] = v[i].w; }
    asm volatile("s_waitcnt lgkmcnt(0)" ::: "memory");
    const int c = lane & 7;
#pragma unroll
    for (int j = 0; j < 4; ++j) { const int n = (lane >> 3) + 8 * j; const LAS float* s = scr + (8 * c) * 33 + n;
        u32x4 o; o.x = cvtpk(s[0 * 33], s[1 * 33]); o.y = cvtpk(s[2 * 33], s[3 * 33]); o.z = cvtpk(s[4 * 33], s[5 * 33]); o.w = cvtpk(s[6 * 33], s[7 * 33]);
        const int f = n0 + n; int row = f;
        if (MODE == 1) row = ((f >> 7) << 8) + (((f >> 5) & 3) << 6) + (f & 31);
        if (MODE == 2) row = ((f >> 7) << 8) + (((f >> 5) & 3) << 6) + 32 + (f & 31);
        *(u32x4*)(WT + (size_t)row * K + k0 + 8 * c) = o; }
    asm volatile("s_waitcnt lgkmcnt(0)" ::: "memory");
}

__device__ __forceinline__ void p0_prologue(const Frame& F, const Args& a) {
    unsigned char* ws = a.ws;
    if (F.vcu < 96) {
        LAS float* cact = (LAS float*)F.lds;
        LAS float* red = (LAS float*)(F.lds + 32768);
        const float* c = a.in[1];
        for (int i = F.tid; i < 8192; i += NTHREADS) { const int b = i >> 10, k = i & 1023; cact[k * 8 + b] = siluf_(c[i]); }
        __syncthreads();
        const int j = F.vcu * 64 + F.lane;
        const float* w = a.in[2] + (size_t)(128 * F.wave) * 6144 + j;
        float acc[8];
#pragma unroll
        for (int b = 0; b < 8; ++b) acc[b] = 0.f;
#pragma unroll 16
        for (int k = 0; k < 128; ++k) { const float wv = w[(size_t)k * 6144]; const LAS float* cp = cact + (128 * F.wave + k) * 8; const f32x4 c0 = *(const LAS f32x4*)cp, c1 = *(const LAS f32x4*)(cp + 4);
            acc[0] += c0.x * wv; acc[1] += c0.y * wv; acc[2] += c0.z * wv; acc[3] += c0.w * wv; acc[4] += c1.x * wv; acc[5] += c1.y * wv; acc[6] += c1.z * wv; acc[7] += c1.w * wv; }
#pragma unroll
        for (int b = 0; b < 8; ++b) red[(F.wave * 8 + b) * 64 + F.lane] = acc[b];
        __syncthreads();
        { const int b = F.tid >> 6; float s = 0.f;
#pragma unroll
          for (int ww = 0; ww < 8; ++ww) s += red[(ww * 8 + b) * 64 + F.lane];
          ((float*)(ws + WS_MOD))[b * 6144 + j] = s + a.in[3][j]; }
        __syncthreads();
    }
    LAS float* scr = (LAS float*)(F.lds + F.wave * 16384);
    const int gw = F.vcu * NWAVES + F.wave, NGW = F.G * NWAVES;
    constexpr int I_IN = 16 * 112, I_OUT = 16 * 32;
    constexpr int NITEMS = I_IN + I_OUT;
    bf16* win = (bf16*)(ws + WS_WIN); bf16* wout = (bf16*)(ws + WS_WOUT);
    for (int it = NITEMS - 1 - gw; it >= 0; it -= NGW) {
        int r = it;
        if (r < I_IN) { p0_transpose_item<0>(a.in[6], 1024, INW, win, scr, r, F.lane); continue; } r -= I_IN;
        p0_transpose_item<0>(a.in[15], 1024, 1024, wout, scr, r, F.lane);
    }
}

__device__ __forceinline__ void p0b_norm1(const Frame& F, const Args& a) {
    const float* x = a.in[0]; const float* ng = a.in[4]; const float* mod = (const float*)(a.ws + WS_MOD);
    bf16* H = (bf16*)(a.ws + WS_H);
    const int gw = F.vcu * NWAVES + F.wave, NGW = F.G * NWAVES;
    const int per = (NTOK + NGW - 1) / NGW;
    const int m0 = gw * per, m1 = (m0 + per < NTOK) ? m0 + per : NTOK;
    if (m0 >= NTOK) return;
    for (int s0 = m0; s0 < m1; ) {
        const int b = s0 >> 13, e1 = ((b + 1) << 13) < m1 ? ((b + 1) << 13) : m1;
        f32x4 ga[4], sha[4];
        { const f32x4* gp = (const f32x4*)ng + F.lane; const f32x4* shp = (const f32x4*)(mod + b * 6144) + F.lane; const f32x4* scp = (const f32x4*)(mod + b * 6144 + 1024) + F.lane;
#pragma unroll
          for (int j = 0; j < 4; ++j) { ga[j] = gp[64 * j] * (scp[64 * j] + 1.f); sha[j] = shp[64 * j]; } }
        f32x4 nx[4];
        { const f32x4* xr = (const f32x4*)(x + (size_t)s0 * D) + F.lane;
#pragma unroll
          for (int j = 0; j < 4; ++j) nx[j] = xr[64 * j]; }
        for (int m = s0; m < e1; ++m) {
            f32x4 v[4];
#pragma unroll
            for (int j = 0; j < 4; ++j) v[j] = nx[j];
            { const int mn = (m + 1 < e1) ? m + 1 : m; const f32x4* xr = (const f32x4*)(x + (size_t)mn * D) + F.lane;
#pragma unroll
              for (int j = 0; j < 4; ++j) nx[j] = xr[64 * j]; }
            float s = 0.f;
#pragma unroll
            for (int j = 0; j < 4; ++j) s += (v[j].x * v[j].x + v[j].y * v[j].y) + (v[j].z * v[j].z + v[j].w * v[j].w);
            const float r = __builtin_amdgcn_rsqf(wave_sum(s) * (1.f / D) + EPS);
            u32x2* o8 = (u32x2*)(H + (size_t)m * D) + F.lane;
#pragma unroll
            for (int j = 0; j < 4; ++j) { const f32x4 y = v[j] * r * ga[j] + sha[j];
                u32x2 o; o.x = cvtpk(y.x, y.y); o.y = cvtpk(y.z, y.w); o8[64 * j] = o; }
        }
        s0 = e1;
    }
}

struct EpiProj {
    static constexpr bool PERM = true;
    static constexpr int NST = 16;
    bf16* O; const float* lbraw;
    bf16* QC; bf16* KV;
    LAS unsigned char* scr;
    __device__ __forceinline__ void operator()(const f32x4 (&acc)[2][2][4][2], const pg8::Unit& u, int wr, int wc, int fr, int fq) const {
        const int seg = u.pn >> 1;
        const int col0 = u.pn * 256 + wc * 64 + 8 * fq;
        float lb[2][8];
        if (seg == 4) {
#pragma unroll
            for (int bj = 0; bj < 2; ++bj)
#pragma unroll
                for (int i = 0; i < 8; ++i) { const int k = col0 + bj * 32 + i - COL_FR; const float r0 = lbraw[k], r1 = lbraw[512 + k]; lb[bj][i] = fast_rcp(1.f + fast_exp2((r1 - r0) * LOG2E)); }
        }
        LAS unsigned char* ws_ = scr + (wr * 4 + wc) * 2048;
        const int l = fr + 16 * fq, r8 = l >> 3, c8 = l & 7;
        const int colT = u.pn * 256 + wc * 64 + 8 * c8, rowT = u.pm * 256 + wr * 64 + r8;
        u32x4 rq[2][2];
#pragma unroll
        for (int it = 0; it <= 8; ++it) {
            if (it < 8) { const int ai = it >> 2, m = it & 3; u32x4 w[2];
#pragma unroll
                for (int bj = 0; bj < 2; ++bj) { float v[8];
#pragma unroll
                    for (int i = 0; i < 4; ++i) { v[i] = acc[ai][bj][m][0][i]; v[4 + i] = acc[ai][bj][m][1][i]; }
                    if (seg == 0) {
#pragma unroll
                        for (int i = 0; i < 8; ++i) v[i] *= QSCALE;
                    } else if (seg == 3 || seg == 6) {
#pragma unroll
                        for (int i = 0; i < 8; ++i) v[i] = siluf_(v[i]);
                    } else if (seg == 4) {
#pragma unroll
                        for (int i = 0; i < 8; ++i) { const float lw = lb[bj][i]; v[i] = __builtin_amdgcn_logf(lw + (1.f - lw) * sigmoidf_(v[i])) * 0.6931471805599453f; }
                    }
                    w[bj].x = cvtpk(v[0], v[1]); w[bj].y = cvtpk(v[2], v[3]); w[bj].z = cvtpk(v[4], v[5]); w[bj].w = cvtpk(v[6], v[7]); }
                pg8::xpose128(ws_, fr, fq, w[0], w[1], rq[it & 1][0], rq[it & 1][1]); }
            if (it > 0) { const int ai = (it - 1) >> 2, m = (it - 1) & 3; const u32x4 rA = rq[(it - 1) & 1][0], rB = rq[(it - 1) & 1][1];
                const int row = rowT + ai * 128 + m * 16;
                if (seg < 3) {
                    const int c = colT & 511, hh = c >> 7, e = c & 127; const size_t tokrow = (size_t)((row >> 13) * 4 + hh) * SEQ + (row & (SEQ - 1));
                    if (seg == 0) { bf16* dst = QC + tokrow * 128 + e; *(u32x4*)dst = rA; *(u32x4*)(dst + 8 * 128) = rB; }
                    else { bf16* dst = KV + tokrow * 256 + (seg == 2 ? 128 : 0) + e; *(u32x4*)dst = rA; *(u32x4*)(dst + 8 * 256) = rB; }
                } else { bf16* rowp = O + (size_t)row * INW + colT; *(u32x4*)rowp = rA; *(u32x4*)(rowp + (size_t)8 * INW) = rB; } } }
    }
};

struct EpiRes1 {
    static constexpr bool PERM = true;
    static constexpr int NST = 16;
    const float* x; bf16* x1b; const float* mod;
    LAS unsigned char* scr;
    __device__ __forceinline__ void operator()(const f32x4 (&acc)[2][2][4][2], const pg8::Unit& u, int wr, int wc, int fr, int fq) const {
        const int b = (u.pm * 256) >> 13;
        const int col0 = u.pn * 256 + wc * 64 + 8 * fq;
        f32x4 gv[2][2];
#pragma unroll
        for (int bj = 0; bj < 2; ++bj)
#pragma unroll
            for (int n = 0; n < 2; ++n) gv[bj][n] = *(const f32x4*)(mod + b * 6144 + 2048 + col0 + bj * 32 + n * 4);
        LAS unsigned char* ws_ = scr + (wr * 4 + wc) * 2048;
        const int l = fr + 16 * fq, r8 = l >> 3, c8 = l & 7;
        const int colT = u.pn * 256 + wc * 64 + 8 * c8, rowT = u.pm * 256 + wr * 64 + r8;
        f32x4 xb[3][4];
#define RES1_LOAD(it) do { const size_t o_ = (size_t)(rowT + ((it) >> 2) * 128 + ((it) & 3) * 16) * D + colT; \
            xb[(it) % 3][0] = *(const f32x4*)(x + o_); xb[(it) % 3][1] = *(const f32x4*)(x + o_ + 4); xb[(it) % 3][2] = *(const f32x4*)(x + o_ + 8 * D); xb[(it) % 3][3] = *(const f32x4*)(x + o_ + 8 * D + 4); } while (0)
        RES1_LOAD(0); RES1_LOAD(1);
#pragma unroll
        for (int it = 0; it < 8; ++it) { const int ai = it >> 2, m = it & 3; const size_t off = (size_t)(rowT + ai * 128 + m * 16) * D + colT;
            if (it + 2 < 8) RES1_LOAD(it + 2);
            u32x4 w[2];
#pragma unroll
            for (int bj = 0; bj < 2; ++bj) { const f32x4 t0 = gv[bj][0] * acc[ai][bj][m][0], t1 = gv[bj][1] * acc[ai][bj][m][1];
                w[bj].x = cvtpk(t0.x, t0.y); w[bj].y = cvtpk(t0.z, t0.w); w[bj].z = cvtpk(t1.x, t1.y); w[bj].w = cvtpk(t1.z, t1.w); }
            u32x4 rA, rB; pg8::xpose128(ws_, fr, fq, w[0], w[1], rA, rB);
            const f32x4 xa0 = xb[it % 3][0], xa1 = xb[it % 3][1], xb0 = xb[it % 3][2], xb1 = xb[it % 3][3];
            u32x4 o;
            o.x = cvtpk(xa0.x + bflo(rA.x), xa0.y + bfhi(rA.x)); o.y = cvtpk(xa0.z + bflo(rA.y), xa0.w + bfhi(rA.y));
            o.z = cvtpk(xa1.x + bflo(rA.z), xa1.y + bfhi(rA.z)); o.w = cvtpk(xa1.z + bflo(rA.w), xa1.w + bfhi(rA.w));
            *(u32x4*)(x1b + off) = o;
            o.x = cvtpk(xb0.x + bflo(rB.x), xb0.y + bfhi(rB.x)); o.y = cvtpk(xb0.z + bflo(rB.y), xb0.w + bfhi(rB.y));
            o.z = cvtpk(xb1.x + bflo(rB.z), xb1.y + bfhi(rB.z)); o.w = cvtpk(xb1.z + bflo(rB.w), xb1.w + bfhi(rB.w));
            *(u32x4*)(x1b + off + 8 * D) = o; }
#undef RES1_LOAD
    }
};

constexpr int WC_ITEMS = 3 * 32 * 256, WC_CHUNKS = WC_ITEMS / (32 * 8);
typedef const __attribute__((address_space(1))) f32x4* gcf4p;
typedef __attribute__((address_space(1))) u32x4* gu4p;
__device__ __forceinline__ void wconv_load(const Args& a, f32x4 (&v)[8], int it, int lane) {
    const int m = it >> 13, r = it & 8191, e = r >> 8, blk = r & 255;
    const int N = m < 2 ? 512 : 1024, nb = m < 2 ? (blk & 15) : (blk & 31), kb = m < 2 ? (blk >> 4) : (blk >> 5);
    const float* p1 = a.in[20]; const float* p3 = a.in[21]; const float* p2 = a.in[22]; asm volatile("" : "+s"(p1), "+s"(p3), "+s"(p2));
    const float* W = (m == 0 ? p1 : m == 1 ? p3 : p2) + (size_t)e * (1024 * 512) + (size_t)(64 * kb + 8 * (lane >> 3)) * N + 32 * nb + 4 * (lane & 7);
#pragma unroll
    for (int i = 0; i < 8; ++i) v[i] = *(gcf4p)(W + (size_t)i * N);
}
__device__ __forceinline__ void wconv_store(const Args& a, const f32x4 (&v)[8], int it, int lane, LAS unsigned char* scr) {
    const int m = it >> 13, r = it & 8191, e = r >> 8, blk = r & 255;
    const int K = m < 2 ? 1024 : 512, nb = m < 2 ? (blk & 15) : (blk & 31), kb = m < 2 ? (blk >> 4) : (blk >> 5);
    bf16* q13 = (bf16*)(a.ws + WS_W13); bf16* q2 = (bf16*)(a.ws + WS_W2); asm volatile("" : "+s"(q13), "+s"(q2));
    bf16* WT = (m < 2 ? q13 + (size_t)e * (1024 * 1024) : q2 + (size_t)e * (1024 * 512)) + 64 * kb;
    const int kk = lane >> 3, nn = lane & 7;
#pragma unroll
    for (int h = 0; h < 2; ++h) {
#pragma unroll
        for (int jj = 0; jj < 2; ++jj) { const int j = 2 * h + jj;
            u32x4 o; o.x = cvtpk(v[0][j], v[1][j]); o.y = cvtpk(v[2][j], v[3][j]); o.z = cvtpk(v[4][j], v[5][j]); o.w = cvtpk(v[6][j], v[7][j]);
            *(LAS u32x4*)(scr + (8 * jj + nn) * 128 + ((kk ^ nn) << 4)) = o; }
        asm volatile("" ::: "memory");
#pragma unroll
        for (int p = 0; p < 2; ++p) { const int f = 32 * nb + 4 * kk + 2 * h + p;
            const u32x4 o = *(const LAS u32x4*)(scr + (8 * p + kk) * 128 + ((nn ^ kk) << 4));
            const int row = m < 2 ? ((f >> 7) << 8) + (((f >> 5) & 3) << 6) + (m == 1 ? 32 : 0) + (f & 31) : f;
            *(gu4p)(WT + (size_t)row * K + 8 * nn) = o; }
        asm volatile("" ::: "memory");
    }
}

constexpr int HG_RS_ = 272, HG_SCS = 144, HG_ARR = 64 * HG_RS_;
constexpr int HG_RAW = 0, HG_QT = 3 * HG_ARR, HG_KT = HG_QT + HG_ARR, HG_SC = HG_KT + HG_ARR, HG_SEG = HG_SC + 64 * HG_SCS, HG_EL = HG_SEG + 4096, HG_OUT = HG_EL + 512, HG_END = HG_OUT + HG_ARR;
static_assert(HG_END <= RING_BYTES, "hgrn LDS map");
__device__ __forceinline__ s16x4 tr16(const LAS unsigned char* p) { return __builtin_bit_cast(s16x4, __builtin_amdgcn_ds_read_tr16_b64_v4i16((LAS s16x4*)p)); }

__device__ __forceinline__ void hgrn_stream(const Frame& F, const Args& a, int bh) {
    const int b = bh >> 2, h = bh & 3;
    const bf16* P = (const bf16*)(a.ws + WS_PROJ) + (size_t)b * SEQ * INW;
    bf16* Y = (bf16*)(a.ws + WS_Y) + (size_t)b * SEQ * D + 512 + h * 128;
    LAS unsigned char* lds = F.lds;
    const int tid = F.tid, lane = F.lane, w = F.wave, l15 = lane & 15, g = lane >> 4;
    u32x4 pre[4][2], gsr[2];
    const __amdgpu_buffer_rsrc_t prs = __builtin_amdgcn_make_buffer_rsrc((void*)P, (short)0, SEQ * INW * 2, 0x00020000);
    const unsigned hg_voff = (unsigned)((tid >> 4) * INW + COL_QR + h * 128 + (tid & 15) * 8) * 2u;
#define HG_LOAD(c) do { _Pragma("unroll") for (int ar = 0; ar < 4; ++ar) _Pragma("unroll") for (int i = 0; i < 2; ++i) { \
        pre[ar][i] = __builtin_bit_cast(u32x4, __builtin_amdgcn_raw_buffer_load_b128(prs, hg_voff, (unsigned)((((c) * 64 + 32 * i) * INW + 512 * ar) * 2), 0)); } } while (0)
#define HG_STORE() do { _Pragma("unroll") for (int ar = 0; ar < 3; ++ar) _Pragma("unroll") for (int i = 0; i < 2; ++i) { const int q = tid + 512 * i, row = q >> 4, ch = q & 15; \
        *(LAS u32x4*)(lds + HG_RAW + ar * HG_ARR + row * HG_RS_ + ch * 16) = pre[ar][i]; } gsr[0] = pre[3][0]; gsr[1] = pre[3][1]; } while (0)
    f32x4 S[8];
#pragma unroll
    for (int kb = 0; kb < 8; ++kb) S[kb] = (f32x4){0.f, 0.f, 0.f, 0.f};
    float ngc[8];
    { const float* ngp = a.in[14] + h * 128 + (tid & 15) * 8;
#pragma unroll
      for (int i = 0; i < 8; ++i) ngc[i] = ngp[i]; }
    HG_LOAD(0);
    HG_STORE();
    for (int c = 0; c < SEQ / 64; ++c) {
        __syncthreads();
        if (c + 1 < SEQ / 64) HG_LOAD(c + 1);
        const bool wdo = c < WC_CHUNKS; const int wit = (c * 32 + bh) * 8 + w;
        f32x4 wv[8];
        if (wdo) wconv_load(a, wv, wit, lane);
        else {
#pragma unroll
            for (int i = 0; i < 8; ++i) wv[i] = (f32x4){0.f, 0.f, 0.f, 0.f}; }
        float bl[8][2];
        {
            float run0 = 0.f, run1 = 0.f;
#pragma unroll
            for (int i = 0; i < 8; ++i) { const unsigned v = *(const LAS unsigned*)(lds + HG_RAW + HG_ARR + (8 * w + i) * HG_RS_ + 4 * lane);
                run0 += bflo(v); run1 += bfhi(v); bl[i][0] = run0; bl[i][1] = run1; }
            *(LAS f32x2*)(lds + HG_SEG + (w * 128 + 2 * lane) * 4) = (f32x2){run0, run1};
        }
        __syncthreads();
        {
            float off0 = 0.f, off1 = 0.f, tot0 = 0.f, tot1 = 0.f;
#pragma unroll
            for (int s = 0; s < 8; ++s) { const f32x2 v = *(const LAS f32x2*)(lds + HG_SEG + (s * 128 + 2 * lane) * 4); if (s < w) { off0 += v.x; off1 += v.y; } tot0 += v.x; tot1 += v.y; }
            if (w == 0) *(LAS f32x2*)(lds + HG_EL + 2 * lane * 4) = (f32x2){fast_exp2(tot0 * LOG2E), fast_exp2(tot1 * LOG2E)};
#pragma unroll
            for (int i = 0; i < 8; ++i) { const int t = 8 * w + i;
                const unsigned lfv = *(const LAS unsigned*)(lds + HG_RAW + HG_ARR + t * HG_RS_ + 4 * lane);
                const unsigned qv = *(const LAS unsigned*)(lds + HG_RAW + t * HG_RS_ + 4 * lane);
                const float b0 = bl[i][0] + off0, b1 = bl[i][1] + off1;
                const float e0 = fast_exp2(b0 * LOG2E), e1 = fast_exp2(b1 * LOG2E);
                const float k0 = 1.f - fast_exp2(bflo(lfv) * LOG2E), k1 = 1.f - fast_exp2(bfhi(lfv) * LOG2E);
                *(LAS unsigned*)(lds + HG_QT + t * HG_RS_ + 4 * lane) = cvtpk(bflo(qv) * e0, bfhi(qv) * e1);
                *(LAS unsigned*)(lds + HG_KT + t * HG_RS_ + 4 * lane) = cvtpk(k0 * fast_rcp(e0), k1 * fast_rcp(e1)); }
        }
        __syncthreads();
#pragma unroll
        for (int i = 0; i < 2; ++i) { const int tile = 2 * w + i, tb = tile >> 2, sb = tile & 3;
            f32x4 sc = (f32x4){0.f, 0.f, 0.f, 0.f};
#pragma unroll
            for (int ks = 0; ks < 4; ++ks) { const bf16x8 af = *(const LAS bf16x8*)(lds + HG_QT + (16 * tb + l15) * HG_RS_ + (32 * ks + 8 * g) * 2);
                const bf16x8 bfr = *(const LAS bf16x8*)(lds + HG_KT + (16 * sb + l15) * HG_RS_ + (32 * ks + 8 * g) * 2);
                sc = __builtin_amdgcn_mfma_f32_16x16x32_bf16(af, bfr, sc, 0, 0, 0); }
#pragma unroll
            for (int r = 0; r < 4; ++r) { const int t = 16 * tb + 4 * g + r, s = 16 * sb + l15; const float v = (s <= t) ? sc[r] : 0.f;
                *(LAS unsigned short*)(lds + HG_SC + t * HG_SCS + s * 2) = (unsigned short)(cvtpk(v, 0.f) & 0xffffu); } }
        __syncthreads();
        bf16x8 vf[2];
#pragma unroll
        for (int ss = 0; ss < 2; ++ss) { const LAS unsigned char* vp = lds + HG_RAW + 2 * HG_ARR + (32 * ss + 8 * g + (l15 >> 2)) * HG_RS_ + (16 * w + 4 * (l15 & 3)) * 2;
            const s16x4 lo = tr16(vp), hi = tr16(vp + 4 * HG_RS_); vf[ss] = (bf16x8){lo[0], lo[1], lo[2], lo[3], hi[0], hi[1], hi[2], hi[3]}; }
        f32x4 o[4];
        {
            bf16x8 sf[4];
#pragma unroll
            for (int ks = 0; ks < 4; ++ks) { u32x4 t4; t4.x = cvtpk(S[2 * ks][0], S[2 * ks][1]); t4.y = cvtpk(S[2 * ks][2], S[2 * ks][3]); t4.z = cvtpk(S[2 * ks + 1][0], S[2 * ks + 1][1]); t4.w = cvtpk(S[2 * ks + 1][2], S[2 * ks + 1][3]);
                sf[ks] = __builtin_bit_cast(bf16x8, t4); }
#pragma unroll
            for (int tb = 0; tb < 4; ++tb) { f32x4 acc = (f32x4){0.f, 0.f, 0.f, 0.f};
#pragma unroll
                for (int ks = 0; ks < 4; ++ks) { const LAS unsigned char* qp = lds + HG_QT + (16 * tb + l15) * HG_RS_ + (32 * ks + 4 * g) * 2;
                    const u32x2 q0 = *(const LAS u32x2*)qp, q1 = *(const LAS u32x2*)(qp + 32);
                    const u32x4 q4 = (u32x4){q0.x, q0.y, q1.x, q1.y};
                    acc = __builtin_amdgcn_mfma_f32_16x16x32_bf16(__builtin_bit_cast(bf16x8, q4), sf[ks], acc, 0, 0, 0); }
#pragma unroll
                for (int ss = 0; ss < 2; ++ss) { const bf16x8 af = *(const LAS bf16x8*)(lds + HG_SC + (16 * tb + l15) * HG_SCS + (32 * ss + 8 * g) * 2);
                    acc = __builtin_amdgcn_mfma_f32_16x16x32_bf16(af, vf[ss], acc, 0, 0, 0); }
                o[tb] = acc; }
        }
#pragma unroll
        for (int kb = 0; kb < 8; ++kb) {
#pragma unroll
            for (int ss = 0; ss < 2; ++ss) { const LAS unsigned char* kp = lds + HG_KT + (32 * ss + 8 * g + (l15 >> 2)) * HG_RS_ + (16 * kb + 4 * (l15 & 3)) * 2;
                const s16x4 lo = tr16(kp), hi = tr16(kp + 4 * HG_RS_); const bf16x8 af = (bf16x8){lo[0], lo[1], lo[2], lo[3], hi[0], hi[1], hi[2], hi[3]};
                S[kb] = __builtin_amdgcn_mfma_f32_16x16x32_bf16(af, vf[ss], S[kb], 0, 0, 0); }
            const f32x4 el = *(const LAS f32x4*)(lds + HG_EL + (16 * kb + 4 * g) * 4);
            S[kb] = S[kb] * el; }
#pragma unroll
        for (int tb = 0; tb < 4; ++tb)
#pragma unroll
            for (int r = 0; r < 4; ++r) *(LAS unsigned short*)(lds + HG_OUT + (16 * tb + 4 * g + r) * HG_RS_ + (16 * w + l15) * 2) = (unsigned short)(cvtpk(o[tb][r], 0.f) & 0xffffu);
        __syncthreads();
#pragma unroll
        for (int i = 0; i < 2; ++i) { const int q = tid + 512 * i, row = q >> 4, ch = q & 15;
            const u32x4 ov = *(const LAS u32x4*)(lds + HG_OUT + row * HG_RS_ + ch * 16);
            float x[8]; x[0] = bflo(ov.x); x[1] = bfhi(ov.x); x[2] = bflo(ov.y); x[3] = bfhi(ov.y); x[4] = bflo(ov.z); x[5] = bfhi(ov.z); x[6] = bflo(ov.w); x[7] = bfhi(ov.w);
            float ss = 0.f;
#pragma unroll
            for (int j = 0; j < 8; ++j) ss += x[j] * x[j];
            ss = row_sum(ss);
            const float rr = __builtin_amdgcn_rsqf(ss * (1.f / 128.f) + EPS);
            const u32x4 gv = gsr[i];
            u32x4 yo;
            yo.x = cvtpk(x[0] * rr * ngc[0] * bflo(gv.x), x[1] * rr * ngc[1] * bfhi(gv.x)); yo.y = cvtpk(x[2] * rr * ngc[2] * bflo(gv.y), x[3] * rr * ngc[3] * bfhi(gv.y));
            yo.z = cvtpk(x[4] * rr * ngc[4] * bflo(gv.z), x[5] * rr * ngc[5] * bfhi(gv.z)); yo.w = cvtpk(x[6] * rr * ngc[6] * bflo(gv.w), x[7] * rr * ngc[7] * bfhi(gv.w));
            *(u32x4*)(Y + (size_t)(c * 64 + row) * D + ch * 8) = yo; }
        if (c + 1 < SEQ / 64) HG_STORE();
        if (wdo) wconv_store(a, wv, wit, lane, lds + EPI_SCR + w * 2048);
    }
    __syncthreads();
#undef HG_LOAD
#undef HG_STORE
}

constexpr int AT_BUF = 32768, AT_LUT = MISC_OFF + 4096, AT_WS = MISC_OFF + 6144, AT_TKT = MISC_OFF + 8192;
__device__ __forceinline__ int crow(int r, int hi) { return (r & 3) + 8 * (r >> 2) + 4 * hi; }
__device__ __forceinline__ int t5_bucket(int n) {
    if (n < 16) return n;
    int b = 16;
    b += (n >= 19); b += (n >= 21); b += (n >= 24); b += (n >= 27); b += (n >= 31); b += (n >= 35); b += (n >= 40); b += (n >= 46);
    b += (n >= 52); b += (n >= 59); b += (n >= 67); b += (n >= 77); b += (n >= 87); b += (n >= 99); b += (n >= 113);
    return b;
}
__device__ __forceinline__ float fmax_nc(float x, float y) { return __builtin_amdgcn_fmed3f(x, y, INFINITY); }
#define AT_SB() __builtin_amdgcn_sched_barrier(0)

__device__ __forceinline__ void at_qk(f32x16& p0, f32x16& p1, const LAS unsigned char* kb, const bf16x8 (&qf)[4]) {
    bf16x8 kf[8];
#pragma unroll
    for (int d0 = 0; d0 < 4; ++d0) { kf[2 * d0] = *(const LAS bf16x8*)(kb + d0 * 2048); kf[2 * d0 + 1] = *(const LAS bf16x8*)(kb + d0 * 2048 + 512); }
#pragma unroll
    for (int r = 0; r < 16; ++r) { p0[r] = 0.f; p1[r] = 0.f; }
#pragma unroll
    for (int d0 = 0; d0 < 4; ++d0) { p0 = __builtin_amdgcn_mfma_f32_32x32x16_bf16(kf[2 * d0], qf[d0], p0, 0, 0, 0); p1 = __builtin_amdgcn_mfma_f32_32x32x16_bf16(kf[2 * d0 + 1], qf[d0], p1, 0, 0, 0); }
}
__device__ __forceinline__ bf16x8 at_vfrag(const LAS unsigned char* vb, int db, int ks) {
    const s16x4 lo = tr16(vb + db * 4096 + ks * 1024), hh = tr16(vb + db * 4096 + ks * 1024 + 512);
    return (bf16x8){lo[0], lo[1], lo[2], lo[3], hh[0], hh[1], hh[2], hh[3]};
}
__device__ __forceinline__ bf16x8 at_kfrag(const LAS unsigned char* kb, int i) { return *(const LAS bf16x8*)(kb + (i >> 1) * 2048 + (i & 1) * 512); }
__device__ __forceinline__ float at_rowmax(const f32x16& c0, const f32x16& c1) {
    float a, b2;
    asm volatile("s_nop 15\n\ts_nop 7\n\tv_max3_f32 %0, %1, %2, %3" : "=v"(a) : "v"(c0[0]), "v"(c0[1]), "v"(c1[0]));
    asm volatile("v_max3_f32 %0, %1, %2, %3" : "=v"(b2) : "v"(c0[2]), "v"(c0[3]), "v"(c1[1]));
    asm volatile("v_max3_f32 %0, %1, %2, %3" : "=v"(a) : "v"(a), "v"(c1[2]), "v"(c1[3]));
#pragma unroll
    for (int r = 4; r < 16; r += 4) {
        asm volatile("v_max3_f32 %0, %1, %2, %3" : "=v"(a) : "v"(a), "v"(c0[r]), "v"(c0[r + 1]));
        asm volatile("v_max3_f32 %0, %1, %2, %3" : "=v"(b2) : "v"(b2), "v"(c0[r + 2]), "v"(c0[r + 3]));
        asm volatile("v_max3_f32 %0, %1, %2, %3" : "=v"(a) : "v"(a), "v"(c1[r]), "v"(c1[r + 1]));
        asm volatile("v_max3_f32 %0, %1, %2, %3" : "=v"(b2) : "v"(b2), "v"(c1[r + 2]), "v"(c1[r + 3]));
    }
    float m;
    asm volatile("v_max_f32_e32 %0, %1, %2" : "=v"(m) : "v"(a), "v"(b2));
    return fmaxf(m, __shfl_xor(m, 32));
}
constexpr float AT_THR = 6.0f;
#define AT_PK2(P, i) cvtpk(P[i], P[i + 1])

__device__ __forceinline__ void at_step(f32x16& C0, f32x16& C1, const f32x16& P0, const f32x16& P1, f32x16 (&O)[4], const bf16x8 (&qf)[4],
                                        const __amdgpu_buffer_rsrc_t prs, const unsigned k_voff, const unsigned v_voff, const unsigned so0, u32x4 (&pk)[2], u32x4 (&pv)[2],
                                        const LAS unsigned char* kb, const LAS unsigned char* vbp, const LAS unsigned char* kbn,
                                        float& mhat, float& l_reg, bool& resc, const LAS float* lut, bool band, LAS float* wsf, int r32, int hi) {
    bf16x8 va[4], vb[4];
    u32x4 pw0, pw1, pw2, pw3;
    float sacc = 0.f;
    f32x16 z16;
#pragma unroll
    for (int r = 0; r < 16; ++r) z16[r] = 0.f;
    bf16x8 k0 = at_kfrag(kb, 0), k1 = at_kfrag(kb, 1);
    __builtin_amdgcn_s_setprio(1);
    C0 = __builtin_amdgcn_mfma_f32_32x32x16_bf16(k0, qf[0], z16, 0, 0, 0); k0 = at_kfrag(kb, 2); va[0] = at_vfrag(vbp, 0, 0);
    sacc += (P0[0] + P0[1]) + (P0[2] + P0[3]); pw0.x = AT_PK2(P0, 0); pw0.y = AT_PK2(P0, 2); AT_SB();
    C1 = __builtin_amdgcn_mfma_f32_32x32x16_bf16(k1, qf[0], z16, 0, 0, 0); k1 = at_kfrag(kb, 3); va[1] = at_vfrag(vbp, 0, 1);
    sacc += (P0[4] + P0[5]) + (P0[6] + P0[7]); pw0.z = AT_PK2(P0, 4); pw0.w = AT_PK2(P0, 6); AT_SB();
    C0 = __builtin_amdgcn_mfma_f32_32x32x16_bf16(k0, qf[1], C0, 0, 0, 0); k0 = at_kfrag(kb, 4); va[2] = at_vfrag(vbp, 0, 2);
    sacc += (P0[8] + P0[9]) + (P0[10] + P0[11]); pw1.x = AT_PK2(P0, 8); pw1.y = AT_PK2(P0, 10); AT_SB();
    C1 = __builtin_amdgcn_mfma_f32_32x32x16_bf16(k1, qf[1], C1, 0, 0, 0); k1 = at_kfrag(kb, 5); va[3] = at_vfrag(vbp, 0, 3);
    sacc += (P0[12] + P0[13]) + (P0[14] + P0[15]); pw1.z = AT_PK2(P0, 12); pw1.w = AT_PK2(P0, 14); AT_SB();
    C0 = __builtin_amdgcn_mfma_f32_32x32x16_bf16(k0, qf[2], C0, 0, 0, 0); k0 = at_kfrag(kb, 6);
    sacc += (P1[0] + P1[1]) + (P1[2] + P1[3]); pw2.x = AT_PK2(P1, 0); pw2.y = AT_PK2(P1, 2); AT_SB();
    C1 = __builtin_amdgcn_mfma_f32_32x32x16_bf16(k1, qf[2], C1, 0, 0, 0); k1 = at_kfrag(kb, 7);
    sacc += (P1[4] + P1[5]) + (P1[6] + P1[7]); pw2.z = AT_PK2(P1, 4); pw2.w = AT_PK2(P1, 6); AT_SB();
    C0 = __builtin_amdgcn_mfma_f32_32x32x16_bf16(k0, qf[3], C0, 0, 0, 0);
    sacc += (P1[8] + P1[9]) + (P1[10] + P1[11]); pw3.x = AT_PK2(P1, 8); pw3.y = AT_PK2(P1, 10); AT_SB();
    C1 = __builtin_amdgcn_mfma_f32_32x32x16_bf16(k1, qf[3], C1, 0, 0, 0);
    sacc += (P1[12] + P1[13]) + (P1[14] + P1[15]); pw3.z = AT_PK2(P1, 12); pw3.w = AT_PK2(P1, 14); AT_SB();
    { bf16x8 kone, qneg;
      { u32x4 t4 = (u32x4){0u, 0u, 0u, 0u}; if (hi == 0) t4.x = 0x3F80u; kone = __builtin_bit_cast(bf16x8, t4);
        t4.x = 0u; if (hi == 0) t4.x = cvtpk(-mhat, 0.f) & 0xffffu; qneg = __builtin_bit_cast(bf16x8, t4); }
      C0 = __builtin_amdgcn_mfma_f32_32x32x16_bf16(kone, qneg, C0, 0, 0, 0);
      C1 = __builtin_amdgcn_mfma_f32_32x32x16_bf16(kone, qneg, C1, 0, 0, 0); } AT_SB();
    pk[0] = __builtin_bit_cast(u32x4, __builtin_amdgcn_raw_buffer_load_b128(prs, k_voff, so0, 0)); pv[0] = __builtin_bit_cast(u32x4, __builtin_amdgcn_raw_buffer_load_b128(prs, v_voff, so0, 0));
    pk[1] = __builtin_bit_cast(u32x4, __builtin_amdgcn_raw_buffer_load_b128(prs, k_voff, so0 + 32u * 512u, 0)); pv[1] = __builtin_bit_cast(u32x4, __builtin_amdgcn_raw_buffer_load_b128(prs, v_voff, so0 + 32u * 512u, 0));
    l_reg += sacc;
    __builtin_amdgcn_s_setprio(0);
    if (band) {
#pragma unroll
        for (int r = 0; r < 16; ++r) { const int ko = (r & 3) + 8 * (r >> 2); C0[r] += lut[-ko]; C1[r] += lut[-ko - 32]; }
    }
    const float rm = at_rowmax(C0, C1);
    resc = false;
    if (__any(rm > AT_THR)) {
        const float m_new = bf2f((unsigned short)(cvtpk(mhat + fmaxf(rm, 0.f), 0.f) & 0xffffu));
        const float dl = m_new - mhat;
        const float f = fast_exp2(-dl);
        l_reg *= f; if (hi == 0) wsf[r32] = f; mhat = m_new; resc = true;
#pragma unroll
        for (int r = 0; r < 16; ++r) { C0[r] -= dl; C1[r] -= dl; }
    }
    AT_SB();
    __builtin_amdgcn_s_setprio(1);
    const bf16x8 pa0 = __builtin_bit_cast(bf16x8, pw0), pa1 = __builtin_bit_cast(bf16x8, pw1), pa2 = __builtin_bit_cast(bf16x8, pw2), pa3 = __builtin_bit_cast(bf16x8, pw3);
#define AT_EX2(X, i) do { X[i] = fast_exp2(X[i]); X[i + 1] = fast_exp2(X[i + 1]); } while (0)
    O[0] = __builtin_amdgcn_mfma_f32_32x32x16_bf16(pa0, va[0], O[0], 0, 0, 0); vb[0] = at_vfrag(vbp, 1, 0); AT_EX2(C0, 0); AT_SB();
    O[0] = __builtin_amdgcn_mfma_f32_32x32x16_bf16(pa1, va[1], O[0], 0, 0, 0); vb[1] = at_vfrag(vbp, 1, 1); AT_EX2(C0, 2); AT_SB();
    O[0] = __builtin_amdgcn_mfma_f32_32x32x16_bf16(pa2, va[2], O[0], 0, 0, 0); vb[2] = at_vfrag(vbp, 1, 2); AT_EX2(C0, 4); AT_SB();
    O[0] = __builtin_amdgcn_mfma_f32_32x32x16_bf16(pa3, va[3], O[0], 0, 0, 0); vb[3] = at_vfrag(vbp, 1, 3); AT_EX2(C0, 6); AT_SB();
    O[1] = __builtin_amdgcn_mfma_f32_32x32x16_bf16(pa0, vb[0], O[1], 0, 0, 0); va[0] = at_vfrag(vbp, 2, 0); AT_EX2(C0, 8); AT_SB();
    O[1] = __builtin_amdgcn_mfma_f32_32x32x16_bf16(pa1, vb[1], O[1], 0, 0, 0); va[1] = at_vfrag(vbp, 2, 1); AT_EX2(C0, 10); AT_SB();
    O[1] = __builtin_amdgcn_mfma_f32_32x32x16_bf16(pa2, vb[2], O[1], 0, 0, 0); va[2] = at_vfrag(vbp, 2, 2); AT_EX2(C0, 12); AT_SB();
    O[1] = __builtin_amdgcn_mfma_f32_32x32x16_bf16(pa3, vb[3], O[1], 0, 0, 0); va[3] = at_vfrag(vbp, 2, 3); AT_EX2(C0, 14); AT_SB();
    O[2] = __builtin_amdgcn_mfma_f32_32x32x16_bf16(pa0, va[0], O[2], 0, 0, 0); vb[0] = at_vfrag(vbp, 3, 0); AT_EX2(C1, 0); AT_SB();
    O[2] = __builtin_amdgcn_mfma_f32_32x32x16_bf16(pa1, va[1], O[2], 0, 0, 0); vb[1] = at_vfrag(vbp, 3, 1); AT_EX2(C1, 2); AT_SB();
    O[2] = __builtin_amdgcn_mfma_f32_32x32x16_bf16(pa2, va[2], O[2], 0, 0, 0); vb[2] = at_vfrag(vbp, 3, 2); AT_EX2(C1, 4); AT_SB();
    O[2] = __builtin_amdgcn_mfma_f32_32x32x16_bf16(pa3, va[3], O[2], 0, 0, 0); vb[3] = at_vfrag(vbp, 3, 3); AT_EX2(C1, 6); AT_SB();
    O[3] = __builtin_amdgcn_mfma_f32_32x32x16_bf16(pa0, vb[0], O[3], 0, 0, 0); AT_EX2(C1, 8); AT_SB();
    O[3] = __builtin_amdgcn_mfma_f32_32x32x16_bf16(pa1, vb[1], O[3], 0, 0, 0); AT_EX2(C1, 10); AT_SB();
    O[3] = __builtin_amdgcn_mfma_f32_32x32x16_bf16(pa2, vb[2], O[3], 0, 0, 0); AT_EX2(C1, 12); AT_SB();
    O[3] = __builtin_amdgcn_mfma_f32_32x32x16_bf16(pa3, vb[3], O[3], 0, 0, 0); AT_EX2(C1, 14); AT_SB();
    __builtin_amdgcn_s_setprio(0);
#undef AT_EX2
}
__device__ __forceinline__ void at_rescale(f32x16 (&O)[4], const LAS float* wsf, int hi) {
#pragma unroll
    for (int gq = 0; gq < 4; ++gq) { const f32x4 al = *(const LAS f32x4*)(wsf + 8 * gq + 4 * hi);
#pragma unroll
        for (int db = 0; db < 4; ++db) { O[db][4 * gq + 0] *= al.x; O[db][4 * gq + 1] *= al.y; O[db][4 * gq + 2] *= al.z; O[db][4 * gq + 3] *= al.w; } }
}

__device__ __forceinline__ void attn_unit(const Frame& F, const Args& a, int bh, int qb, float lam) {
    const int b = bh >> 2, h = bh & 3;
    const bf16* KVb = (const bf16*)(a.ws + WS_KV) + (size_t)bh * SEQ * 256;
    const bf16* QCb = (const bf16*)(a.ws + WS_QC) + (size_t)bh * SEQ * 128;
    LAS unsigned char* lds = F.lds;
    int tid = F.tid; asm volatile("" : "+v"(tid));
    const int lane = tid & 63, w = F.wave, wq = w & 3, mc = w >> 2, r32 = lane & 31, hi = lane >> 5;
    const int q0 = qb * 128, NT = 2 * qb + 2;
    LAS float* wsf = (LAS float*)(lds + AT_WS + 256 * w);
    const int k_kv = ((tid >> 7) << 3) + (tid & 7), k_ch = (tid >> 3) & 15;
    const int k_lds = (k_ch >> 3) * 8192 + (k_ch & 7) * 1024 + k_kv * 16;
    const unsigned k_voff = (unsigned)(k_kv * 256 + k_ch * 8) * 2u;
    const int v_kv = (((tid >> 5) & 15) << 1) + ((tid >> 2) & 1), v_ch = (((tid >> 3) & 3) << 2) + (tid & 3);
    const int v_lds = 16384 + (v_ch >> 2) * 4096 + v_kv * 64 + (v_ch & 3) * 16;
    const unsigned v_voff = (unsigned)(v_kv * 256 + 128 + v_ch * 8) * 2u;
    const __amdgpu_buffer_rsrc_t prs = __builtin_amdgcn_make_buffer_rsrc((void*)KVb, (short)0, SEQ * 512, 0x00020000);
    u32x4 pk[2], pv[2];
#define AT_LOAD(j) do { _Pragma("unroll") for (int i = 0; i < 2; ++i) { const unsigned so = (unsigned)(((j) * 64 + 32 * i) * 512); \
        pk[i] = __builtin_bit_cast(u32x4, __builtin_amdgcn_raw_buffer_load_b128(prs, k_voff, so, 0)); pv[i] = __builtin_bit_cast(u32x4, __builtin_amdgcn_raw_buffer_load_b128(prs, v_voff, so, 0)); } } while (0)
#define AT_STORE(bufo) do { _Pragma("unroll") for (int i = 0; i < 2; ++i) { *(LAS u32x4*)(lds + (bufo) + k_lds + 32 * 16 * i) = pk[i]; *(LAS u32x4*)(lds + (bufo) + v_lds + 32 * 64 * i) = pv[i]; } } while (0)
    bf16x8 qf[4];
    { const bf16* qp = QCb + (size_t)(q0 + 32 * wq + r32) * 128 + mc * 64 + 8 * hi;
#pragma unroll
      for (int d0 = 0; d0 < 4; ++d0) qf[d0] = *(const bf16x8*)(qp + 16 * d0); }
    f32x16 O[4];
#pragma unroll
    for (int db = 0; db < 4; ++db)
#pragma unroll
        for (int r = 0; r < 16; ++r) O[db][r] = 0.f;
    float mhat = -INFINITY, l_reg = 0.f;
    {
        u32x4 qk[3][2], qv[3][2]; const int j2 = NT > 2 ? 2 : 1;
#pragma unroll
        for (int tl = 0; tl < 3; ++tl) { const int jt = tl < 2 ? tl : j2;
#pragma unroll
            for (int i = 0; i < 2; ++i) { const unsigned so = (unsigned)((jt * 64 + 32 * i) * 512);
                qk[tl][i] = __builtin_bit_cast(u32x4, __builtin_amdgcn_raw_buffer_load_b128(prs, k_voff, so, 0)); qv[tl][i] = __builtin_bit_cast(u32x4, __builtin_amdgcn_raw_buffer_load_b128(prs, v_voff, so, 0)); } }
#pragma unroll
        for (int tl = 0; tl < 3; ++tl)
#pragma unroll
            for (int i = 0; i < 2; ++i) { *(LAS u32x4*)(lds + tl * AT_BUF + k_lds + 32 * 16 * i) = qk[tl][i]; *(LAS u32x4*)(lds + tl * AT_BUF + v_lds + 32 * 64 * i) = qv[tl][i]; }
    }
    __syncthreads();
    const int koff = mc * 8192 + hi * 1024 + r32 * 16;
    const int voff = 16384 + ((lane >> 4) & 1) * 32 + (lane & 3) * 8 + (4 * hi + ((lane & 15) >> 2)) * 64;
    const LAS float* lutp = (const LAS float*)(lds + AT_LUT) + (q0 + 32 * wq + r32 + 127 - 4 * hi);
    f32x16 pA0, pA1, pB0, pB1;
    at_qk(pA0, pA1, lds + koff, qf);
    if (0 >= NT - 4) {
#pragma unroll
        for (int r = 0; r < 16; ++r) { const int ko = (r & 3) + 8 * (r >> 2); pA0[r] += lutp[-ko]; pA1[r] += lutp[-ko - 32]; }
    }
    mhat = bf2f((unsigned short)(cvtpk(at_rowmax(pA0, pA1), 0.f) & 0xffffu));
#pragma unroll
    for (int r = 0; r < 16; ++r) { pA0[r] = fast_exp2(pA0[r] - mhat); pA1[r] = fast_exp2(pA1[r] - mhat); }
    bool resc = false;
#define AT_SLOT(t) (((t) & 3) * AT_BUF)
#define AT_STEP(CA, CB, PA, PB, t) do { const int jl_ = ((t) + 2 < NT) ? (t) + 2 : NT - 1; \
        at_step(CA, CB, PA, PB, O, qf, prs, k_voff, v_voff, (unsigned)(jl_ * 64 * 512), pk, pv, lds + AT_SLOT(t) + koff, lds + AT_SLOT((t) - 1) + voff, lds + AT_SLOT((t) + 1) + koff, mhat, l_reg, resc, lutp - 64 * (t), (t) >= NT - 4, wsf, r32, hi); \
        AT_STORE(AT_SLOT((t) + 2)); __syncthreads(); if (resc) at_rescale(O, wsf, hi); } while (0)
    int t = 1;
    for (; t + 1 < NT; t += 2) { AT_STEP(pB0, pB1, pA0, pA1, t); AT_STEP(pA0, pA1, pB0, pB1, t + 1); }
    AT_STEP(pB0, pB1, pA0, pA1, t);
    {
        float sacc = 0.f;
#pragma unroll
        for (int r = 0; r < 16; ++r) sacc += pB0[r] + pB1[r];
        l_reg += sacc;
        u32x4 q4; bf16x8 pa[4];
        q4.x = AT_PK2(pB0, 0); q4.y = AT_PK2(pB0, 2); q4.z = AT_PK2(pB0, 4); q4.w = AT_PK2(pB0, 6); pa[0] = __builtin_bit_cast(bf16x8, q4);
        q4.x = AT_PK2(pB0, 8); q4.y = AT_PK2(pB0, 10); q4.z = AT_PK2(pB0, 12); q4.w = AT_PK2(pB0, 14); pa[1] = __builtin_bit_cast(bf16x8, q4);
        q4.x = AT_PK2(pB1, 0); q4.y = AT_PK2(pB1, 2); q4.z = AT_PK2(pB1, 4); q4.w = AT_PK2(pB1, 6); pa[2] = __builtin_bit_cast(bf16x8, q4);
        q4.x = AT_PK2(pB1, 8); q4.y = AT_PK2(pB1, 10); q4.z = AT_PK2(pB1, 12); q4.w = AT_PK2(pB1, 14); pa[3] = __builtin_bit_cast(bf16x8, q4);
        const LAS unsigned char* vbp = lds + AT_SLOT(NT - 1) + voff;
#pragma unroll
        for (int db = 0; db < 4; ++db)
#pragma unroll
            for (int ks = 0; ks < 4; ++ks) O[db] = __builtin_amdgcn_mfma_f32_32x32x16_bf16(pa[ks], at_vfrag(vbp, db, ks), O[db], 0, 0, 0);
    }
    __syncthreads();
    l_reg = sum_x32(l_reg, l_reg);
    { const float sc = (mc == 0 ? 1.f : lam) * fast_rcp(l_reg);
      if (hi == 0) wsf[r32] = sc;
      at_rescale(O, wsf, hi); }
    LAS float* ex = (LAS float*)lds + (mc * 4 + wq) * 4096;
#pragma unroll
    for (int db = 0; db < 4; ++db)
#pragma unroll
        for (int r = 0; r < 16; ++r) ex[crow(r, hi) * 128 + 32 * db + r32] = O[db][r];
    __syncthreads();
    {
        const int l15 = lane & 15, lr = lane >> 4;
        float gv[8];
        { const float* sg = a.in[11] + 8 * l15;
#pragma unroll
          for (int i = 0; i < 8; ++i) gv[i] = sg[i] * 0.8f; }
        bf16* Y = (bf16*)(a.ws + WS_Y) + (size_t)(b * SEQ + q0) * D + h * 128 + 8 * l15;
#pragma unroll
        for (int p = 0; p < 4; ++p) { const int R = 16 * w + 4 * p + lr;
            const LAS float* pa = (const LAS float*)lds + (R >> 5) * 4096 + (R & 31) * 128 + 8 * l15; const LAS float* pb = pa + 4 * 4096;
            const f32x4 a0 = *(const LAS f32x4*)pa, a1 = *(const LAS f32x4*)(pa + 4), b0 = *(const LAS f32x4*)pb, b1 = *(const LAS f32x4*)(pb + 4);
            const f32x4 o0 = a0 - b0, o1 = a1 - b1;
            float ss = (o0.x * o0.x + o0.y * o0.y) + (o0.z * o0.z + o0.w * o0.w) + (o1.x * o1.x + o1.y * o1.y) + (o1.z * o1.z + o1.w * o1.w);
            ss = row_sum(ss);
            const float rr = __builtin_amdgcn_rsqf(ss * (1.f / 128.f) + EPS);
            u32x4 yo;
            yo.x = cvtpk(o0.x * rr * gv[0], o0.y * rr * gv[1]); yo.y = cvtpk(o0.z * rr * gv[2], o0.w * rr * gv[3]);
            yo.z = cvtpk(o1.x * rr * gv[4], o1.y * rr * gv[5]); yo.w = cvtpk(o1.z * rr * gv[6], o1.w * rr * gv[7]);
            *(u32x4*)(Y + (size_t)R * D) = yo; }
    }
    __syncthreads();
#undef AT_LOAD
#undef AT_STORE
#undef AT_SLOT
#undef AT_STEP
}

__device__ __forceinline__ void p2_mixers(const Frame& F, const Args& a) {
    float lam;
    { const float v1 = a.in[7][F.lane] * a.in[8][F.lane], v2 = a.in[9][F.lane] * a.in[10][F.lane];
      lam = __expf(wave_sum(v1)) - __expf(wave_sum(v2)) + 0.2f; }
    const int per = F.G / 32;
    if (per < 1) return;
    const int bh = F.vcu / per, s = F.vcu % per;
    if (bh >= 32) return;
    { const int h = bh & 3; const float* tab = a.in[12]; const float t31 = tab[31 * 4 + h];
      for (int i = F.tid; i < 384; i += NTHREADS) { const int dist = i - 127; ((LAS float*)(F.lds + AT_LUT))[i] = dist < 0 ? -INFINITY : (tab[t5_bucket(dist) * 4 + h] - t31) * LOG2E; } }
    if (s == 0) hgrn_stream(F, a, bh);
    constexpr int NDYN = 14;
    if (s >= 1) {
        const int na = per - 1;
        for (int k = 0; k * na < 64 - NDYN; ++k) {
            const int idx = k * na + ((k & 1) ? (na - s) : (s - 1));
            if (idx < 64 - NDYN) attn_unit(F, a, bh, 63 - idx, lam);
        }
    }
    {
        unsigned* qhead = (unsigned*)(a.ws + WS_CTL) + CW_Q + 64 * bh;
        LAS unsigned* tk = (LAS unsigned*)(F.lds + AT_TKT);
        for (;;) {
            if (F.tid == 0) *tk = __hip_atomic_fetch_add(qhead, 1u, __ATOMIC_RELAXED, __HIP_MEMORY_SCOPE_AGENT);
            __syncthreads();
            const unsigned t = *tk;
            __syncthreads();
            if (t >= (unsigned)NDYN) break;
            attn_unit(F, a, bh, NDYN - 1 - (int)t, lam);
        }
    }
}

constexpr int RT_W = 0, RT_HIST = 73728, RT_BASE = 73856;
__device__ __forceinline__ void p4_router(const Frame& F, const Args& a) {
    LAS unsigned char* lds = F.lds;
    const float* wg = a.in[16]; const float* bg = a.in[17]; const float* we = a.in[18]; const float* be = a.in[19];
    for (int i = F.tid; i < 4 * 1024; i += NTHREADS) { const int d = i >> 2, e = i & 3;
        ((LAS unsigned short*)(lds + RT_W))[e * 1024 + d] = (unsigned short)(cvtpk(wg[i], 0.f) & 0xffffu); }
    for (int i = F.tid; i < 32 * 1024; i += NTHREADS) { const int d = i >> 5, e = i & 31;
        ((LAS unsigned short*)(lds + RT_W))[(4 + e) * 1024 + d] = (unsigned short)(cvtpk(we[i], 0.f) & 0xffffu); }
    if (F.tid < 32) ((LAS unsigned*)(lds + RT_HIST))[F.tid] = 0u;
    __syncthreads();
    const bf16* x1 = (const bf16*)(a.ws + WS_X1B); const float* ng = a.in[5]; const float* mod = (const float*)(a.ws + WS_MOD);
    bf16* H = (bf16*)(a.ws + WS_H);
    const int gw = F.vcu * NWAVES + F.wave, NGW = F.G * NWAVES, lane = F.lane;
    int my_tok = -1, my_e0 = 0, my_e1 = 0; float my_w0 = 0.f, my_w1 = 0.f;
    const int per = (NTOK + NGW - 1) / NGW;
    const int m0 = gw * per, m1 = (m0 + per < NTOK) ? m0 + per : NTOK;
    int it = 0;
    for (int s0 = m0; s0 < m1; ) {
      const int b = s0 >> 13, e1 = ((b + 1) << 13) < m1 ? ((b + 1) << 13) : m1;
      f32x4 ga[4], sha[4];
      { const f32x4* gp = (const f32x4*)ng + lane; const f32x4* shp = (const f32x4*)(mod + b * 6144 + 3072) + lane; const f32x4* scp = (const f32x4*)(mod + b * 6144 + 4096) + lane;
#pragma unroll
        for (int j = 0; j < 4; ++j) { ga[j] = gp[64 * j] * (scp[64 * j] + 1.f); sha[j] = shp[64 * j]; } }
      u32x2 nxv[4];
      { const u32x2* xr = (const u32x2*)(x1 + (size_t)s0 * D) + lane;
#pragma unroll
        for (int j = 0; j < 4; ++j) nxv[j] = xr[64 * j]; }
      for (int m = s0; m < e1; ++m, ++it) {
        f32x4 v[4]; float s = 0.f;
#pragma unroll
        for (int j = 0; j < 4; ++j) { const u32x2 xv = nxv[j]; v[j] = (f32x4){bflo(xv.x), bfhi(xv.x), bflo(xv.y), bfhi(xv.y)}; s += (v[j].x * v[j].x + v[j].y * v[j].y) + (v[j].z * v[j].z + v[j].w * v[j].w); }
        { const int mn = (m + 1 < e1) ? m + 1 : m; const u32x2* xr = (const u32x2*)(x1 + (size_t)mn * D) + lane;
#pragma unroll
          for (int j = 0; j < 4; ++j) nxv[j] = xr[64 * j]; }
        const float r = __builtin_amdgcn_rsqf(wave_sum(s) * (1.f / D) + EPS);
        u32x2* o8 = (u32x2*)(H + (size_t)m * D) + lane;
        u32x2 hp[4];
#pragma unroll
        for (int j = 0; j < 4; ++j) {
            v[j] = v[j] * r * ga[j] + sha[j];
            u32x2 o; o.x = cvtpk(v[j].x, v[j].y); o.y = cvtpk(v[j].z, v[j].w); o8[64 * j] = o; asm("" : "+v"(o.x), "+v"(o.y)); hp[j] = o; }
        asm volatile("" ::: "memory");
        float lg[4];
#pragma unroll
        for (int e = 0; e < 4; ++e) { float acc = 0.f;
#pragma unroll
            for (int j = 0; j < 4; ++j) { const u32x2 wv = *(const LAS u32x2*)(lds + RT_W + (e * 1024 + 256 * j + 4 * lane) * 2);
                acc = dot2bf(wv.x, hp[j].x, acc); acc = dot2bf(wv.y, hp[j].y, acc); }
            lg[e] = wave_sum(acc) + bg[e]; }
        int gi = 0; float gm = lg[0];
#pragma unroll
        for (int i = 1; i < 4; ++i) if (lg[i] > gm) { gm = lg[i]; gi = i; }
        gi = __builtin_amdgcn_readfirstlane(gi);
        float gs = 0.f;
#pragma unroll
        for (int i = 0; i < 4; ++i) gs += __expf(lg[i] - gm);
        const float gate = 1.f / gs;
        float pe[8];
        { const LAS unsigned char* wb_ = lds + RT_W + (size_t)(4 + gi * 8) * 2048;
#pragma unroll
          for (int e = 0; e < 8; ++e) { float acc = 0.f;
#pragma unroll
              for (int j = 0; j < 4; ++j) { const u32x2 wv = *(const LAS u32x2*)(wb_ + (e * 1024 + 256 * j + 4 * lane) * 2);
                  acc = dot2bf(wv.x, hp[j].x, acc); acc = dot2bf(wv.y, hp[j].y, acc); }
              pe[e] = acc; } }
        float t4[4], t2[2], t1;
#pragma unroll
        for (int i = 0; i < 4; ++i) t4[i] = sum_x32(pe[i], pe[i + 4]);
#pragma unroll
        for (int i = 0; i < 2; ++i) t2[i] = sum_x16(t4[i], t4[i + 2]);
        { const bool up = (lane & 8) != 0; const float keep = up ? t2[1] : t2[0], send = up ? t2[0] : t2[1]; t1 = keep + dppf<0x128>(send); }
        t1 += dppf<0xB1>(t1); t1 += dppf<0x4E>(t1); t1 += dppf<0x141>(t1);
        float el[8];
#pragma unroll
        for (int i = 0; i < 8; ++i) el[i] = __builtin_bit_cast(float, __builtin_amdgcn_readlane(__builtin_bit_cast(int, t1), 8 * ((i & 1) + 2 * ((i >> 1) & 1) + 4 * ((i >> 2) & 1)))) + be[gi * 8 + i];
        int ia = 0; float va = el[0];
#pragma unroll
        for (int i = 1; i < 8; ++i) if (el[i] > va) { va = el[i]; ia = i; }
        int ib = -1; float vb = -INFINITY;
#pragma unroll
        for (int i = 0; i < 8; ++i) if (i != ia && el[i] > vb) { vb = el[i]; ib = i; }
        const float wa = gate / (1.f + __expf(vb - va)), wb = gate - wa;
        if (lane == it) { my_tok = m; my_e0 = gi * 8 + ia; my_e1 = gi * 8 + ib; my_w0 = wa; my_w1 = wb; }
      }
      s0 = e1;
    }
    LAS unsigned* hist = (LAS unsigned*)(lds + RT_HIST); LAS unsigned* base = (LAS unsigned*)(lds + RT_BASE);
    unsigned r0 = 0, r1 = 0;
    if (my_tok >= 0) { r0 = atomicAdd((unsigned*)hist + my_e0, 1u); r1 = atomicAdd((unsigned*)hist + my_e1, 1u); }
    __syncthreads();
    unsigned* cnt = (unsigned*)(a.ws + WS_CTL) + CW_CNT;
    if (F.tid < 32) { const unsigned hv = hist[F.tid]; base[F.tid] = hv ? __hip_atomic_fetch_add(cnt + F.tid, hv, __ATOMIC_RELAXED, __HIP_MEMORY_SCOPE_AGENT) : 0u; }
    __syncthreads();
    if (my_tok >= 0) {
        int* list = (int*)(a.ws + WS_LIST); float* tw = (float*)(a.ws + WS_TOKW);
        const int p0_ = (int)(base[my_e0] + r0), p1_ = (int)(base[my_e1] + r1);
        list[(size_t)my_e0 * NTOK + p0_] = my_tok * 2;
        list[(size_t)my_e1 * NTOK + p1_] = my_tok * 2 + 1;
        tw[my_tok * 2] = my_w0; tw[my_tok * 2 + 1] = my_w1;
        int* toks = (int*)(a.ws + WS_TOKS);
        toks[my_tok * 2] = (my_e0 << 20) | p0_; toks[my_tok * 2 + 1] = (my_e1 << 20) | p1_;
    }
}

constexpr int MOE_CNTL = MISC_OFF + 256, MOE_LTOK = MISC_OFF + 4096, MOE_MAXU = 12;
struct MoeOrder {
    const LAS int* pre; const LAS int* cntl; const LAS int* ltok; const int* list; int G, c, lane; bool gather;
    __device__ __forceinline__ bool next(int i, pg8::Unit& u) const {
        const int total = pre[32];
        int rt, pn;
        if (G == 256) {
            rt = (i * 8 + (c & 7)) * 8 + ((c >> 3) & 7); pn = c >> 6;
            if (rt >= total) return false;
        } else { const long L = (long)i * G + c; if (L >= (long)total * 4) return false; rt = (int)(L >> 2); pn = (int)(L & 3); }
        const int e = __builtin_popcountll(__ballot(pre[(lane & 31) + 1] <= rt) & 0xffffffffull);
        u.e = e; u.pm = rt; u.pn = e * 4 + pn; u.r0 = (rt - pre[e]) * 256; const int n = cntl[e] - u.r0; u.nrows = n < 256 ? n : 256; u.slot = i; return true;
    }
    __device__ __forceinline__ int arow(const pg8::Unit& u, int r) const {
        if (!gather) return u.pm * 256 + r;
        if (u.slot < MOE_MAXU) return ltok[u.slot * 256 + r];
        return r < u.nrows ? (list[(size_t)u.e * NTOK + u.r0 + r] >> 1) : 0;
    }
};
struct EpiSwiGLU {
    static constexpr bool PERM = true;
    static constexpr int NST = 8;
    bf16* act;
    LAS unsigned char* scr;
    __device__ __forceinline__ void operator()(const f32x4 (&acc)[2][2][4][2], const pg8::Unit& u, int wr, int wc, int fr, int fq) const {
        LAS unsigned char* ws_ = scr + (wr * 4 + wc) * 2048;
        const int l = fr + 16 * fq, r8 = l >> 3, c8 = l & 7;
        bf16* base = act + (size_t)(u.pm * 256 + wr * 64 + (c8 >> 2) * 16 + r8) * FF + (u.pn & 3) * 128 + wc * 32 + 8 * (c8 & 3);
        u32x4 rq[2][2];
#pragma unroll
        for (int it = 0; it <= 4; ++it) {
            if (it < 4) { const int ai = it >> 1, m2 = it & 1; u32x4 w[2];
#pragma unroll
                for (int q = 0; q < 2; ++q) { const int m = 2 * m2 + q; const f32x4 a0 = acc[ai][0][m][0], a1 = acc[ai][0][m][1], b0 = acc[ai][1][m][0], b1 = acc[ai][1][m][1];
                    w[q].x = cvtpk(siluf_(a0.x) * b0.x, siluf_(a0.y) * b0.y); w[q].y = cvtpk(siluf_(a0.z) * b0.z, siluf_(a0.w) * b0.w);
                    w[q].z = cvtpk(siluf_(a1.x) * b1.x, siluf_(a1.y) * b1.y); w[q].w = cvtpk(siluf_(a1.z) * b1.z, siluf_(a1.w) * b1.w); }
                pg8::xpose128(ws_, fr, fq, w[0], w[1], rq[it & 1][0], rq[it & 1][1]); }
            if (it > 0) { const int ai = (it - 1) >> 1, m2 = (it - 1) & 1;
                bf16* rowp = base + (size_t)(ai * 128 + m2 * 32) * FF;
                *(u32x4*)rowp = rq[(it - 1) & 1][0]; *(u32x4*)(rowp + (size_t)8 * FF) = rq[(it - 1) & 1][1]; } }
    }
};
struct EpiScatter {
    static constexpr bool PERM = true;
    static constexpr int NST = 16;
    bf16* ybuf;
    LAS unsigned char* scr;
    __device__ __forceinline__ void operator()(const f32x4 (&acc)[2][2][4][2], const pg8::Unit& u, int wr, int wc, int fr, int fq) const {
        LAS unsigned char* ws_ = scr + (wr * 4 + wc) * 2048;
        const int l = fr + 16 * fq, r8 = l >> 3, c8 = l & 7;
        bf16* base = ybuf + (size_t)(u.pm * 256 + wr * 64 + r8) * D + (u.pn & 3) * 256 + wc * 64 + 8 * c8;
        u32x4 rq[2][2];
#pragma unroll
        for (int it = 0; it <= 8; ++it) {
            if (it < 8) { const int ai = it >> 2, m = it & 3; u32x4 w[2];
#pragma unroll
                for (int bj = 0; bj < 2; ++bj) { const f32x4 v0 = acc[ai][bj][m][0], v1 = acc[ai][bj][m][1];
                    w[bj].x = cvtpk(v0.x, v0.y); w[bj].y = cvtpk(v0.z, v0.w); w[bj].z = cvtpk(v1.x, v1.y); w[bj].w = cvtpk(v1.z, v1.w); }
                pg8::xpose128(ws_, fr, fq, w[0], w[1], rq[it & 1][0], rq[it & 1][1]); }
            if (it > 0) { const int ai = (it - 1) >> 2, m = (it - 1) & 3;
                bf16* rowp = base + (size_t)(ai * 128 + m * 16) * D;
                *(u32x4*)rowp = rq[(it - 1) & 1][0]; *(u32x4*)(rowp + (size_t)8 * D) = rq[(it - 1) & 1][1]; } }
    }
};

__device__ __forceinline__ void p7_final(const Frame& F, const Args& a) {
    float* out = a.out; const float* fg = a.in[23]; const float* mod = (const float*)(a.ws + WS_MOD);
    const bf16* yb = (const bf16*)(a.ws + WS_YBUF); const float* tw = (const float*)(a.ws + WS_TOKW); const int* toks = (const int*)(a.ws + WS_TOKS); const bf16* x1b = (const bf16*)(a.ws + WS_X1B);
    const int gw = F.vcu * NWAVES + F.wave, NGW = F.G * NWAVES, lane = F.lane;
    const int per = (NTOK + NGW - 1) / NGW;
    const int m0 = gw * per, m1 = (m0 + per < NTOK) ? m0 + per : NTOK;
    if (m0 >= NTOK) return;
    const int prev = ((const LAS int*)(F.lds + MISC_OFF))[lane & 31];
    u32x4 nx[2], ny0[2], ny1[2];
#define P7_ROW(sv) (__builtin_amdgcn_readlane(prev, (sv) >> 20) * 256 + ((sv) & 0xFFFFF))
#define P7_LOAD(mm, ra, rb) do { _Pragma("unroll") for (int j = 0; j < 2; ++j) { nx[j] = *((const u32x4*)(x1b + (size_t)(mm) * D) + lane + 64 * j); \
        ny0[j] = *((const u32x4*)(yb + (size_t)(ra) * D) + lane + 64 * j); ny1[j] = *((const u32x4*)(yb + (size_t)(rb) * D) + lane + 64 * j); } } while (0)
    f32x4 fgr[2][2];
#pragma unroll
    for (int j = 0; j < 2; ++j) { const f32x4* gp = (const f32x4*)(fg + 512 * j) + 2 * lane; fgr[j][0] = gp[0]; fgr[j][1] = gp[1]; }
    for (int s0 = m0; s0 < m1; ) {
        const int b = s0 >> 13; int e1 = ((b + 1) << 13) < m1 ? ((b + 1) << 13) : m1; if (e1 > s0 + 32) e1 = s0 + 32;
        const int nrow = e1 - s0;
        const int tv = (lane < 2 * nrow) ? toks[2 * s0 + lane] : 0; const float wv = (lane < 2 * nrow) ? tw[2 * s0 + lane] : 0.f;
        f32x4 g2r[2][2];
#pragma unroll
        for (int j = 0; j < 2; ++j) { const f32x4* g2p = (const f32x4*)(mod + b * 6144 + 5120 + 512 * j) + 2 * lane; g2r[j][0] = g2p[0]; g2r[j][1] = g2p[1]; }
        { const int sa = __builtin_amdgcn_readlane(tv, 0), sb = __builtin_amdgcn_readlane(tv, 1); P7_LOAD(s0, P7_ROW(sa), P7_ROW(sb)); }
        for (int i = 0; i < nrow; ++i) { const int m = s0 + i;
            u32x4 cx[2], cy0[2], cy1[2];
#pragma unroll
            for (int j = 0; j < 2; ++j) { cx[j] = nx[j]; cy0[j] = ny0[j]; cy1[j] = ny1[j]; }
            { const int in_ = (i + 1 < nrow) ? i + 1 : i; const int sa = __builtin_amdgcn_readlane(tv, 2 * in_), sb = __builtin_amdgcn_readlane(tv, 2 * in_ + 1); P7_LOAD(s0 + in_, P7_ROW(sa), P7_ROW(sb)); }
            const float w0 = __builtin_bit_cast(float, __builtin_amdgcn_readlane(__builtin_bit_cast(int, wv), 2 * i)), w1 = __builtin_bit_cast(float, __builtin_amdgcn_readlane(__builtin_bit_cast(int, wv), 2 * i + 1));
            float v[2][8]; float s = 0.f;
#pragma unroll
            for (int j = 0; j < 2; ++j) { const f32x4 ga = g2r[j][0], gb = g2r[j][1];
                const float g2[8] = {ga.x, ga.y, ga.z, ga.w, gb.x, gb.y, gb.z, gb.w};
                const unsigned xw[4] = {cx[j].x, cx[j].y, cx[j].z, cx[j].w}, aw[4] = {cy0[j].x, cy0[j].y, cy0[j].z, cy0[j].w}, bw[4] = {cy1[j].x, cy1[j].y, cy1[j].z, cy1[j].w};
#pragma unroll
                for (int k = 0; k < 4; ++k) { const float mm0 = w0 * bflo(aw[k]) + w1 * bflo(bw[k]), mm1 = w0 * bfhi(aw[k]) + w1 * bfhi(bw[k]);
                    v[j][2 * k] = bflo(xw[k]) + g2[2 * k] * mm0; v[j][2 * k + 1] = bfhi(xw[k]) + g2[2 * k + 1] * mm1;
                    s += v[j][2 * k] * v[j][2 * k] + v[j][2 * k + 1] * v[j][2 * k + 1]; } }
            const float r = __builtin_amdgcn_rsqf(wave_sum(s) * (1.f / D) + EPS);
#pragma unroll
            for (int j = 0; j < 2; ++j) { const f32x4 ga = fgr[j][0], gb = fgr[j][1];
                f32x4* op = (f32x4*)(out + (size_t)m * D + 512 * j) + 2 * lane;
                op[0] = (f32x4){v[j][0] * r * ga.x, v[j][1] * r * ga.y, v[j][2] * r * ga.z, v[j][3] * r * ga.w};
                op[1] = (f32x4){v[j][4] * r * gb.x, v[j][5] * r * gb.y, v[j][6] * r * gb.z, v[j][7] * r * gb.w}; }
        }
        s0 = e1;
    }
#undef P7_LOAD
#undef P7_ROW
}

constexpr unsigned long long P1_CPERM = 0x0ull | (0ull << 0) | (1ull << 4) | (2ull << 8) | (3ull << 12) | (4ull << 16) | (5ull << 20) | (10ull << 24) | (11ull << 28)
                                       | (6ull << 32) | (7ull << 36) | (12ull << 40) | (13ull << 44) | (8ull << 48) | (9ull << 52) | (15ull << 60);
#define LOAD_ARGS(la) Args la; { const __attribute__((address_space(4))) Args* ap_ = (const __attribute__((address_space(4))) Args*)__builtin_amdgcn_kernarg_segment_ptr(); asm volatile("" : "+s"(ap_)); la = *(const Args*)ap_; }
__global__ void __launch_bounds__(NTHREADS, 2) fwd_megakernel(Args args_unused) {
    extern __shared__ __attribute__((aligned(16))) unsigned char lds_raw[];
    cg::grid_group grid = cg::this_grid();
    Frame F;
    F.lds = (LAS unsigned char*)lds_raw;
    F.tid = threadIdx.x; F.lane = F.tid & 63; F.wave = __builtin_amdgcn_readfirstlane(F.tid >> 6);
    F.G = gridDim.x; { const int bx = blockIdx.x; F.vcu = (F.G % 8 == 0) ? (bx % 8) * (F.G / 8) + bx / 8 : bx; }
#define REFRAME() do { int l_; asm volatile("v_mbcnt_lo_u32_b32 %0, -1, 0\n\tv_mbcnt_hi_u32_b32 %0, -1, %0" : "=v"(l_)); F.lane = l_; F.tid = F.wave * 64 + l_; } while (0)
    for (int u = F.tid; u < (LDS_BYTES - MISC_OFF) / 4; u += NTHREADS) ((LAS unsigned*)(F.lds + MISC_OFF))[u] = 0u;
    __syncthreads();
    XcdBarrier xbar;
    { LOAD_ARGS(args0); xbar = xcd_barrier_post((unsigned*)(args0.ws + WS_CTL) + CW_BAR, (volatile LAS unsigned*)(F.lds + MISC_OFF + 1024)); }
#define GRID_BAR() xcd_barrier(xbar)

    { REFRAME(); LOAD_ARGS(args); p0_prologue(F, args); }
    grid.sync();
    { REFRAME(); LOAD_ARGS(args); p0b_norm1(F, args); }
    GRID_BAR();
    {
        REFRAME(); LOAD_ARGS(args); unsigned char* ws = args.ws;
        pg8::Gemm g{(const bf16*)(ws + WS_H), (const bf16*)(ws + WS_WIN), 1024}; pg8::DenseOrder S; S.init(NTOK, INW, F.G, (int)blockIdx.x, P1_CPERM, 4);
        EpiProj E{(bf16*)(ws + WS_PROJ), args.in[13], (bf16*)(ws + WS_QC), (bf16*)(ws + WS_KV), F.lds + EPI_SCR};
        pg8::gemm_phase<EpiProj, pg8::DenseOrder>(F.lds, g, S, E, F.tid);
    }
    GRID_BAR();
    { REFRAME(); LOAD_ARGS(args); p2_mixers(F, args); }
    GRID_BAR();
    {
        REFRAME(); LOAD_ARGS(args); unsigned char* ws = args.ws;
        pg8::Gemm g{(const bf16*)(ws + WS_Y), (const bf16*)(ws + WS_WOUT), 1024}; pg8::DenseOrder S; S.init(NTOK, D, F.G, (int)blockIdx.x);
        EpiRes1 E{args.in[0], (bf16*)(ws + WS_X1B), (const float*)(ws + WS_MOD), F.lds + EPI_SCR};
        pg8::gemm_phase<EpiRes1, pg8::DenseOrder>(F.lds, g, S, E, F.tid);
    }
    GRID_BAR();
    { REFRAME(); LOAD_ARGS(args); p4_router(F, args); }
    GRID_BAR();
    {
        LAS int* pre = (LAS int*)(F.lds + MISC_OFF);
        { LOAD_ARGS(args);
          const unsigned* cnt = (const unsigned*)(args.ws + WS_CTL) + CW_CNT;
          if (F.tid < 64) {
              const int lane = F.tid; const int cv_ = (int)__hip_atomic_load(cnt + (lane & 31), __ATOMIC_RELAXED, __HIP_MEMORY_SCOPE_AGENT); const int tl = lane < 32 ? ((cv_ + 255) >> 8) : 0;
              if (lane < 32) ((LAS int*)(F.lds + MOE_CNTL))[lane] = cv_;
              int inc = tl;
#pragma unroll
              for (int o = 1; o < 32; o <<= 1) { const int t = __shfl_up(inc, o); if (lane >= o) inc += t; }
              if (lane < 32) pre[lane] = inc - tl;
              if (lane == 31) pre[32] = inc; } }
        __syncthreads();
        {
            REFRAME(); LOAD_ARGS(args); unsigned char* ws = args.ws;
            pg8::Gemm g{(const bf16*)(ws + WS_H), (const bf16*)(ws + WS_W13), 1024};
            MoeOrder S{pre, (const LAS int*)(F.lds + MOE_CNTL), (const LAS int*)(F.lds + MOE_LTOK), (const int*)(ws + WS_LIST), F.G, (int)blockIdx.x, F.lane, true};
            {
                const int* list = (const int*)(ws + WS_LIST); int tv[MOE_MAXU];
#pragma unroll
                for (int i = 0; i < MOE_MAXU; ++i) { pg8::Unit u; tv[i] = 0;
                    if (F.tid < 256 && S.next(i, u) && F.tid < u.nrows) tv[i] = list[(size_t)u.e * NTOK + u.r0 + F.tid] >> 1; }
#pragma unroll
                for (int i = 0; i < MOE_MAXU; ++i) if (F.tid < 256) ((LAS int*)(F.lds + MOE_LTOK))[i * 256 + F.tid] = tv[i];
                __syncthreads();
            }
            EpiSwiGLU E{(bf16*)(ws + WS_ACT), F.lds + EPI_SCR};
            pg8::gemm_phase<EpiSwiGLU, MoeOrder>(F.lds, g, S, E, F.tid);
        }
        GRID_BAR();
        {
            REFRAME(); LOAD_ARGS(args); unsigned char* ws = args.ws;
            pg8::Gemm g{(const bf16*)(ws + WS_ACT), (const bf16*)(ws + WS_W2), 512};
            MoeOrder S{pre, (const LAS int*)(F.lds + MOE_CNTL), (const LAS int*)(F.lds + MOE_LTOK), (const int*)(ws + WS_LIST), F.G, (int)blockIdx.x, F.lane, false};
            EpiScatter E{(bf16*)(ws + WS_YBUF), F.lds + EPI_SCR};
            pg8::gemm_phase<EpiScatter, MoeOrder>(F.lds, g, S, E, F.tid);
        }
    }
    GRID_BAR();
    { REFRAME(); LOAD_ARGS(args); p7_final(F, args); }
}

extern "C" void kernel_launch(void* const* d_in, const int* in_sizes, int n_in, void* d_out, int out_size, void* d_ws, size_t ws_size, hipStream_t stream) {
    static int grid = 0;
    if (grid == 0) {
        if (n_in != 24 || out_size != NTOK * D || ws_size < WS_END) { fprintf(stderr, "kernel_launch: unexpected problem (n_in %d out %d ws %zu)\n", n_in, out_size, ws_size); grid = -1; return; }
        int dev = 0, cus = 0, per_cu = 0;
        hipGetDevice(&dev);
        hipDeviceGetAttribute(&cus, hipDeviceAttributeMultiprocessorCount, dev);
        hipFuncSetAttribute((const void*)fwd_megakernel, hipFuncAttributeMaxDynamicSharedMemorySize, LDS_BYTES);
        hipOccupancyMaxActiveBlocksPerMultiprocessor(&per_cu, (const void*)fwd_megakernel, NTHREADS, LDS_BYTES);
        if (per_cu < 1) { fprintf(stderr, "kernel_launch: occupancy query says %d blocks per CU\n", per_cu); per_cu = 1; }
        grid = cus;
        (void)hipGetLastError();
    }
    if (grid < 0) return;
    hipMemsetAsync((char*)d_ws + WS_CTL, 0, CTL_ZERO_BYTES, stream);
    Args a{};
    for (int i = 0; i < 24; ++i) a.in[i] = (const float*)d_in[i];
    a.out = (float*)d_out; a.ws = (unsigned char*)d_ws;
    void* kargs[] = {&a};
    hipError_t e = hipLaunchCooperativeKernel((const void*)fwd_megakernel, dim3(grid), dim3(NTHREADS), kargs, LDS_BYTES, stream);
    if (e != hipSuccess) fprintf(stderr, "cooperative launch failed: %s (grid %d)\n", hipGetErrorString(e), grid);
}
```

```cpp
#include <hip/hip_runtime.h>
#include <hip/hip_cooperative_groups.h>
#include <cstdint>
#include <cstdio>
namespace cg = cooperative_groups;

#define LAS __attribute__((address_space(3)))
#define GAS __attribute__((address_space(1)))
typedef unsigned short bf16;
typedef short bf16x8 __attribute__((ext_vector_type(8)));
typedef short s16x4 __attribute__((ext_vector_type(4)));
typedef float f32x2 __attribute__((ext_vector_type(2)));
typedef float f32x4 __attribute__((ext_vector_type(4)));
typedef float f32x16 __attribute__((ext_vector_type(16)));
typedef unsigned u32x2 __attribute__((ext_vector_type(2)));
typedef unsigned u32x4 __attribute__((ext_vector_type(4)));
typedef __bf16 bf16x2_t __attribute__((ext_vector_type(2)));

constexpr int D = 1024, BATCH = 8, SEQ = 8192, NTOK = BATCH * SEQ;
constexpr int INW = 3584;
constexpr int COL_QA = 0, COL_KA = 512, COL_VA = 1024, COL_QR = 1536, COL_FR = 2048, COL_IR = 2560, COL_GR = 3072;
constexpr int NEXP = 32, FF = 512;
constexpr float EPS = 1e-6f;
constexpr float LOG2E = 1.4426950408889634f;
constexpr float QSCALE = 0.125f * LOG2E;
constexpr int NWAVES = 8, NTHREADS = 512;

constexpr size_t MiB = 1u << 20;
constexpr size_t WS_CTL = 0, CTL_ZERO_BYTES = 64 * 1024;
constexpr size_t WS_MOD = 1 * MiB;
constexpr size_t WS_WIN = 2 * MiB;
constexpr size_t WS_WOUT = 9 * MiB;
constexpr size_t WS_W13 = 11 * MiB;
constexpr size_t WS_W2 = 75 * MiB;
constexpr size_t WS_LIST = 107 * MiB;
constexpr size_t WS_TOKW = 115 * MiB;
constexpr size_t WS_TOKS = 115 * MiB + 512 * 1024;
constexpr size_t WS_H = 116 * MiB;
constexpr size_t WS_Y = 244 * MiB;
constexpr size_t WS_PROJ = 372 * MiB;
constexpr size_t WS_ACT = 372 * MiB;
constexpr size_t WS_YBUF = 508 * MiB;
constexpr size_t WS_QC = 820 * MiB;
constexpr size_t WS_KV = 884 * MiB;
constexpr size_t WS_X1B = 884 * MiB;
constexpr size_t WS_END = 1012 * MiB;
constexpr int CW_CNT = 0;
constexpr int CW_Q = 64;
constexpr int CW_BAR = 8192;

constexpr int RING_BYTES = 131072;
constexpr int MISC_OFF = RING_BYTES;
constexpr int EPI_SCR = MISC_OFF + 16384;
constexpr int LDS_BYTES = 163840;

__device__ __forceinline__ unsigned cvtpk(float lo, float hi) { f32x2 v = {lo, hi}; bf16x2_t b = __builtin_convertvector(v, bf16x2_t); return __builtin_bit_cast(unsigned, b); }
__device__ __forceinline__ float dot2bf(unsigned a, unsigned b, float acc) {
    asm("" : "+v"(a));
    return __builtin_amdgcn_fdot2_f32_bf16(__builtin_bit_cast(bf16x2_t, a), __builtin_bit_cast(bf16x2_t, b), acc, false); }
__device__ __forceinline__ float bf2f(unsigned short x) { return __uint_as_float(((unsigned)x) << 16); }
__device__ __forceinline__ float bflo(unsigned x) { return __uint_as_float(x << 16); }
__device__ __forceinline__ float bfhi(unsigned x) { return __uint_as_float(x & 0xffff0000u); }
template <int CTRL> __device__ __forceinline__ float dppf(float x) { return __builtin_bit_cast(float, __builtin_amdgcn_update_dpp(0, __builtin_bit_cast(int, x), CTRL, 0xf, 0xf, false)); }
__device__ __forceinline__ void swap32(float a, float b, float& r0, float& r1) { auto r = __builtin_amdgcn_permlane32_swap(__builtin_bit_cast(unsigned, a), __builtin_bit_cast(unsigned, b), false, false);
    unsigned u0 = r[0], u1 = r[1]; asm("" : "+v"(u0), "+v"(u1)); r0 = __builtin_bit_cast(float, u0); r1 = __builtin_bit_cast(float, u1); }
__device__ __forceinline__ void swap16(float a, float b, float& r0, float& r1) { auto r = __builtin_amdgcn_permlane16_swap(__builtin_bit_cast(unsigned, a), __builtin_bit_cast(unsigned, b), false, false);
    unsigned u0 = r[0], u1 = r[1]; asm("" : "+v"(u0), "+v"(u1)); r0 = __builtin_bit_cast(float, u0); r1 = __builtin_bit_cast(float, u1); }
__device__ __forceinline__ float sum_x32(float a, float b) { float r0, r1; swap32(a, b, r0, r1); return r0 + r1; }
__device__ __forceinline__ float sum_x16(float a, float b) { float r0, r1; swap16(a, b, r0, r1); return r0 + r1; }
__device__ __forceinline__ float row_sum(float v) { v += dppf<0xB1>(v); v += dppf<0x4E>(v); v += dppf<0x141>(v); v += dppf<0x140>(v); return v; }
__device__ __forceinline__ float wave_sum(float v) { v = row_sum(v); v = sum_x16(v, v); return sum_x32(v, v); }
__device__ __forceinline__ float fast_exp2(float x) { return __builtin_amdgcn_exp2f(x); }
__device__ __forceinline__ float fast_rcp(float x) { return __builtin_amdgcn_rcpf(x); }
__device__ __forceinline__ float sigmoidf_(float x) { return fast_rcp(1.f + fast_exp2(-x * LOG2E)); }
__device__ __forceinline__ float siluf_(float x) { return x * sigmoidf_(x); }

namespace pg8 {
constexpr int BM = 256, BK = 64, HALF = 128, HTB = HALF * BK * 2, STAGE_BYTES = 8 * HTB;
__host__ __device__ __forceinline__ int lds_byte(int r, int c) { const int st = (r >> 4) * 2 + (c >> 5), rr = r & 15, cc = c & 31, ob = rr * 64 + cc * 2; return st * 1024 + (ob ^ (((ob >> 9) & 1) << 5)); }
__host__ __device__ __forceinline__ void stage_rc(int b, int& R, int& C) { const int st = b / 1024, sb = b % 1024, swz = sb ^ (((sb >> 9) & 1) << 5); R = (st >> 1) * 16 + swz / 64; C = (st & 1) * 32 + (swz % 64) / 2; }
__host__ __device__ __forceinline__ int perm32(int rho) { const int n = rho >> 4, i = rho & 15; return 8 * (i >> 2) + 4 * n + (i & 3); }

template <int STRICT, int LAX> __device__ __forceinline__ void wait_v_sel(int sel) {
    asm volatile("s_cmp_lg_u32 %0, 0\n\ts_cbranch_scc1 1f\n\ts_waitcnt vmcnt(%1)\n1:\n\ts_waitcnt vmcnt(%2)" :: "s"(sel), "n"(STRICT), "n"(LAX) : "scc", "memory"); }
template <int N> __device__ __forceinline__ void wait_v() { asm volatile("s_waitcnt vmcnt(%0)" :: "n"(N) : "memory"); }
struct Unit { int pm, pn, e, r0, nrows, slot; };
struct Gemm { const bf16* A; const bf16* Bt; int K; };

template <class Epi, class Sched>
__device__ __forceinline__ void gemm_phase(LAS unsigned char* lds, const Gemm g, const Sched& S, const Epi& E, const int tid) {
    const int  wid = __builtin_amdgcn_readfirstlane(tid >> 6), lane = tid & 63, wr = wid >> 2, wc = wid & 3, fr = lane & 15, fq = lane >> 4;
    const int K = g.K, nt = K / BK;
    int RA[2], CA[2]; unsigned voffB[2];
#pragma unroll
    for (int i = 0; i < 2; ++i) { int R, C; stage_rc(tid * 16 + i * 8192, R, C); const int Rb = Epi::PERM ? (64 * (R >> 5) + perm32(R & 31)) : R;
        RA[i] = R; CA[i] = C; voffB[i] = (unsigned)(Rb * K + C) * 2u; }
    const size_t kstep = (size_t)(BK * 2);
    const size_t hstep = (size_t)(Epi::PERM ? 32 : HALF) * K * 2;
    const size_t tstep = (size_t)BM * K * 2;
    const unsigned ldsw = (unsigned)wid * 1024u;
    const int aoff = lds_byte(wr * 64 + fr, fq * 8), boff = lds_byte(wc * 32 + fr, fq * 8);
#define PG8_SA(b, h) (((b) * 2 + (h)) * HTB)
#define PG8_SB(b, h) ((4 + (b) * 2 + (h)) * HTB)
#define PG8_STAGE(bufoff, gbase, voff) do { _Pragma("unroll") for (int _i = 0; _i < 2; ++_i) \
        __builtin_amdgcn_global_load_lds((const unsigned*)((const char*)(gbase) + (voff)[_i]), (LAS unsigned*)(lds + (bufoff) + ldsw + _i * 8192), 16, 0, 0); } while (0)
#define PG8_LDA(dst, b, h) do { _Pragma("unroll") for (int m = 0; m < 4; ++m) _Pragma("unroll") for (int k = 0; k < 2; ++k) dst[m][k] = *(const LAS bf16x8*)(lds + PG8_SA(b, h) + aoff + m * 2048 + k * 1024); } while (0)
#define PG8_LDB(dst, b, h) do { _Pragma("unroll") for (int n = 0; n < 2; ++n) _Pragma("unroll") for (int k = 0; k < 2; ++k) dst[n][k] = *(const LAS bf16x8*)(lds + PG8_SB(b, h) + boff + n * 2048 + k * 1024); } while (0)
#define PG8_MMA(ai, bj, At, Bt) do { __builtin_amdgcn_s_setprio(1); _Pragma("unroll") for (int m = 0; m < 4; ++m) _Pragma("unroll") for (int n = 0; n < 2; ++n) _Pragma("unroll") for (int k = 0; k < 2; ++k) \
        acc[ai][bj][m][n] = __builtin_amdgcn_mfma_f32_16x16x32_bf16(Bt[n][k], At[m][k], acc[ai][bj][m][n], 0, 0, 0); __builtin_amdgcn_s_setprio(0); } while (0)
#define PG8_WAIT_V(n) asm volatile("s_waitcnt vmcnt(" #n ")" ::: "memory")
#define PG8_WAIT_L(n) asm volatile("s_waitcnt lgkmcnt(" #n ")" ::: "memory")
#define PG8_BAR __builtin_amdgcn_s_barrier()
#define PG8_SCHED __builtin_amdgcn_sched_barrier(0)
#define PG8_AOFF(dst, u) do { _Pragma("unroll") for (int _h = 0; _h < 2; ++_h) _Pragma("unroll") for (int _i = 0; _i < 2; ++_i) \
        dst[_h][_i] = ((unsigned)S.arow(u, _h * HALF + RA[_i]) * (unsigned)K + (unsigned)CA[_i]) * 2u; } while (0)
    Unit cur, nxt; int ui = 0;
    if (!S.next(0, cur)) return;
    f32x4 acc[2][2][4][2];
#pragma unroll
    for (int a = 0; a < 2; ++a)
#pragma unroll
        for (int b = 0; b < 2; ++b)
#pragma unroll
            for (int m = 0; m < 4; ++m)
#pragma unroll
                for (int n = 0; n < 2; ++n) acc[a][b][m][n] = (f32x4){0.f, 0.f, 0.f, 0.f};
    bf16x8 At[4][2], B0[2][2], B1[2][2];
    unsigned cv[2][2], nv[2][2];
    PG8_AOFF(cv, cur);
    const char* Ab = (const char*)g.A;
    const char* cB = (const char*)g.Bt + (size_t)cur.pn * tstep;
    {
        PG8_STAGE(PG8_SB(0, 0), cB, voffB); PG8_STAGE(PG8_SB(0, 1), cB + hstep, voffB); PG8_STAGE(PG8_SA(0, 0), Ab, cv[0]); PG8_STAGE(PG8_SA(0, 1), Ab, cv[1]);
        if (wr == 1) PG8_BAR;
        PG8_WAIT_V(2); PG8_BAR;
        PG8_STAGE(PG8_SB(1, 0), cB + kstep, voffB); PG8_STAGE(PG8_SA(1, 0), Ab + kstep, cv[0]); PG8_STAGE(PG8_SB(1, 1), cB + hstep + kstep, voffB);
        PG8_WAIT_V(6); PG8_BAR;
    }
    for (;;) {
        const bool has_next = S.next(ui + 1, nxt);
        if (has_next) { PG8_AOFF(nv, nxt); } else {
#pragma unroll
            for (int _h = 0; _h < 2; ++_h)
#pragma unroll
                for (int _i = 0; _i < 2; ++_i) nv[_h][_i] = cv[_h][_i]; }
        const char* nB = has_next ? (const char*)g.Bt + (size_t)nxt.pn * tstep : cB;
        for (int t = 0; t < nt; t += 2) {
            const bool last = (t == nt - 2);
            const int relax = __builtin_amdgcn_readfirstlane(((t == 0) && (ui > 0)) ? 1 : 0);
            const char* a1 = Ab + (size_t)(t + 1) * kstep;
            const char* a2 = last ? Ab : Ab + (size_t)(t + 2) * kstep; const char* b2 = last ? nB : cB + (size_t)(t + 2) * kstep;
            const char* a3 = a2 + kstep; const char* b3 = b2 + kstep;
            unsigned o2[2][2];
#pragma unroll
            for (int _h = 0; _h < 2; ++_h)
#pragma unroll
                for (int _i = 0; _i < 2; ++_i) o2[_h][_i] = last ? nv[_h][_i] : cv[_h][_i];
            PG8_LDB(B0, 0, 0); PG8_LDB(B1, 0, 1); PG8_SCHED; PG8_LDA(At, 0, 0); PG8_STAGE(PG8_SA(1, 1), a1, cv[1]);
            wait_v_sel<8, 8 + Epi::NST>(relax);
            PG8_WAIT_L(0); PG8_BAR; PG8_MMA(0, 0, At, B0); PG8_MMA(0, 1, At, B1); PG8_BAR; PG8_SCHED;
            PG8_LDA(At, 0, 1); PG8_STAGE(PG8_SB(0, 0), b2, voffB); PG8_STAGE(PG8_SB(0, 1), b2 + hstep, voffB); PG8_STAGE(PG8_SA(0, 0), a2, o2[0]);
            wait_v_sel<8, 8 + Epi::NST>(relax);
            PG8_WAIT_L(0); PG8_BAR; PG8_MMA(1, 0, At, B0); PG8_MMA(1, 1, At, B1); PG8_BAR; PG8_SCHED;
            PG8_LDB(B0, 1, 0); PG8_LDB(B1, 1, 1); PG8_SCHED; PG8_LDA(At, 1, 0); PG8_STAGE(PG8_SA(0, 1), a2, o2[1]);
            PG8_WAIT_V(8); PG8_WAIT_L(0); PG8_BAR; PG8_MMA(0, 0, At, B0); PG8_MMA(0, 1, At, B1); PG8_BAR; PG8_SCHED;
            PG8_LDA(At, 1, 1); PG8_STAGE(PG8_SB(1, 0), b3, voffB); PG8_STAGE(PG8_SB(1, 1), b3 + hstep, voffB); PG8_STAGE(PG8_SA(1, 0), a3, o2[0]);
            PG8_WAIT_V(8); PG8_WAIT_L(0); PG8_BAR; PG8_MMA(1, 0, At, B0); PG8_MMA(1, 1, At, B1); PG8_BAR; PG8_SCHED;
        }
        if (wr == 0) PG8_BAR;
        { int le; asm volatile("v_mbcnt_lo_u32_b32 %0, -1, 0\n\tv_mbcnt_hi_u32_b32 %0, -1, %0" : "=v"(le));
          E(acc, cur, wr, wc, le & 15, le >> 4); }
        if (!has_next) break;
#pragma unroll
        for (int a = 0; a < 2; ++a)
#pragma unroll
            for (int b = 0; b < 2; ++b)
#pragma unroll
                for (int m = 0; m < 4; ++m)
#pragma unroll
                    for (int n = 0; n < 2; ++n) acc[a][b][m][n] = (f32x4){0.f, 0.f, 0.f, 0.f};
        cur = nxt; cB = nB; ++ui;
#pragma unroll
        for (int _h = 0; _h < 2; ++_h)
#pragma unroll
            for (int _i = 0; _i < 2; ++_i) cv[_h][_i] = nv[_h][_i];
        if (wr == 1) PG8_BAR;
    }
    PG8_WAIT_V(0);
    PG8_BAR;
#undef PG8_SA
#undef PG8_SB
#undef PG8_STAGE
#undef PG8_LDA
#undef PG8_LDB
#undef PG8_MMA
#undef PG8_WAIT_V
#undef PG8_WAIT_L
#undef PG8_BAR
#undef PG8_SCHED
#undef PG8_AOFF
}

struct DenseOrder {
    int nM, nN, nwg, G, c; unsigned long long cperm;
    __device__ void init(int M, int N, int G_, int c_, unsigned long long cperm_ = 0ull) { nM = M / BM; nN = N / BM; nwg = nM * nN; G = G_; c = c_; cperm = cperm_; }
    __device__ __forceinline__ bool next(int i, Unit& u) const {
        const long L = (long)i * G + c; if (L >= nwg) return false;
        int wgid = (int)L; { const int q = nwg / 8, r = nwg % 8, xcd = wgid % 8, off = wgid / 8; wgid = (xcd < r ? xcd * (q + 1) : r * (q + 1) + (xcd - r) * q) + off; }
        const int nig = 8 * nN, gid = wgid / nig, fm = gid * 8, gsz = (nM - fm) < 8 ? (nM - fm) : 8;
        u.pm = fm + ((wgid % nig) % gsz); u.pn = (wgid % nig) / gsz; if (cperm) u.pn = (int)((cperm >> (4 * u.pn)) & 15ull);
        u.e = 0; u.r0 = 0; u.nrows = BM; u.slot = 0; return true;
    }
    __device__ __forceinline__ int arow(const Unit& u, int r) const { return u.pm * BM + r; }
};
__device__ __forceinline__ void xpose128(LAS unsigned char* scr, int fr, int fq, const u32x4& w0, const u32x4& w1, u32x4& rA, u32x4& rB) {
    const int sw = fr & 7;
    *(LAS u32x4*)(scr + fr * 128 + ((fq ^ sw) << 4)) = w0;
    *(LAS u32x4*)(scr + fr * 128 + (((4 + fq) ^ sw) << 4)) = w1;
    asm volatile("" ::: "memory");
    const int l = fr + 16 * fq, r = l >> 3, c = l & 7;
    rA = *(const LAS u32x4*)(scr + r * 128 + ((c ^ r) << 4));
    rB = *(const LAS u32x4*)(scr + 1024 + r * 128 + ((c ^ r) << 4));
    asm volatile("" ::: "memory");
}
}

#define XB_TMO      128
#define XB_XCNT(j)  (256  + 64 * (j))
#define XB_XSUB(j)  (1280 + 64 * (j))
#define XB_XGEN(j)  (2304 + 64 * (j))
#define XB_TOP      3328
#define XB_TOPGEN   3392
#define XCD_BAR_WORDS 3456
#define XB_SPIN_CAP (1u << 18)
__device__ __forceinline__ unsigned xb_ld(unsigned* p)              { return __hip_atomic_load(p, __ATOMIC_RELAXED, __HIP_MEMORY_SCOPE_AGENT); }
__device__ __forceinline__ unsigned xb_add(unsigned* p, unsigned v) { return __hip_atomic_fetch_add(p, v, __ATOMIC_RELAXED, __HIP_MEMORY_SCOPE_AGENT); }
__device__ __forceinline__ unsigned xb_xcc_id() { return (unsigned)__builtin_amdgcn_s_getreg((3 << 11) | 20) & 0xFu; }
#define XB_SPIN(cond, bar) do { unsigned _sp = 0; while (cond) { __builtin_amdgcn_s_sleep(1); \
    if ((++_sp & 255u) == 0u) { if (xb_ld(&(bar)[XB_TMO])) break; if (_sp > XB_SPIN_CAP) { atomicAdd(&(bar)[XB_TMO], 1u); break; } } } } while (0)
struct XcdBarrier { unsigned* bar; unsigned x; volatile LAS unsigned* st; };
__device__ __forceinline__ XcdBarrier xcd_barrier_post(unsigned* bar, volatile LAS unsigned* st) {
    XcdBarrier b; b.bar = bar; b.x = xb_xcc_id(); b.st = st;
    if (threadIdx.x == 0) (void)xb_add(&bar[XB_XCNT(b.x)], 1u);
    return b;
}
__device__ __forceinline__ void xcd_barrier_complete(unsigned* bar, unsigned x, unsigned& nloc, unsigned& nx) {
    const unsigned G = gridDim.x * gridDim.y * gridDim.z;
    unsigned sum, cnt, mine, sp = 0u;
    for (;;) {
        sum = 0u; cnt = 0u; mine = 0u;
#pragma unroll
        for (unsigned j = 0; j < 16; ++j) { const unsigned c = xb_ld(&bar[XB_XCNT(j)]); sum += c; cnt += (c > 0u) ? 1u : 0u; mine = (j == x) ? c : mine; }
        if (sum == G) break;
        __builtin_amdgcn_s_sleep(1);
        if ((++sp & 255u) == 0u) { if (xb_ld(&bar[XB_TMO])) break; if (sp > XB_SPIN_CAP) { atomicAdd(&bar[XB_TMO], 1u); break; } }
    }
    nloc = mine > 0u ? mine : 1u; nx = cnt > 0u ? cnt : 1u;
}
__device__ __forceinline__ void xcd_barrier(const XcdBarrier& b) {
    asm volatile("s_waitcnt vmcnt(0)" ::: "memory");
    __syncthreads();
    if (threadIdx.x == 0) {
        unsigned* bar = b.bar;
        __builtin_amdgcn_s_waitcnt(0);
        unsigned nloc = b.st[0], nx = b.st[1];
        if (nloc == 0u) { xcd_barrier_complete(bar, b.x, nloc, nx); b.st[0] = nloc; b.st[1] = nx; }
        const unsigned old = xb_add(&bar[XB_XSUB(b.x)], 1u);
        const unsigned gen = old / nloc;
        if (old + 1u == (gen + 1u) * nloc) {
            __builtin_amdgcn_fence(__ATOMIC_RELEASE, "agent");
            asm volatile("s_waitcnt vmcnt(0)" ::: "memory");
            const unsigned og = xb_add(&bar[XB_TOP], 1u);
            const unsigned tg = og / nx;
            if (og + 1u == (tg + 1u) * nx) xb_add(&bar[XB_TOPGEN], 1u);
            else XB_SPIN(xb_ld(&bar[XB_TOPGEN]) == tg, bar);
            __builtin_amdgcn_fence(__ATOMIC_ACQUIRE, "agent");
            xb_add(&bar[XB_XGEN(b.x)], 1u);
            asm volatile("s_waitcnt vmcnt(0)" ::: "memory");
        } else {
            XB_SPIN(xb_ld(&bar[XB_XGEN(b.x)]) == gen, bar);
            __builtin_amdgcn_fence(__ATOMIC_ACQUIRE, "agent");
            asm volatile("s_waitcnt vmcnt(0)" ::: "memory");
        }
    }
    __syncthreads();
}

struct Args { const float* in[24]; float* out; unsigned char* ws; };
struct Frame {
    LAS unsigned char* lds;
    int tid, lane, wave, vcu, G;
};

template <int MODE>
__device__ __forceinline__ void p0_transpose_item(const float* W, int K, int N, bf16* WT, LAS float* scr, int item, int lane) {
    const int nblk = N / 32, kb = item / nblk, nb = item % nblk, k0 = 64 * kb, n0 = 32 * nb;
    f32x4 v[8];
#pragma unroll
    for (int i = 0; i < 8; ++i) v[i] = *(const f32x4*)(W + (size_t)(k0 + 8 * i + (lane >> 3)) * N + n0 + 4 * (lane & 7));
#pragma unroll
    for (int i = 0; i < 8; ++i) { LAS float* d = scr + (8 * i + (lane >> 3)) * 33 + 4 * (lane & 7); d[0] = v[i].x; d[1] = v[i].y; d[2] = v[i].z; d[3] = v[i].w; }
    asm volatile("s_waitcnt lgkmcnt(0)" ::: "memory");
    const int c = lane & 7;
#pragma unroll
    for (int j = 0; j < 4; ++j) { const int n = (lane >> 3) + 8 * j; const LAS float* s = scr + (8 * c) * 33 + n;
        u32x4 o; o.x = cvtpk(s[0 * 33], s[1 * 33]); o.y = cvtpk(s[2 * 33], s[3 * 33]); o.z = cvtpk(s[4 * 33], s[5 * 33]); o.w = cvtpk(s[6 * 33], s[7 * 33]);
        const int f = n0 + n; int row = f;
        if (MODE == 1) row = ((f >> 7) << 8) + (((f >> 5) & 3) << 6) + (f & 31);
        if (MODE == 2) row = ((f >> 7) << 8) + (((f >> 5) & 3) << 6) + 32 + (f & 31);
        *(u32x4*)(WT + (size_t)row * K + k0 + 8 * c) = o; }
    asm volatile("s_waitcnt lgkmcnt(0)" ::: "memory");
}

__device__ __forceinline__ void p0_prologue(const Frame& F, const Args& a) {
    unsigned char* ws = a.ws;
    if (F.vcu < 96) {
        LAS float* cact = (LAS float*)F.lds;
        LAS float* red = (LAS float*)(F.lds + 32768);
        const float* c = a.in[1];
        for (int i = F.tid; i < 8192; i += NTHREADS) { const int b = i >> 10, k = i & 1023; cact[k * 8 + b] = siluf_(c[i]); }
        __syncthreads();
        const int j = F.vcu * 64 + F.lane;
        const float* w = a.in[2] + (size_t)(128 * F.wave) * 6144 + j;
        float acc[8];
#pragma unroll
        for (int b = 0; b < 8; ++b) acc[b] = 0.f;
#pragma unroll 16
        for (int k = 0; k < 128; ++k) { const float wv = w[(size_t)k * 6144]; const LAS float* cp = cact + (128 * F.wave + k) * 8; const f32x4 c0 = *(const LAS f32x4*)cp, c1 = *(const LAS f32x4*)(cp + 4);
            acc[0] += c0.x * wv; acc[1] += c0.y * wv; acc[2] += c0.z * wv; acc[3] += c0.w * wv; acc[4] += c1.x * wv; acc[5] += c1.y * wv; acc[6] += c1.z * wv; acc[7] += c1.w * wv; }
#pragma unroll
        for (int b = 0; b < 8; ++b) red[(F.wave * 8 + b) * 64 + F.lane] = acc[b];
        __syncthreads();
        { const int b = F.tid >> 6; float s = 0.f;
#pragma unroll
          for (int ww = 0; ww < 8; ++ww) s += red[(ww * 8 + b) * 64 + F.lane];
          ((float*)(ws + WS_MOD))[b * 6144 + j] = s + a.in[3][j]; }
        __syncthreads();
    }
    LAS float* scr = (LAS float*)(F.lds + F.wave * 16384);
    const int gw = F.vcu * NWAVES + F.wave, NGW = F.G * NWAVES;
    constexpr int I_IN = 16 * 112, I_OUT = 16 * 32;
    constexpr int NITEMS = I_IN + I_OUT;
    bf16* win = (bf16*)(ws + WS_WIN); bf16* wout = (bf16*)(ws + WS_WOUT);
    for (int it = NITEMS - 1 - gw; it >= 0; it -= NGW) {
        int r = it;
        if (r < I_IN) { p0_transpose_item<0>(a.in[6], 1024, INW, win, scr, r, F.lane); continue; } r -= I_IN;
        p0_transpose_item<0>(a.in[15], 1024, 1024, wout, scr, r, F.lane);
    }
}

__device__ __forceinline__ void p0b_norm1(const Frame& F, const Args& a) {
    const float* x = a.in[0]; const float* ng = a.in[4]; const float* mod = (const float*)(a.ws + WS_MOD);
    bf16* H = (bf16*)(a.ws + WS_H);
    LAS unsigned char* lds = F.lds;
    constexpr int DEP = 8;
    const int rpb = (NTOK + F.G - 1) / F.G;
    const int r0 = F.vcu * rpb, r1 = (r0 + rpb < NTOK) ? r0 + rpb : NTOK;
    const int pair = F.wave & 3, niter = (rpb + 3) >> 2;
    LAS unsigned char* ring = lds + pair * (DEP * 4096);
    if (r0 >= NTOK) return;
    if (F.wave < 4) {
#define P0B_DMA(i_) do { int row_ = r0 + pair + 4 * (i_); if (row_ >= r1) row_ = r1 - 1; const float* src_ = x + (size_t)row_ * D + 4 * F.lane; \
        LAS unsigned char* dst_ = ring + ((i_) & (DEP - 1)) * 4096; \
        _Pragma("unroll") for (int j = 0; j < 4; ++j) __builtin_amdgcn_global_load_lds((const unsigned*)(src_ + 256 * j), (LAS unsigned*)(dst_ + 1024 * j), 16, 0, 0); } while (0)
#pragma unroll
        for (int i = 0; i < DEP - 1; ++i) P0B_DMA(i);
        for (int i = 0; i < niter; ++i) {
            asm volatile("s_waitcnt vmcnt(24)" ::: "memory");
            __builtin_amdgcn_s_barrier();
            P0B_DMA(i + DEP - 1);
        }
        asm volatile("s_waitcnt vmcnt(0)" ::: "memory");
#undef P0B_DMA
    } else {
        for (int i0 = 0; i0 < niter; ) {
            const int rowb = r0 + pair + 4 * i0, rc = rowb < r1 ? rowb : r1 - 1, b = rc >> 13;
            int i1 = ((((b + 1) << 13) - (r0 + pair)) + 3) >> 2; if (i1 > niter || rowb >= r1) i1 = niter;
            f32x4 ga[4], sha[4];
            { const f32x4* gp = (const f32x4*)ng + F.lane; const f32x4* shp = (const f32x4*)(mod + b * 6144) + F.lane; const f32x4* scp = (const f32x4*)(mod + b * 6144 + 1024) + F.lane;
#pragma unroll
              for (int j = 0; j < 4; ++j) { ga[j] = gp[64 * j] * (scp[64 * j] + 1.f); sha[j] = shp[64 * j]; } }
            for (int i = i0; i < i1; ++i) {
                __builtin_amdgcn_s_barrier();
                const int row = r0 + pair + 4 * i;
                const LAS unsigned char* src = ring + (i & (DEP - 1)) * 4096 + 16 * F.lane;
                f32x4 v[4];
#pragma unroll
                for (int j = 0; j < 4; ++j) v[j] = *(const LAS f32x4*)(src + 1024 * j);
                asm volatile("s_waitcnt lgkmcnt(0)" ::: "memory");
                if (row < r1) {
                    float s = 0.f;
#pragma unroll
                    for (int j = 0; j < 4; ++j) s += (v[j].x * v[j].x + v[j].y * v[j].y) + (v[j].z * v[j].z + v[j].w * v[j].w);
                    const float r = __builtin_amdgcn_rsqf(wave_sum(s) * (1.f / D) + EPS);
                    u32x2* o8 = (u32x2*)(H + (size_t)row * D) + F.lane;
#pragma unroll
                    for (int j = 0; j < 4; ++j) { const f32x4 y = v[j] * r * ga[j] + sha[j];
                        u32x2 o; o.x = cvtpk(y.x, y.y); o.y = cvtpk(y.z, y.w); o8[64 * j] = o; }
                }
            }
            i0 = i1;
        }
    }
}

struct EpiProj {
    static constexpr bool PERM = true;
    static constexpr int NST = 16;
    bf16* O; const float* lbraw;
    bf16* QC; bf16* KV;
    LAS unsigned char* scr;
    __device__ __forceinline__ void operator()(const f32x4 (&acc)[2][2][4][2], const pg8::Unit& u, int wr, int wc, int fr, int fq) const {
        const int seg = u.pn >> 1;
        const int col0 = u.pn * 256 + wc * 64 + 8 * fq;
        float lb[2][8];
        if (seg == 4) {
#pragma unroll
            for (int bj = 0; bj < 2; ++bj)
#pragma unroll
                for (int i = 0; i < 8; ++i) { const int k = col0 + bj * 32 + i - COL_FR; const float r0 = lbraw[k], r1 = lbraw[512 + k]; lb[bj][i] = fast_rcp(1.f + fast_exp2((r1 - r0) * LOG2E)); }
        }
        LAS unsigned char* ws_ = scr + (wr * 4 + wc) * 2048;
        const int l = fr + 16 * fq, r8 = l >> 3, c8 = l & 7;
        const int colT = u.pn * 256 + wc * 64 + 8 * c8, rowT = u.pm * 256 + wr * 64 + r8;
        u32x4 rq[2][2];
#pragma unroll
        for (int it = 0; it <= 8; ++it) {
            if (it < 8) { const int ai = it >> 2, m = it & 3; u32x4 w[2];
#pragma unroll
                for (int bj = 0; bj < 2; ++bj) { float v[8];
#pragma unroll
                    for (int i = 0; i < 4; ++i) { v[i] = acc[ai][bj][m][0][i]; v[4 + i] = acc[ai][bj][m][1][i]; }
                    if (seg == 0) {
#pragma unroll
                        for (int i = 0; i < 8; ++i) v[i] *= QSCALE;
                    } else if (seg == 3 || seg == 6) {
#pragma unroll
                        for (int i = 0; i < 8; ++i) v[i] = siluf_(v[i]);
                    } else if (seg == 4) {
#pragma unroll
                        for (int i = 0; i < 8; ++i) { const float lw = lb[bj][i]; v[i] = __builtin_amdgcn_logf(lw + (1.f - lw) * sigmoidf_(v[i])) * 0.6931471805599453f; }
                    }
                    w[bj].x = cvtpk(v[0], v[1]); w[bj].y = cvtpk(v[2], v[3]); w[bj].z = cvtpk(v[4], v[5]); w[bj].w = cvtpk(v[6], v[7]); }
                pg8::xpose128(ws_, fr, fq, w[0], w[1], rq[it & 1][0], rq[it & 1][1]); }
            if (it > 0) { const int ai = (it - 1) >> 2, m = (it - 1) & 3; const u32x4 rA = rq[(it - 1) & 1][0], rB = rq[(it - 1) & 1][1];
                const int row = rowT + ai * 128 + m * 16;
                if (seg < 3) {
                    const int c = colT & 511, hh = c >> 7, e = c & 127; const size_t tokrow = (size_t)((row >> 13) * 4 + hh) * SEQ + (row & (SEQ - 1));
                    if (seg == 0) { bf16* dst = QC + tokrow * 128 + e; *(u32x4*)dst = rA; *(u32x4*)(dst + 8 * 128) = rB; }
                    else { bf16* dst = KV + tokrow * 256 + (seg == 2 ? 128 : 0) + e; *(u32x4*)dst = rA; *(u32x4*)(dst + 8 * 256) = rB; }
                } else { bf16* rowp = O + (size_t)row * INW + colT; *(u32x4*)rowp = rA; *(u32x4*)(rowp + (size_t)8 * INW) = rB; } } }
    }
};

struct EpiRes1 {
    static constexpr bool PERM = true;
    static constexpr int NST = 16;
    const float* x; bf16* x1b; const float* mod;
    LAS unsigned char* scr;
    __device__ __forceinline__ void operator()(const f32x4 (&acc)[2][2][4][2], const pg8::Unit& u, int wr, int wc, int fr, int fq) const {
        const int b = (u.pm * 256) >> 13;
        const int col0 = u.pn * 256 + wc * 64 + 8 * fq;
        f32x4 gv[2][2];
#pragma unroll
        for (int bj = 0; bj < 2; ++bj)
#pragma unroll
            for (int n = 0; n < 2; ++n) gv[bj][n] = *(const f32x4*)(mod + b * 6144 + 2048 + col0 + bj * 32 + n * 4);
        LAS unsigned char* ws_ = scr + (wr * 4 + wc) * 2048;
        const int l = fr + 16 * fq, r8 = l >> 3, c8 = l & 7;
        const int colT = u.pn * 256 + wc * 64 + 8 * c8, rowT = u.pm * 256 + wr * 64 + r8;
        f32x4 xb[3][4];
#define RES1_LOAD(it) do { const size_t o_ = (size_t)(rowT + ((it) >> 2) * 128 + ((it) & 3) * 16) * D + colT; \
            xb[(it) % 3][0] = *(const f32x4*)(x + o_); xb[(it) % 3][1] = *(const f32x4*)(x + o_ + 4); xb[(it) % 3][2] = *(const f32x4*)(x + o_ + 8 * D); xb[(it) % 3][3] = *(const f32x4*)(x + o_ + 8 * D + 4); } while (0)
        RES1_LOAD(0); RES1_LOAD(1);
#pragma unroll
        for (int it = 0; it < 8; ++it) { const int ai = it >> 2, m = it & 3; const size_t off = (size_t)(rowT + ai * 128 + m * 16) * D + colT;
            if (it + 2 < 8) RES1_LOAD(it + 2);
            u32x4 w[2];
#pragma unroll
            for (int bj = 0; bj < 2; ++bj) { const f32x4 t0 = gv[bj][0] * acc[ai][bj][m][0], t1 = gv[bj][1] * acc[ai][bj][m][1];
                w[bj].x = cvtpk(t0.x, t0.y); w[bj].y = cvtpk(t0.z, t0.w); w[bj].z = cvtpk(t1.x, t1.y); w[bj].w = cvtpk(t1.z, t1.w); }
            u32x4 rA, rB; pg8::xpose128(ws_, fr, fq, w[0], w[1], rA, rB);
            const f32x4 xa0 = xb[it % 3][0], xa1 = xb[it % 3][1], xb0 = xb[it % 3][2], xb1 = xb[it % 3][3];
            u32x4 o;
            o.x = cvtpk(xa0.x + bflo(rA.x), xa0.y + bfhi(rA.x)); o.y = cvtpk(xa0.z + bflo(rA.y), xa0.w + bfhi(rA.y));
            o.z = cvtpk(xa1.x + bflo(rA.z), xa1.y + bfhi(rA.z)); o.w = cvtpk(xa1.z + bflo(rA.w), xa1.w + bfhi(rA.w));
            *(u32x4*)(x1b + off) = o;
            o.x = cvtpk(xb0.x + bflo(rB.x), xb0.y + bfhi(rB.x)); o.y = cvtpk(xb0.z + bflo(rB.y), xb0.w + bfhi(rB.y));
            o.z = cvtpk(xb1.x + bflo(rB.z), xb1.y + bfhi(rB.z)); o.w = cvtpk(xb1.z + bflo(rB.w), xb1.w + bfhi(rB.w));
            *(u32x4*)(x1b + off + 8 * D) = o; }
#undef RES1_LOAD
    }
};

constexpr int WC_ITEMS = 3 * 32 * 256, WC_CHUNKS = WC_ITEMS / (32 * 8);
typedef const __attribute__((address_space(1))) f32x4* gcf4p;
typedef __attribute__((address_space(1))) u32x4* gu4p;
__device__ __forceinline__ void wconv_load(const Args& a, f32x4 (&v)[8], int it, int lane) {
    const int m = it >> 13, r = it & 8191, e = r >> 8, blk = r & 255;
    const int N = m < 2 ? 512 : 1024, nb = m < 2 ? (blk & 15) : (blk & 31), kb = m < 2 ? (blk >> 4) : (blk >> 5);
    const float* p1 = a.in[20]; const float* p3 = a.in[21]; const float* p2 = a.in[22]; asm volatile("" : "+s"(p1), "+s"(p3), "+s"(p2));
    const float* W = (m == 0 ? p1 : m == 1 ? p3 : p2) + (size_t)e * (1024 * 512) + (size_t)(64 * kb + 8 * (lane >> 3)) * N + 32 * nb + 4 * (lane & 7);
#pragma unroll
    for (int i = 0; i < 8; ++i) v[i] = *(gcf4p)(W + (size_t)i * N);
}
__device__ __forceinline__ void wconv_store(const Args& a, const f32x4 (&v)[8], int it, int lane, LAS unsigned char* scr) {
    const int m = it >> 13, r = it & 8191, e = r >> 8, blk = r & 255;
    const int K = m < 2 ? 1024 : 512, nb = m < 2 ? (blk & 15) : (blk & 31), kb = m < 2 ? (blk >> 4) : (blk >> 5);
    bf16* q13 = (bf16*)(a.ws + WS_W13); bf16* q2 = (bf16*)(a.ws + WS_W2); asm volatile("" : "+s"(q13), "+s"(q2));
    bf16* WT = (m < 2 ? q13 + (size_t)e * (1024 * 1024) : q2 + (size_t)e * (1024 * 512)) + 64 * kb;
    const int kk = lane >> 3, nn = lane & 7;
#pragma unroll
    for (int h = 0; h < 2; ++h) {
#pragma unroll
        for (int jj = 0; jj < 2; ++jj) { const int j = 2 * h + jj;
            u32x4 o; o.x = cvtpk(v[0][j], v[1][j]); o.y = cvtpk(v[2][j], v[3][j]); o.z = cvtpk(v[4][j], v[5][j]); o.w = cvtpk(v[6][j], v[7][j]);
            *(LAS u32x4*)(scr + (8 * jj + nn) * 128 + ((kk ^ nn) << 4)) = o; }
        asm volatile("" ::: "memory");
#pragma unroll
        for (int p = 0; p < 2; ++p) { const int f = 32 * nb + 4 * kk + 2 * h + p;
            const u32x4 o = *(const LAS u32x4*)(scr + (8 * p + kk) * 128 + ((nn ^ kk) << 4));
            const int row = m < 2 ? ((f >> 7) << 8) + (((f >> 5) & 3) << 6) + (m == 1 ? 32 : 0) + (f & 31) : f;
            *(gu4p)(WT + (size_t)row * K + 8 * nn) = o; }
        asm volatile("" ::: "memory");
    }
}

constexpr int HG_RS_ = 272, HG_SCS = 144, HG_ARR = 64 * HG_RS_;
constexpr int HG_RAW = 0, HG_QT = 3 * HG_ARR, HG_KT = HG_QT + HG_ARR, HG_SC = HG_KT + HG_ARR, HG_SEG = HG_SC + 64 * HG_SCS, HG_EL = HG_SEG + 4096, HG_OUT = HG_EL + 512, HG_END = HG_OUT + HG_ARR;
static_assert(HG_END <= RING_BYTES, "hgrn LDS map");
__device__ __forceinline__ s16x4 tr16(const LAS unsigned char* p) { return __builtin_bit_cast(s16x4, __builtin_amdgcn_ds_read_tr16_b64_v4i16((LAS s16x4*)p)); }

__device__ __forceinline__ void hgrn_stream(const Frame& F, const Args& a, int bh) {
    const int b = bh >> 2, h = bh & 3;
    const bf16* P = (const bf16*)(a.ws + WS_PROJ) + (size_t)b * SEQ * INW;
    bf16* Y = (bf16*)(a.ws + WS_Y) + (size_t)b * SEQ * D + 512 + h * 128;
    LAS unsigned char* lds = F.lds;
    const int tid = F.tid, lane = F.lane, w = F.wave, l15 = lane & 15, g = lane >> 4;
    u32x4 pre[4][2], gsr[2];
    const __amdgpu_buffer_rsrc_t prs = __builtin_amdgcn_make_buffer_rsrc((void*)P, (short)0, SEQ * INW * 2, 0x00020000);
    const unsigned hg_voff = (unsigned)((tid >> 4) * INW + COL_QR + h * 128 + (tid & 15) * 8) * 2u;
#define HG_LOAD(c) do { _Pragma("unroll") for (int ar = 0; ar < 4; ++ar) _Pragma("unroll") for (int i = 0; i < 2; ++i) { \
        pre[ar][i] = __builtin_bit_cast(u32x4, __builtin_amdgcn_raw_buffer_load_b128(prs, hg_voff, (unsigned)((((c) * 64 + 32 * i) * INW + 512 * ar) * 2), 0)); } } while (0)
#define HG_STORE() do { _Pragma("unroll") for (int ar = 0; ar < 3; ++ar) _Pragma("unroll") for (int i = 0; i < 2; ++i) { const int q = tid + 512 * i, row = q >> 4, ch = q & 15; \
        *(LAS u32x4*)(lds + HG_RAW + ar * HG_ARR + row * HG_RS_ + ch * 16) = pre[ar][i]; } gsr[0] = pre[3][0]; gsr[1] = pre[3][1]; } while (0)
    f32x4 S[8];
#pragma unroll
    for (int kb = 0; kb < 8; ++kb) S[kb] = (f32x4){0.f, 0.f, 0.f, 0.f};
    float ngc[8];
    { const float* ngp = a.in[14] + h * 128 + (tid & 15) * 8;
#pragma unroll
      for (int i = 0; i < 8; ++i) ngc[i] = ngp[i]; }
    HG_LOAD(0);
    HG_STORE();
    for (int c = 0; c < SEQ / 64; ++c) {
        __syncthreads();
        if (c + 1 < SEQ / 64) HG_LOAD(c + 1);
        const bool wdo = c < WC_CHUNKS; const int wit = (c * 32 + bh) * 8 + w;
        f32x4 wv[8];
        if (wdo) wconv_load(a, wv, wit, lane);
        else {
#pragma unroll
            for (int i = 0; i < 8; ++i) wv[i] = (f32x4){0.f, 0.f, 0.f, 0.f}; }
        float bl[8][2];
        {
            float run0 = 0.f, run1 = 0.f;
#pragma unroll
            for (int i = 0; i < 8; ++i) { const unsigned v = *(const LAS unsigned*)(lds + HG_RAW + HG_ARR + (8 * w + i) * HG_RS_ + 4 * lane);
                run0 += bflo(v); run1 += bfhi(v); bl[i][0] = run0; bl[i][1] = run1; }
            *(LAS f32x2*)(lds + HG_SEG + (w * 128 + 2 * lane) * 4) = (f32x2){run0, run1};
        }
        __syncthreads();
        {
            float off0 = 0.f, off1 = 0.f, tot0 = 0.f, tot1 = 0.f;
#pragma unroll
            for (int s = 0; s < 8; ++s) { const f32x2 v = *(const LAS f32x2*)(lds + HG_SEG + (s * 128 + 2 * lane) * 4); if (s < w) { off0 += v.x; off1 += v.y; } tot0 += v.x; tot1 += v.y; }
            if (w == 0) *(LAS f32x2*)(lds + HG_EL + 2 * lane * 4) = (f32x2){fast_exp2(tot0 * LOG2E), fast_exp2(tot1 * LOG2E)};
#pragma unroll
            for (int i = 0; i < 8; ++i) { const int t = 8 * w + i;
                const unsigned lfv = *(const LAS unsigned*)(lds + HG_RAW + HG_ARR + t * HG_RS_ + 4 * lane);
                const unsigned qv = *(const LAS unsigned*)(lds + HG_RAW + t * HG_RS_ + 4 * lane);
                const float b0 = bl[i][0] + off0, b1 = bl[i][1] + off1;
                const float e0 = fast_exp2(b0 * LOG2E), e1 = fast_exp2(b1 * LOG2E);
                const float k0 = 1.f - fast_exp2(bflo(lfv) * LOG2E), k1 = 1.f - fast_exp2(bfhi(lfv) * LOG2E);
                *(LAS unsigned*)(lds + HG_QT + t * HG_RS_ + 4 * lane) = cvtpk(bflo(qv) * e0, bfhi(qv) * e1);
                *(LAS unsigned*)(lds + HG_KT + t * HG_RS_ + 4 * lane) = cvtpk(k0 * fast_rcp(e0), k1 * fast_rcp(e1)); }
        }
        __syncthreads();
#pragma unroll
        for (int i = 0; i < 2; ++i) { const int tile = 2 * w + i, tb = tile >> 2, sb = tile & 3;
            f32x4 sc = (f32x4){0.f, 0.f, 0.f, 0.f};
#pragma unroll
            for (int ks = 0; ks < 4; ++ks) { const bf16x8 af = *(const LAS bf16x8*)(lds + HG_QT + (16 * tb + l15) * HG_RS_ + (32 * ks + 8 * g) * 2);
                const bf16x8 bfr = *(const LAS bf16x8*)(lds + HG_KT + (16 * sb + l15) * HG_RS_ + (32 * ks + 8 * g) * 2);
                sc = __builtin_amdgcn_mfma_f32_16x16x32_bf16(af, bfr, sc, 0, 0, 0); }
#pragma unroll
            for (int r = 0; r < 4; ++r) { const int t = 16 * tb + 4 * g + r, s = 16 * sb + l15; const float v = (s <= t) ? sc[r] : 0.f;
                *(LAS unsigned short*)(lds + HG_SC + t * HG_SCS + s * 2) = (unsigned short)(cvtpk(v, 0.f) & 0xffffu); } }
        __syncthreads();
        bf16x8 vf[2];
#pragma unroll
        for (int ss = 0; ss < 2; ++ss) { const LAS unsigned char* vp = lds + HG_RAW + 2 * HG_ARR + (32 * ss + 8 * g + (l15 >> 2)) * HG_RS_ + (16 * w + 4 * (l15 & 3)) * 2;
            const s16x4 lo = tr16(vp), hi = tr16(vp + 4 * HG_RS_); vf[ss] = (bf16x8){lo[0], lo[1], lo[2], lo[3], hi[0], hi[1], hi[2], hi[3]}; }
        f32x4 o[4];
        {
            bf16x8 sf[4];
#pragma unroll
            for (int ks = 0; ks < 4; ++ks) { u32x4 t4; t4.x = cvtpk(S[2 * ks][0], S[2 * ks][1]); t4.y = cvtpk(S[2 * ks][2], S[2 * ks][3]); t4.z = cvtpk(S[2 * ks + 1][0], S[2 * ks + 1][1]); t4.w = cvtpk(S[2 * ks + 1][2], S[2 * ks + 1][3]);
                sf[ks] = __builtin_bit_cast(bf16x8, t4); }
#pragma unroll
            for (int tb = 0; tb < 4; ++tb) { f32x4 acc = (f32x4){0.f, 0.f, 0.f, 0.f};
#pragma unroll
                for (int ks = 0; ks < 4; ++ks) { const LAS unsigned char* qp = lds + HG_QT + (16 * tb + l15) * HG_RS_ + (32 * ks + 4 * g) * 2;
                    const u32x2 q0 = *(const LAS u32x2*)qp, q1 = *(const LAS u32x2*)(qp + 32);
                    const u32x4 q4 = (u32x4){q0.x, q0.y, q1.x, q1.y};
                    acc = __builtin_amdgcn_mfma_f32_16x16x32_bf16(__builtin_bit_cast(bf16x8, q4), sf[ks], acc, 0, 0, 0); }
#pragma unroll
                for (int ss = 0; ss < 2; ++ss) { const bf16x8 af = *(const LAS bf16x8*)(lds + HG_SC + (16 * tb + l15) * HG_SCS + (32 * ss + 8 * g) * 2);
                    acc = __builtin_amdgcn_mfma_f32_16x16x32_bf16(af, vf[ss], acc, 0, 0, 0); }
                o[tb] = acc; }
        }
#pragma unroll
        for (int kb = 0; kb < 8; ++kb) {
#pragma unroll
            for (int ss = 0; ss < 2; ++ss) { const LAS unsigned char* kp = lds + HG_KT + (32 * ss + 8 * g + (l15 >> 2)) * HG_RS_ + (16 * kb + 4 * (l15 & 3)) * 2;
                const s16x4 lo = tr16(kp), hi = tr16(kp + 4 * HG_RS_); const bf16x8 af = (bf16x8){lo[0], lo[1], lo[2], lo[3], hi[0], hi[1], hi[2], hi[3]};
                S[kb] = __builtin_amdgcn_mfma_f32_16x16x32_bf16(af, vf[ss], S[kb], 0, 0, 0); }
            const f32x4 el = *(const LAS f32x4*)(lds + HG_EL + (16 * kb + 4 * g) * 4);
            S[kb] = S[kb] * el; }
#pragma unroll
        for (int tb = 0; tb < 4; ++tb)
#pragma unroll
            for (int r = 0; r < 4; ++r) *(LAS unsigned short*)(lds + HG_OUT + (16 * tb + 4 * g + r) * HG_RS_ + (16 * w + l15) * 2) = (unsigned short)(cvtpk(o[tb][r], 0.f) & 0xffffu);
        __syncthreads();
#pragma unroll
        for (int i = 0; i < 2; ++i) { const int q = tid + 512 * i, row = q >> 4, ch = q & 15;
            const u32x4 ov = *(const LAS u32x4*)(lds + HG_OUT + row * HG_RS_ + ch * 16);
            float x[8]; x[0] = bflo(ov.x); x[1] = bfhi(ov.x); x[2] = bflo(ov.y); x[3] = bfhi(ov.y); x[4] = bflo(ov.z); x[5] = bfhi(ov.z); x[6] = bflo(ov.w); x[7] = bfhi(ov.w);
            float ss = 0.f;
#pragma unroll
            for (int j = 0; j < 8; ++j) ss += x[j] * x[j];
            ss = row_sum(ss);
            const float rr = __builtin_amdgcn_rsqf(ss * (1.f / 128.f) + EPS);
            const u32x4 gv = gsr[i];
            u32x4 yo;
            yo.x = cvtpk(x[0] * rr * ngc[0] * bflo(gv.x), x[1] * rr * ngc[1] * bfhi(gv.x)); yo.y = cvtpk(x[2] * rr * ngc[2] * bflo(gv.y), x[3] * rr * ngc[3] * bfhi(gv.y));
            yo.z = cvtpk(x[4] * rr * ngc[4] * bflo(gv.z), x[5] * rr * ngc[5] * bfhi(gv.z)); yo.w = cvtpk(x[6] * rr * ngc[6] * bflo(gv.w), x[7] * rr * ngc[7] * bfhi(gv.w));
            *(u32x4*)(Y + (size_t)(c * 64 + row) * D + ch * 8) = yo; }
        if (c + 1 < SEQ / 64) HG_STORE();
        if (wdo) wconv_store(a, wv, wit, lane, lds + EPI_SCR + w * 2048);
    }
    __syncthreads();
#undef HG_LOAD
#undef HG_STORE
}

constexpr int AT_BUF = 32768, AT_LUT = MISC_OFF + 4096, AT_WS = MISC_OFF + 6144, AT_TKT = MISC_OFF + 8192;
__device__ __forceinline__ int crow(int r, int hi) { return (r & 3) + 8 * (r >> 2) + 4 * hi; }
__device__ __forceinline__ int t5_bucket(int n) {
    if (n < 16) return n;
    int b = 16;
    b += (n >= 19); b += (n >= 21); b += (n >= 24); b += (n >= 27); b += (n >= 31); b += (n >= 35); b += (n >= 40); b += (n >= 46);
    b += (n >= 52); b += (n >= 59); b += (n >= 67); b += (n >= 77); b += (n >= 87); b += (n >= 99); b += (n >= 113);
    return b;
}
__device__ __forceinline__ float fmax_nc(float x, float y) { return __builtin_amdgcn_fmed3f(x, y, INFINITY); }
#define AT_SB() __builtin_amdgcn_sched_barrier(0)

__device__ __forceinline__ void at_qk(f32x16& p0, f32x16& p1, const LAS unsigned char* kb, const bf16x8 (&qf)[4]) {
    bf16x8 kf[8];
#pragma unroll
    for (int d0 = 0; d0 < 4; ++d0) { kf[2 * d0] = *(const LAS bf16x8*)(kb + d0 * 2048); kf[2 * d0 + 1] = *(const LAS bf16x8*)(kb + d0 * 2048 + 512); }
#pragma unroll
    for (int r = 0; r < 16; ++r) { p0[r] = 0.f; p1[r] = 0.f; }
#pragma unroll
    for (int d0 = 0; d0 < 4; ++d0) { p0 = __builtin_amdgcn_mfma_f32_32x32x16_bf16(kf[2 * d0], qf[d0], p0, 0, 0, 0); p1 = __builtin_amdgcn_mfma_f32_32x32x16_bf16(kf[2 * d0 + 1], qf[d0], p1, 0, 0, 0); }
}
__device__ __forceinline__ bf16x8 at_vfrag(const LAS unsigned char* vb, int db, int ks) {
    const s16x4 lo = tr16(vb + db * 4096 + ks * 1024), hh = tr16(vb + db * 4096 + ks * 1024 + 512);
    return (bf16x8){lo[0], lo[1], lo[2], lo[3], hh[0], hh[1], hh[2], hh[3]};
}
__device__ __forceinline__ bf16x8 at_kfrag(const LAS unsigned char* kb, int i) { return *(const LAS bf16x8*)(kb + (i >> 1) * 2048 + (i & 1) * 512); }
__device__ __forceinline__ float at_rowmax(const f32x16& c0, const f32x16& c1) {
    float a, b2;
    asm volatile("s_nop 15\n\ts_nop 7\n\tv_max3_f32 %0, %1, %2, %3" : "=v"(a) : "v"(c0[0]), "v"(c0[1]), "v"(c1[0]));
    asm volatile("v_max3_f32 %0, %1, %2, %3" : "=v"(b2) : "v"(c0[2]), "v"(c0[3]), "v"(c1[1]));
    asm volatile("v_max3_f32 %0, %1, %2, %3" : "=v"(a) : "v"(a), "v"(c1[2]), "v"(c1[3]));
#pragma unroll
    for (int r = 4; r < 16; r += 4) {
        asm volatile("v_max3_f32 %0, %1, %2, %3" : "=v"(a) : "v"(a), "v"(c0[r]), "v"(c0[r + 1]));
        asm volatile("v_max3_f32 %0, %1, %2, %3" : "=v"(b2) : "v"(b2), "v"(c0[r + 2]), "v"(c0[r + 3]));
        asm volatile("v_max3_f32 %0, %1, %2, %3" : "=v"(a) : "v"(a), "v"(c1[r]), "v"(c1[r + 1]));
        asm volatile("v_max3_f32 %0, %1, %2, %3" : "=v"(b2) : "v"(b2), "v"(c1[r + 2]), "v"(c1[r + 3]));
    }
    float m;
    asm volatile("v_max_f32_e32 %0, %1, %2" : "=v"(m) : "v"(a), "v"(b2));
    return fmaxf(m, __shfl_xor(m, 32));
}
constexpr float AT_THR = 6.0f;
#define AT_PK2(P, i) cvtpk(P[i], P[i + 1])

__device__ __forceinline__ void at_step(f32x16& C0, f32x16& C1, const f32x16& P0, const f32x16& P1, f32x16 (&O)[4], const bf16x8 (&qf)[4],
                                        const __amdgpu_buffer_rsrc_t prs, const unsigned k_voff, const unsigned v_voff, const unsigned so0, u32x4 (&pk)[2], u32x4 (&pv)[2],
                                        const LAS unsigned char* kb, const LAS unsigned char* vbp, const LAS unsigned char* kbn,
                                        float& mhat, float& l_reg, bool& resc, const LAS float* lut, bool band, LAS float* wsf, int r32, int hi) {
    bf16x8 va[4], vb[4];
    u32x4 pw0, pw1, pw2, pw3;
    float sacc = 0.f;
    f32x16 z16;
#pragma unroll
    for (int r = 0; r < 16; ++r) z16[r] = 0.f;
    bf16x8 k0 = at_kfrag(kb, 0), k1 = at_kfrag(kb, 1);
    __builtin_amdgcn_s_setprio(1);
    C0 = __builtin_amdgcn_mfma_f32_32x32x16_bf16(k0, qf[0], z16, 0, 0, 0); k0 = at_kfrag(kb, 2); va[0] = at_vfrag(vbp, 0, 0);
    sacc += (P0[0] + P0[1]) + (P0[2] + P0[3]); pw0.x = AT_PK2(P0, 0); pw0.y = AT_PK2(P0, 2); AT_SB();
    C1 = __builtin_amdgcn_mfma_f32_32x32x16_bf16(k1, qf[0], z16, 0, 0, 0); k1 = at_kfrag(kb, 3); va[1] = at_vfrag(vbp, 0, 1);
    sacc += (P0[4] + P0[5]) + (P0[6] + P0[7]); pw0.z = AT_PK2(P0, 4); pw0.w = AT_PK2(P0, 6); AT_SB();
    C0 = __builtin_amdgcn_mfma_f32_32x32x16_bf16(k0, qf[1], C0, 0, 0, 0); k0 = at_kfrag(kb, 4); va[2] = at_vfrag(vbp, 0, 2);
    sacc += (P0[8] + P0[9]) + (P0[10] + P0[11]); pw1.x = AT_PK2(P0, 8); pw1.y = AT_PK2(P0, 10); AT_SB();
    C1 = __builtin_amdgcn_mfma_f32_32x32x16_bf16(k1, qf[1], C1, 0, 0, 0); k1 = at_kfrag(kb, 5); va[3] = at_vfrag(vbp, 0, 3);
    sacc += (P0[12] + P0[13]) + (P0[14] + P0[15]); pw1.z = AT_PK2(P0, 12); pw1.w = AT_PK2(P0, 14); AT_SB();
    C0 = __builtin_amdgcn_mfma_f32_32x32x16_bf16(k0, qf[2], C0, 0, 0, 0); k0 = at_kfrag(kb, 6);
    sacc += (P1[0] + P1[1]) + (P1[2] + P1[3]); pw2.x = AT_PK2(P1, 0); pw2.y = AT_PK2(P1, 2); AT_SB();
    C1 = __builtin_amdgcn_mfma_f32_32x32x16_bf16(k1, qf[2], C1, 0, 0, 0); k1 = at_kfrag(kb, 7);
    sacc += (P1[4] + P1[5]) + (P1[6] + P1[7]); pw2.z = AT_PK2(P1, 4); pw2.w = AT_PK2(P1, 6); AT_SB();
    C0 = __builtin_amdgcn_mfma_f32_32x32x16_bf16(k0, qf[3], C0, 0, 0, 0);
    sacc += (P1[8] + P1[9]) + (P1[10] + P1[11]); pw3.x = AT_PK2(P1, 8); pw3.y = AT_PK2(P1, 10); AT_SB();
    C1 = __builtin_amdgcn_mfma_f32_32x32x16_bf16(k1, qf[3], C1, 0, 0, 0);
    sacc += (P1[12] + P1[13]) + (P1[14] + P1[15]); pw3.z = AT_PK2(P1, 12); pw3.w = AT_PK2(P1, 14); AT_SB();
    { bf16x8 kone, qneg;
      { u32x4 t4 = (u32x4){0u, 0u, 0u, 0u}; if (hi == 0) t4.x = 0x3F80u; kone = __builtin_bit_cast(bf16x8, t4);
        t4.x = 0u; if (hi == 0) t4.x = cvtpk(-mhat, 0.f) & 0xffffu; qneg = __builtin_bit_cast(bf16x8, t4); }
      C0 = __builtin_amdgcn_mfma_f32_32x32x16_bf16(kone, qneg, C0, 0, 0, 0);
      C1 = __builtin_amdgcn_mfma_f32_32x32x16_bf16(kone, qneg, C1, 0, 0, 0); } AT_SB();
    pk[0] = __builtin_bit_cast(u32x4, __builtin_amdgcn_raw_buffer_load_b128(prs, k_voff, so0, 0)); pv[0] = __builtin_bit_cast(u32x4, __builtin_amdgcn_raw_buffer_load_b128(prs, v_voff, so0, 0));
    pk[1] = __builtin_bit_cast(u32x4, __builtin_amdgcn_raw_buffer_load_b128(prs, k_voff, so0 + 32u * 512u, 0)); pv[1] = __builtin_bit_cast(u32x4, __builtin_amdgcn_raw_buffer_load_b128(prs, v_voff, so0 + 32u * 512u, 0));
    l_reg += sacc;
    __builtin_amdgcn_s_setprio(0);
    if (band) {
#pragma unroll
        for (int r = 0; r < 16; ++r) { const int ko = (r & 3) + 8 * (r >> 2); C0[r] += lut[-ko]; C1[r] += lut[-ko - 32]; }
    }
    const float rm = at_rowmax(C0, C1);
    resc = false;
    if (__any(rm > AT_THR)) {
        const float m_new = bf2f((unsigned short)(cvtpk(mhat + fmaxf(rm, 0.f), 0.f) & 0xffffu));
        const float dl = m_new - mhat;
        const float f = fast_exp2(-dl);
        l_reg *= f; if (hi == 0) wsf[r32] = f; mhat = m_new; resc = true;
#pragma unroll
        for (int r = 0; r < 16; ++r) { C0[r] -= dl; C1[r] -= dl; }
    }
    AT_SB();
    __builtin_amdgcn_s_setprio(1);
    const bf16x8 pa0 = __builtin_bit_cast(bf16x8, pw0), pa1 = __builtin_bit_cast(bf16x8, pw1), pa2 = __builtin_bit_cast(bf16x8, pw2), pa3 = __builtin_bit_cast(bf16x8, pw3);
#define AT_EX2(X, i) do { X[i] = fast_exp2(X[i]); X[i + 1] = fast_exp2(X[i + 1]); } while (0)
    O[0] = __builtin_amdgcn_mfma_f32_32x32x16_bf16(pa0, va[0], O[0], 0, 0, 0); vb[0] = at_vfrag(vbp, 1, 0); AT_EX2(C0, 0); AT_SB();
    O[0] = __builtin_amdgcn_mfma_f32_32x32x16_bf16(pa1, va[1], O[0], 0, 0, 0); vb[1] = at_vfrag(vbp, 1, 1); AT_EX2(C0, 2); AT_SB();
    O[0] = __builtin_amdgcn_mfma_f32_32x32x16_bf16(pa2, va[2], O[0], 0, 0, 0); vb[2] = at_vfrag(vbp, 1, 2); AT_EX2(C0, 4); AT_SB();
    O[0] = __builtin_amdgcn_mfma_f32_32x32x16_bf16(pa3, va[3], O[0], 0, 0, 0); vb[3] = at_vfrag(vbp, 1, 3); AT_EX2(C0, 6); AT_SB();
    O[1] = __builtin_amdgcn_mfma_f32_32x32x16_bf16(pa0, vb[0], O[1], 0, 0, 0); va[0] = at_vfrag(vbp, 2, 0); AT_EX2(C0, 8); AT_SB();
    O[1] = __builtin_amdgcn_mfma_f32_32x32x16_bf16(pa1, vb[1], O[1], 0, 0, 0); va[1] = at_vfrag(vbp, 2, 1); AT_EX2(C0, 10); AT_SB();
    O[1] = __builtin_amdgcn_mfma_f32_32x32x16_bf16(pa2, vb[2], O[1], 0, 0, 0); va[2] = at_vfrag(vbp, 2, 2); AT_EX2(C0, 12); AT_SB();
    O[1] = __builtin_amdgcn_mfma_f32_32x32x16_bf16(pa3, vb[3], O[1], 0, 0, 0); va[3] = at_vfrag(vbp, 2, 3); AT_EX2(C0, 14); AT_SB();
    O[2] = __builtin_amdgcn_mfma_f32_32x32x16_bf16(pa0, va[0], O[2], 0, 0, 0); vb[0] = at_vfrag(vbp, 3, 0); AT_EX2(C1, 0); AT_SB();
    O[2] = __builtin_amdgcn_mfma_f32_32x32x16_bf16(pa1, va[1], O[2], 0, 0, 0); vb[1] = at_vfrag(vbp, 3, 1); AT_EX2(C1, 2); AT_SB();
    O[2] = __builtin_amdgcn_mfma_f32_32x32x16_bf16(pa2, va[2], O[2], 0, 0, 0); vb[2] = at_vfrag(vbp, 3, 2); AT_EX2(C1, 4); AT_SB();
    O[2] = __builtin_amdgcn_mfma_f32_32x32x16_bf16(pa3, va[3], O[2], 0, 0, 0); vb[3] = at_vfrag(vbp, 3, 3); AT_EX2(C1, 6); AT_SB();
    O[3] = __builtin_amdgcn_mfma_f32_32x32x16_bf16(pa0, vb[0], O[3], 0, 0, 0); AT_EX2(C1, 8); AT_SB();
    O[3] = __builtin_amdgcn_mfma_f32_32x32x16_bf16(pa1, vb[1], O[3], 0, 0, 0); AT_EX2(C1, 10); AT_SB();
    O[3] = __builtin_amdgcn_mfma_f32_32x32x16_bf16(pa2, vb[2], O[3], 0, 0, 0); AT_EX2(C1, 12); AT_SB();
    O[3] = __builtin_amdgcn_mfma_f32_32x32x16_bf16(pa3, vb[3], O[3], 0, 0, 0); AT_EX2(C1, 14); AT_SB();
    __builtin_amdgcn_s_setprio(0);
#undef AT_EX2
}
__device__ __forceinline__ void at_rescale(f32x16 (&O)[4], const LAS float* wsf, int hi) {
#pragma unroll
    for (int gq = 0; gq < 4; ++gq) { const f32x4 al = *(const LAS f32x4*)(wsf + 8 * gq + 4 * hi);
#pragma unroll
        for (int db = 0; db < 4; ++db) { O[db][4 * gq + 0] *= al.x; O[db][4 * gq + 1] *= al.y; O[db][4 * gq + 2] *= al.z; O[db][4 * gq + 3] *= al.w; } }
}

__device__ __forceinline__ void attn_unit(const Frame& F, const Args& a, int bh, int qb, float lam) {
    const int b = bh >> 2, h = bh & 3;
    const bf16* KVb = (const bf16*)(a.ws + WS_KV) + (size_t)bh * SEQ * 256;
    const bf16* QCb = (const bf16*)(a.ws + WS_QC) + (size_t)bh * SEQ * 128;
    LAS unsigned char* lds = F.lds;
    int tid = F.tid; asm volatile("" : "+v"(tid));
    const int lane = tid & 63, w = F.wave, wq = w & 3, mc = w >> 2, r32 = lane & 31, hi = lane >> 5;
    const int q0 = qb * 128, NT = 2 * qb + 2;
    LAS float* wsf = (LAS float*)(lds + AT_WS + 256 * w);
    const int k_kv = ((tid >> 7) << 3) + (tid & 7), k_ch = (tid >> 3) & 15;
    const int k_lds = (k_ch >> 3) * 8192 + (k_ch & 7) * 1024 + k_kv * 16;
    const unsigned k_voff = (unsigned)(k_kv * 256 + k_ch * 8) * 2u;
    const int v_kv = (((tid >> 5) & 15) << 1) + ((tid >> 2) & 1), v_ch = (((tid >> 3) & 3) << 2) + (tid & 3);
    const int v_lds = 16384 + (v_ch >> 2) * 4096 + v_kv * 64 + (v_ch & 3) * 16;
    const unsigned v_voff = (unsigned)(v_kv * 256 + 128 + v_ch * 8) * 2u;
    const __amdgpu_buffer_rsrc_t prs = __builtin_amdgcn_make_buffer_rsrc((void*)KVb, (short)0, SEQ * 512, 0x00020000);
    u32x4 pk[2], pv[2];
#define AT_LOAD(j) do { _Pragma("unroll") for (int i = 0; i < 2; ++i) { const unsigned so = (unsigned)(((j) * 64 + 32 * i) * 512); \
        pk[i] = __builtin_bit_cast(u32x4, __builtin_amdgcn_raw_buffer_load_b128(prs, k_voff, so, 0)); pv[i] = __builtin_bit_cast(u32x4, __builtin_amdgcn_raw_buffer_load_b128(prs, v_voff, so, 0)); } } while (0)
#define AT_STORE(bufo) do { _Pragma("unroll") for (int i = 0; i < 2; ++i) { *(LAS u32x4*)(lds + (bufo) + k_lds + 32 * 16 * i) = pk[i]; *(LAS u32x4*)(lds + (bufo) + v_lds + 32 * 64 * i) = pv[i]; } } while (0)
    bf16x8 qf[4];
    { const bf16* qp = QCb + (size_t)(q0 + 32 * wq + r32) * 128 + mc * 64 + 8 * hi;
#pragma unroll
      for (int d0 = 0; d0 < 4; ++d0) qf[d0] = *(const bf16x8*)(qp + 16 * d0); }
    f32x16 O[4];
#pragma unroll
    for (int db = 0; db < 4; ++db)
#pragma unroll
        for (int r = 0; r < 16; ++r) O[db][r] = 0.f;
    float mhat = -INFINITY, l_reg = 0.f;
    {
        u32x4 qk[3][2], qv[3][2]; const int j2 = NT > 2 ? 2 : 1;
#pragma unroll
        for (int tl = 0; tl < 3; ++tl) { const int jt = tl < 2 ? tl : j2;
#pragma unroll
            for (int i = 0; i < 2; ++i) { const unsigned so = (unsigned)((jt * 64 + 32 * i) * 512);
                qk[tl][i] = __builtin_bit_cast(u32x4, __builtin_amdgcn_raw_buffer_load_b128(prs, k_voff, so, 0)); qv[tl][i] = __builtin_bit_cast(u32x4, __builtin_amdgcn_raw_buffer_load_b128(prs, v_voff, so, 0)); } }
#pragma unroll
        for (int tl = 0; tl < 3; ++tl)
#pragma unroll
            for (int i = 0; i < 2; ++i) { *(LAS u32x4*)(lds + tl * AT_BUF + k_lds + 32 * 16 * i) = qk[tl][i]; *(LAS u32x4*)(lds + tl * AT_BUF + v_lds + 32 * 64 * i) = qv[tl][i]; }
    }
    __syncthreads();
    const int koff = mc * 8192 + hi * 1024 + r32 * 16;
    const int voff = 16384 + ((lane >> 4) & 1) * 32 + (lane & 3) * 8 + (4 * hi + ((lane & 15) >> 2)) * 64;
    const LAS float* lutp = (const LAS float*)(lds + AT_LUT) + (q0 + 32 * wq + r32 + 127 - 4 * hi);
    f32x16 pA0, pA1, pB0, pB1;
    at_qk(pA0, pA1, lds + koff, qf);
    if (0 >= NT - 4) {
#pragma unroll
        for (int r = 0; r < 16; ++r) { const int ko = (r & 3) + 8 * (r >> 2); pA0[r] += lutp[-ko]; pA1[r] += lutp[-ko - 32]; }
    }
    mhat = bf2f((unsigned short)(cvtpk(at_rowmax(pA0, pA1), 0.f) & 0xffffu));
#pragma unroll
    for (int r = 0; r < 16; ++r) { pA0[r] = fast_exp2(pA0[r] - mhat); pA1[r] = fast_exp2(pA1[r] - mhat); }
    bool resc = false;
#define AT_SLOT(t) (((t) & 3) * AT_BUF)
#define AT_STEP(CA, CB, PA, PB, t) do { const int jl_ = ((t) + 2 < NT) ? (t) + 2 : NT - 1; \
        at_step(CA, CB, PA, PB, O, qf, prs, k_voff, v_voff, (unsigned)(jl_ * 64 * 512), pk, pv, lds + AT_SLOT(t) + koff, lds + AT_SLOT((t) - 1) + voff, lds + AT_SLOT((t) + 1) + koff, mhat, l_reg, resc, lutp - 64 * (t), (t) >= NT - 4, wsf, r32, hi); \
        AT_STORE(AT_SLOT((t) + 2)); __syncthreads(); if (resc) at_rescale(O, wsf, hi); } while (0)
    int t = 1;
    for (; t + 1 < NT; t += 2) { AT_STEP(pB0, pB1, pA0, pA1, t); AT_STEP(pA0, pA1, pB0, pB1, t + 1); }
    AT_STEP(pB0, pB1, pA0, pA1, t);
    {
        float sacc = 0.f;
#pragma unroll
        for (int r = 0; r < 16; ++r) sacc += pB0[r] + pB1[r];
        l_reg += sacc;
        u32x4 q4; bf16x8 pa[4];
        q4.x = AT_PK2(pB0, 0); q4.y = AT_PK2(pB0, 2); q4.z = AT_PK2(pB0, 4); q4.w = AT_PK2(pB0, 6); pa[0] = __builtin_bit_cast(bf16x8, q4);
        q4.x = AT_PK2(pB0, 8); q4.y = AT_PK2(pB0, 10); q4.z = AT_PK2(pB0, 12); q4.w = AT_PK2(pB0, 14); pa[1] = __builtin_bit_cast(bf16x8, q4);
        q4.x = AT_PK2(pB1, 0); q4.y = AT_PK2(pB1, 2); q4.z = AT_PK2(pB1, 4); q4.w = AT_PK2(pB1, 6); pa[2] = __builtin_bit_cast(bf16x8, q4);
        q4.x = AT_PK2(pB1, 8); q4.y = AT_PK2(pB1, 10); q4.z = AT_PK2(pB1, 12); q4.w = AT_PK2(pB1, 14); pa[3] = __builtin_bit_cast(bf16x8, q4);
        const LAS unsigned char* vbp = lds + AT_SLOT(NT - 1) + voff;
#pragma unroll
        for (int db = 0; db < 4; ++db)
#pragma unroll
            for (int ks = 0; ks < 4; ++ks) O[db] = __builtin_amdgcn_mfma_f32_32x32x16_bf16(pa[ks], at_vfrag(vbp, db, ks), O[db], 0, 0, 0);
    }
    __syncthreads();
    l_reg = sum_x32(l_reg, l_reg);
    { const float sc = (mc == 0 ? 1.f : lam) * fast_rcp(l_reg);
      if (hi == 0) wsf[r32] = sc;
      at_rescale(O, wsf, hi); }
    LAS float* ex = (LAS float*)lds + (mc * 4 + wq) * 4096;
#pragma unroll
    for (int db = 0; db < 4; ++db)
#pragma unroll
        for (int r = 0; r < 16; ++r) ex[crow(r, hi) * 128 + 32 * db + r32] = O[db][r];
    __syncthreads();
    {
        const int l15 = lane & 15, lr = lane >> 4;
        float gv[8];
        { const float* sg = a.in[11] + 8 * l15;
#pragma unroll
          for (int i = 0; i < 8; ++i) gv[i] = sg[i] * 0.8f; }
        bf16* Y = (bf16*)(a.ws + WS_Y) + (size_t)(b * SEQ + q0) * D + h * 128 + 8 * l15;
#pragma unroll
        for (int p = 0; p < 4; ++p) { const int R = 16 * w + 4 * p + lr;
            const LAS float* pa = (const LAS float*)lds + (R >> 5) * 4096 + (R & 31) * 128 + 8 * l15; const LAS float* pb = pa + 4 * 4096;
            const f32x4 a0 = *(const LAS f32x4*)pa, a1 = *(const LAS f32x4*)(pa + 4), b0 = *(const LAS f32x4*)pb, b1 = *(const LAS f32x4*)(pb + 4);
            const f32x4 o0 = a0 - b0, o1 = a1 - b1;
            float ss = (o0.x * o0.x + o0.y * o0.y) + (o0.z * o0.z + o0.w * o0.w) + (o1.x * o1.x + o1.y * o1.y) + (o1.z * o1.z + o1.w * o1.w);
            ss = row_sum(ss);
            const float rr = __builtin_amdgcn_rsqf(ss * (1.f / 128.f) + EPS);
            u32x4 yo;
            yo.x = cvtpk(o0.x * rr * gv[0], o0.y * rr * gv[1]); yo.y = cvtpk(o0.z * rr * gv[2], o0.w * rr * gv[3]);
            yo.z = cvtpk(o1.x * rr * gv[4], o1.y * rr * gv[5]); yo.w = cvtpk(o1.z * rr * gv[6], o1.w * rr * gv[7]);
            *(u32x4*)(Y + (size_t)R * D) = yo; }
    }
    __syncthreads();
#undef AT_LOAD
#undef AT_STORE
#undef AT_SLOT
#undef AT_STEP
}

__device__ __forceinline__ void p2_mixers(const Frame& F, const Args& a) {
    float lam;
    { const float v1 = a.in[7][F.lane] * a.in[8][F.lane], v2 = a.in[9][F.lane] * a.in[10][F.lane];
      lam = __expf(wave_sum(v1)) - __expf(wave_sum(v2)) + 0.2f; }
    const int per = F.G / 32;
    if (per < 1) return;
    const int bh = F.vcu / per, s = F.vcu % per;
    if (bh >= 32) return;
    { const int h = bh & 3; const float* tab = a.in[12]; const float t31 = tab[31 * 4 + h];
      for (int i = F.tid; i < 384; i += NTHREADS) { const int dist = i - 127; ((LAS float*)(F.lds + AT_LUT))[i] = dist < 0 ? -INFINITY : (tab[t5_bucket(dist) * 4 + h] - t31) * LOG2E; } }
    if (s == 0) hgrn_stream(F, a, bh);
    constexpr int NDYN = 14;
    if (s >= 1) {
        const int na = per - 1;
        for (int k = 0; k * na < 64 - NDYN; ++k) {
            const int idx = k * na + ((k & 1) ? (na - s) : (s - 1));
            if (idx < 64 - NDYN) attn_unit(F, a, bh, 63 - idx, lam);
        }
    }
    {
        unsigned* qhead = (unsigned*)(a.ws + WS_CTL) + CW_Q + 64 * bh;
        LAS unsigned* tk = (LAS unsigned*)(F.lds + AT_TKT);
        for (;;) {
            if (F.tid == 0) *tk = __hip_atomic_fetch_add(qhead, 1u, __ATOMIC_RELAXED, __HIP_MEMORY_SCOPE_AGENT);
            __syncthreads();
            const unsigned t = *tk;
            __syncthreads();
            if (t >= (unsigned)NDYN) break;
            attn_unit(F, a, bh, NDYN - 1 - (int)t, lam);
        }
    }
}

constexpr int RT_W = 0, RT_HIST = 73728, RT_BASE = 73856;
__device__ __forceinline__ void p4_router(const Frame& F, const Args& a) {
    LAS unsigned char* lds = F.lds;
    const float* wg = a.in[16]; const float* bg = a.in[17]; const float* we = a.in[18]; const float* be = a.in[19];
    for (int i = F.tid; i < 4 * 1024; i += NTHREADS) { const int d = i >> 2, e = i & 3;
        ((LAS unsigned short*)(lds + RT_W))[e * 1024 + d] = (unsigned short)(cvtpk(wg[i], 0.f) & 0xffffu); }
    for (int i = F.tid; i < 32 * 1024; i += NTHREADS) { const int d = i >> 5, e = i & 31;
        ((LAS unsigned short*)(lds + RT_W))[(4 + e) * 1024 + d] = (unsigned short)(cvtpk(we[i], 0.f) & 0xffffu); }
    if (F.tid < 32) ((LAS unsigned*)(lds + RT_HIST))[F.tid] = 0u;
    __syncthreads();
    const bf16* x1 = (const bf16*)(a.ws + WS_X1B); const float* ng = a.in[5]; const float* mod = (const float*)(a.ws + WS_MOD);
    bf16* H = (bf16*)(a.ws + WS_H);
    const int gw = F.vcu * NWAVES + F.wave, NGW = F.G * NWAVES, lane = F.lane;
    int my_tok = -1, my_e0 = 0, my_e1 = 0; float my_w0 = 0.f, my_w1 = 0.f;
    const int per = (NTOK + NGW - 1) / NGW;
    const int m0 = gw * per, m1 = (m0 + per < NTOK) ? m0 + per : NTOK;
    int it = 0;
    for (int s0 = m0; s0 < m1; ) {
      const int b = s0 >> 13, e1 = ((b + 1) << 13) < m1 ? ((b + 1) << 13) : m1;
      f32x4 ga[4], sha[4];
      { const f32x4* gp = (const f32x4*)ng + lane; const f32x4* shp = (const f32x4*)(mod + b * 6144 + 3072) + lane; const f32x4* scp = (const f32x4*)(mod + b * 6144 + 4096) + lane;
#pragma unroll
        for (int j = 0; j < 4; ++j) { ga[j] = gp[64 * j] * (scp[64 * j] + 1.f); sha[j] = shp[64 * j]; } }
      u32x2 nxv[4];
      { const u32x2* xr = (const u32x2*)(x1 + (size_t)s0 * D) + lane;
#pragma unroll
        for (int j = 0; j < 4; ++j) nxv[j] = xr[64 * j]; }
      for (int m = s0; m < e1; ++m, ++it) {
        f32x4 v[4]; float s = 0.f;
#pragma unroll
        for (int j = 0; j < 4; ++j) { const u32x2 xv = nxv[j]; v[j] = (f32x4){bflo(xv.x), bfhi(xv.x), bflo(xv.y), bfhi(xv.y)}; s += (v[j].x * v[j].x + v[j].y * v[j].y) + (v[j].z * v[j].z + v[j].w * v[j].w); }
        { const int mn = (m + 1 < e1) ? m + 1 : m; const u32x2* xr = (const u32x2*)(x1 + (size_t)mn * D) + lane;
#pragma unroll
          for (int j = 0; j < 4; ++j) nxv[j] = xr[64 * j]; }
        const float r = __builtin_amdgcn_rsqf(wave_sum(s) * (1.f / D) + EPS);
        u32x2* o8 = (u32x2*)(H + (size_t)m * D) + lane;
        u32x2 hp[4];
#pragma unroll
        for (int j = 0; j < 4; ++j) {
            v[j] = v[j] * r * ga[j] + sha[j];
            u32x2 o; o.x = cvtpk(v[j].x, v[j].y); o.y = cvtpk(v[j].z, v[j].w); o8[64 * j] = o; asm("" : "+v"(o.x), "+v"(o.y)); hp[j] = o; }
        asm volatile("" ::: "memory");
        float lg[4];
#pragma unroll
        for (int e = 0; e < 4; ++e) { float acc = 0.f;
#pragma unroll
            for (int j = 0; j < 4; ++j) { const u32x2 wv = *(const LAS u32x2*)(lds + RT_W + (e * 1024 + 256 * j + 4 * lane) * 2);
                acc = dot2bf(wv.x, hp[j].x, acc); acc = dot2bf(wv.y, hp[j].y, acc); }
            lg[e] = wave_sum(acc) + bg[e]; }
        int gi = 0; float gm = lg[0];
#pragma unroll
        for (int i = 1; i < 4; ++i) if (lg[i] > gm) { gm = lg[i]; gi = i; }
        gi = __builtin_amdgcn_readfirstlane(gi);
        float gs = 0.f;
#pragma unroll
        for (int i = 0; i < 4; ++i) gs += __expf(lg[i] - gm);
        const float gate = 1.f / gs;
        float pe[8];
        { const LAS unsigned char* wb_ = lds + RT_W + (size_t)(4 + gi * 8) * 2048;
#pragma unroll
          for (int e = 0; e < 8; ++e) { float acc = 0.f;
#pragma unroll
              for (int j = 0; j < 4; ++j) { const u32x2 wv = *(const LAS u32x2*)(wb_ + (e * 1024 + 256 * j + 4 * lane) * 2);
                  acc = dot2bf(wv.x, hp[j].x, acc); acc = dot2bf(wv.y, hp[j].y, acc); }
              pe[e] = acc; } }
        float t4[4], t2[2], t1;
#pragma unroll
        for (int i = 0; i < 4; ++i) t4[i] = sum_x32(pe[i], pe[i + 4]);
#pragma unroll
        for (int i = 0; i < 2; ++i) t2[i] = sum_x16(t4[i], t4[i + 2]);
        { const bool up = (lane & 8) != 0; const float keep = up ? t2[1] : t2[0], send = up ? t2[0] : t2[1]; t1 = keep + dppf<0x128>(send); }
        t1 += dppf<0xB1>(t1); t1 += dppf<0x4E>(t1); t1 += dppf<0x141>(t1);
        float el[8];
#pragma unroll
        for (int i = 0; i < 8; ++i) el[i] = __builtin_bit_cast(float, __builtin_amdgcn_readlane(__builtin_bit_cast(int, t1), 8 * ((i & 1) + 2 * ((i >> 1) & 1) + 4 * ((i >> 2) & 1)))) + be[gi * 8 + i];
        int ia = 0; float va = el[0];
#pragma unroll
        for (int i = 1; i < 8; ++i) if (el[i] > va) { va = el[i]; ia = i; }
        int ib = -1; float vb = -INFINITY;
#pragma unroll
        for (int i = 0; i < 8; ++i) if (i != ia && el[i] > vb) { vb = el[i]; ib = i; }
        const float wa = gate / (1.f + __expf(vb - va)), wb = gate - wa;
        if (lane == it) { my_tok = m; my_e0 = gi * 8 + ia; my_e1 = gi * 8 + ib; my_w0 = wa; my_w1 = wb; }
      }
      s0 = e1;
    }
    LAS unsigned* hist = (LAS unsigned*)(lds + RT_HIST); LAS unsigned* base = (LAS unsigned*)(lds + RT_BASE);
    unsigned r0 = 0, r1 = 0;
    if (my_tok >= 0) { r0 = atomicAdd((unsigned*)hist + my_e0, 1u); r1 = atomicAdd((unsigned*)hist + my_e1, 1u); }
    __syncthreads();
    unsigned* cnt = (unsigned*)(a.ws + WS_CTL) + CW_CNT;
    if (F.tid < 32) { const unsigned hv = hist[F.tid]; base[F.tid] = hv ? __hip_atomic_fetch_add(cnt + F.tid, hv, __ATOMIC_RELAXED, __HIP_MEMORY_SCOPE_AGENT) : 0u; }
    __syncthreads();
    if (my_tok >= 0) {
        int* list = (int*)(a.ws + WS_LIST); float* tw = (float*)(a.ws + WS_TOKW);
        const int p0_ = (int)(base[my_e0] + r0), p1_ = (int)(base[my_e1] + r1);
        list[(size_t)my_e0 * NTOK + p0_] = my_tok * 2;
        list[(size_t)my_e1 * NTOK + p1_] = my_tok * 2 + 1;
        tw[my_tok * 2] = my_w0; tw[my_tok * 2 + 1] = my_w1;
        int* toks = (int*)(a.ws + WS_TOKS);
        toks[my_tok * 2] = (my_e0 << 20) | p0_; toks[my_tok * 2 + 1] = (my_e1 << 20) | p1_;
    }
}

constexpr int MOE_CNTL = MISC_OFF + 256, MOE_LTOK = MISC_OFF + 4096, MOE_MAXU = 12;
struct MoeOrder {
    const LAS int* pre; const LAS int* cntl; const LAS int* ltok; const int* list; int G, c, lane; bool gather;
    __device__ __forceinline__ bool next(int i, pg8::Unit& u) const {
        const int total = pre[32];
        int rt, pn;
        if (G == 256) {
            rt = (i * 8 + (c & 7)) * 8 + ((c >> 3) & 7); pn = c >> 6;
            if (rt >= total) return false;
        } else { const long L = (long)i * G + c; if (L >= (long)total * 4) return false; rt = (int)(L >> 2); pn = (int)(L & 3); }
        const int e = __builtin_popcountll(__ballot(pre[(lane & 31) + 1] <= rt) & 0xffffffffull);
        u.e = e; u.pm = rt; u.pn = e * 4 + pn; u.r0 = (rt - pre[e]) * 256; const int n = cntl[e] - u.r0; u.nrows = n < 256 ? n : 256; u.slot = i; return true;
    }
    __device__ __forceinline__ int arow(const pg8::Unit& u, int r) const {
        if (!gather) return u.pm * 256 + r;
        if (u.slot < MOE_MAXU) return ltok[u.slot * 256 + r];
        return r < u.nrows ? (list[(size_t)u.e * NTOK + u.r0 + r] >> 1) : 0;
    }
};
struct EpiSwiGLU {
    static constexpr bool PERM = true;
    static constexpr int NST = 8;
    bf16* act;
    LAS unsigned char* scr;
    __device__ __forceinline__ void operator()(const f32x4 (&acc)[2][2][4][2], const pg8::Unit& u, int wr, int wc, int fr, int fq) const {
        LAS unsigned char* ws_ = scr + (wr * 4 + wc) * 2048;
        const int l = fr + 16 * fq, r8 = l >> 3, c8 = l & 7;
        bf16* base = act + (size_t)(u.pm * 256 + wr * 64 + (c8 >> 2) * 16 + r8) * FF + (u.pn & 3) * 128 + wc * 32 + 8 * (c8 & 3);
        u32x4 rq[2][2];
#pragma unroll
        for (int it = 0; it <= 4; ++it) {
            if (it < 4) { const int ai = it >> 1, m2 = it & 1; u32x4 w[2];
#pragma unroll
                for (int q = 0; q < 2; ++q) { const int m = 2 * m2 + q; const f32x4 a0 = acc[ai][0][m][0], a1 = acc[ai][0][m][1], b0 = acc[ai][1][m][0], b1 = acc[ai][1][m][1];
                    w[q].x = cvtpk(siluf_(a0.x) * b0.x, siluf_(a0.y) * b0.y); w[q].y = cvtpk(siluf_(a0.z) * b0.z, siluf_(a0.w) * b0.w);
                    w[q].z = cvtpk(siluf_(a1.x) * b1.x, siluf_(a1.y) * b1.y); w[q].w = cvtpk(siluf_(a1.z) * b1.z, siluf_(a1.w) * b1.w); }
                pg8::xpose128(ws_, fr, fq, w[0], w[1], rq[it & 1][0], rq[it & 1][1]); }
            if (it > 0) { const int ai = (it - 1) >> 1, m2 = (it - 1) & 1;
                bf16* rowp = base + (size_t)(ai * 128 + m2 * 32) * FF;
                *(u32x4*)rowp = rq[(it - 1) & 1][0]; *(u32x4*)(rowp + (size_t)8 * FF) = rq[(it - 1) & 1][1]; } }
    }
};
struct EpiScatter {
    static constexpr bool PERM = true;
    static constexpr int NST = 16;
    bf16* ybuf;
    LAS unsigned char* scr;
    __device__ __forceinline__ void operator()(const f32x4 (&acc)[2][2][4][2], const pg8::Unit& u, int wr, int wc, int fr, int fq) const {
        LAS unsigned char* ws_ = scr + (wr * 4 + wc) * 2048;
        const int l = fr + 16 * fq, r8 = l >> 3, c8 = l & 7;
        bf16* base = ybuf + (size_t)(u.pm * 256 + wr * 64 + r8) * D + (u.pn & 3) * 256 + wc * 64 + 8 * c8;
        u32x4 rq[2][2];
#pragma unroll
        for (int it = 0; it <= 8; ++it) {
            if (it < 8) { const int ai = it >> 2, m = it & 3; u32x4 w[2];
#pragma unroll
                for (int bj = 0; bj < 2; ++bj) { const f32x4 v0 = acc[ai][bj][m][0], v1 = acc[ai][bj][m][1];
                    w[bj].x = cvtpk(v0.x, v0.y); w[bj].y = cvtpk(v0.z, v0.w); w[bj].z = cvtpk(v1.x, v1.y); w[bj].w = cvtpk(v1.z, v1.w); }
                pg8::xpose128(ws_, fr, fq, w[0], w[1], rq[it & 1][0], rq[it & 1][1]); }
            if (it > 0) { const int ai = (it - 1) >> 2, m = (it - 1) & 3;
                bf16* rowp = base + (size_t)(ai * 128 + m * 16) * D;
                *(u32x4*)rowp = rq[(it - 1) & 1][0]; *(u32x4*)(rowp + (size_t)8 * D) = rq[(it - 1) & 1][1]; } }
    }
};

__device__ __forceinline__ void p7_final(const Frame& F, const Args& a) {
    float* out = a.out; const float* fg = a.in[23]; const float* mod = (const float*)(a.ws + WS_MOD);
    const bf16* yb = (const bf16*)(a.ws + WS_YBUF); const float* tw = (const float*)(a.ws + WS_TOKW); const int* toks = (const int*)(a.ws + WS_TOKS); const bf16* x1b = (const bf16*)(a.ws + WS_X1B);
    const int gw = F.vcu * NWAVES + F.wave, NGW = F.G * NWAVES, lane = F.lane;
    const int per = (NTOK + NGW - 1) / NGW;
    const int m0 = gw * per, m1 = (m0 + per < NTOK) ? m0 + per : NTOK;
    if (m0 >= NTOK) return;
    const int prev = ((const LAS int*)(F.lds + MISC_OFF))[lane & 31];
    u32x4 nx[2], ny0[2], ny1[2];
#define P7_ROW(sv) (__builtin_amdgcn_readlane(prev, (sv) >> 20) * 256 + ((sv) & 0xFFFFF))
#define P7_LOAD(mm, ra, rb) do { _Pragma("unroll") for (int j = 0; j < 2; ++j) { nx[j] = *((const u32x4*)(x1b + (size_t)(mm) * D) + lane + 64 * j); \
        ny0[j] = *((const u32x4*)(yb + (size_t)(ra) * D) + lane + 64 * j); ny1[j] = *((const u32x4*)(yb + (size_t)(rb) * D) + lane + 64 * j); } } while (0)
    f32x4 fgr[2][2];
#pragma unroll
    for (int j = 0; j < 2; ++j) { const f32x4* gp = (const f32x4*)(fg + 512 * j) + 2 * lane; fgr[j][0] = gp[0]; fgr[j][1] = gp[1]; }
    for (int s0 = m0; s0 < m1; ) {
        const int b = s0 >> 13; int e1 = ((b + 1) << 13) < m1 ? ((b + 1) << 13) : m1; if (e1 > s0 + 32) e1 = s0 + 32;
        const int nrow = e1 - s0;
        const int tv = (lane < 2 * nrow) ? toks[2 * s0 + lane] : 0; const float wv = (lane < 2 * nrow) ? tw[2 * s0 + lane] : 0.f;
        f32x4 g2r[2][2];
#pragma unroll
        for (int j = 0; j < 2; ++j) { const f32x4* g2p = (const f32x4*)(mod + b * 6144 + 5120 + 512 * j) + 2 * lane; g2r[j][0] = g2p[0]; g2r[j][1] = g2p[1]; }
        { const int sa = __builtin_amdgcn_readlane(tv, 0), sb = __builtin_amdgcn_readlane(tv, 1); P7_LOAD(s0, P7_ROW(sa), P7_ROW(sb)); }
        for (int i = 0; i < nrow; ++i) { const int m = s0 + i;
            u32x4 cx[2], cy0[2], cy1[2];
#pragma unroll
            for (int j = 0; j < 2; ++j) { cx[j] = nx[j]; cy0[j] = ny0[j]; cy1[j] = ny1[j]; }
            { const int in_ = (i + 1 < nrow) ? i + 1 : i; const int sa = __builtin_amdgcn_readlane(tv, 2 * in_), sb = __builtin_amdgcn_readlane(tv, 2 * in_ + 1); P7_LOAD(s0 + in_, P7_ROW(sa), P7_ROW(sb)); }
            const float w0 = __builtin_bit_cast(float, __builtin_amdgcn_readlane(__builtin_bit_cast(int, wv), 2 * i)), w1 = __builtin_bit_cast(float, __builtin_amdgcn_readlane(__builtin_bit_cast(int, wv), 2 * i + 1));
            float v[2][8]; float s = 0.f;
#pragma unroll
            for (int j = 0; j < 2; ++j) { const f32x4 ga = g2r[j][0], gb = g2r[j][1];
                const float g2[8] = {ga.x, ga.y, ga.z, ga.w, gb.x, gb.y, gb.z, gb.w};
                const unsigned xw[4] = {cx[j].x, cx[j].y, cx[j].z, cx[j].w}, aw[4] = {cy0[j].x, cy0[j].y, cy0[j].z, cy0[j].w}, bw[4] = {cy1[j].x, cy1[j].y, cy1[j].z, cy1[j].w};
#pragma unroll
                for (int k = 0; k < 4; ++k) { const float mm0 = w0 * bflo(aw[k]) + w1 * bflo(bw[k]), mm1 = w0 * bfhi(aw[k]) + w1 * bfhi(bw[k]);
                    v[j][2 * k] = bflo(xw[k]) + g2[2 * k] * mm0; v[j][2 * k + 1] = bfhi(xw[k]) + g2[2 * k + 1] * mm1;
                    s += v[j][2 * k] * v[j][2 * k] + v[j][2 * k + 1] * v[j][2 * k + 1]; } }
            const float r = __builtin_amdgcn_rsqf(wave_sum(s) * (1.f / D) + EPS);
#pragma unroll
            for (int j = 0; j < 2; ++j) { const f32x4 ga = fgr[j][0], gb = fgr[j][1];
                f32x4* op = (f32x4*)(out + (size_t)m * D + 512 * j) + 2 * lane;
                op[0] = (f32x4){v[j][0] * r * ga.x, v[j][1] * r * ga.y, v[j][2] * r * ga.z, v[j][3] * r * ga.w};
                op[1] = (f32x4){v[j][4] * r * gb.x, v[j][5] * r * gb.y, v[j][6] * r * gb.z, v[j][7] * r * gb.w}; }
        }
        s0 = e1;
    }
#undef P7_LOAD
#undef P7_ROW
}

constexpr unsigned long long P1_CPERM = 0x0ull | (0ull << 0) | (1ull << 4) | (2ull << 8) | (3ull << 12) | (4ull << 16) | (5ull << 20) | (10ull << 24) | (11ull << 28)
                                       | (6ull << 32) | (7ull << 36) | (12ull << 40) | (13ull << 44) | (8ull << 48) | (9ull << 52) | (15ull << 60);
#define LOAD_ARGS(la) Args la; { const __attribute__((address_space(4))) Args* ap_ = (const __attribute__((address_space(4))) Args*)__builtin_amdgcn_kernarg_segment_ptr(); asm volatile("" : "+s"(ap_)); la = *(const Args*)ap_; }
__global__ void __launch_bounds__(NTHREADS, 2) fwd_megakernel(Args args_unused) {
    extern __shared__ __attribute__((aligned(16))) unsigned char lds_raw[];
    cg::grid_group grid = cg::this_grid();
    Frame F;
    F.lds = (LAS unsigned char*)lds_raw;
    F.tid = threadIdx.x; F.lane = F.tid & 63; F.wave = __builtin_amdgcn_readfirstlane(F.tid >> 6);
    F.G = gridDim.x; { const int bx = blockIdx.x; F.vcu = (F.G % 8 == 0) ? (bx % 8) * (F.G / 8) + bx / 8 : bx; }
#define REFRAME() do { int l_; asm volatile("v_mbcnt_lo_u32_b32 %0, -1, 0\n\tv_mbcnt_hi_u32_b32 %0, -1, %0" : "=v"(l_)); F.lane = l_; F.tid = F.wave * 64 + l_; } while (0)
    for (int u = F.tid; u < (LDS_BYTES - MISC_OFF) / 4; u += NTHREADS) ((LAS unsigned*)(F.lds + MISC_OFF))[u] = 0u;
    __syncthreads();
    XcdBarrier xbar;
    { LOAD_ARGS(args0); xbar = xcd_barrier_post((unsigned*)(args0.ws + WS_CTL) + CW_BAR, (volatile LAS unsigned*)(F.lds + MISC_OFF + 1024)); }
#define GRID_BAR() xcd_barrier(xbar)

    { REFRAME(); LOAD_ARGS(args); p0_prologue(F, args); }
    grid.sync();
    { REFRAME(); LOAD_ARGS(args); p0b_norm1(F, args); }
    GRID_BAR();
    {
        REFRAME(); LOAD_ARGS(args); unsigned char* ws = args.ws;
        pg8::Gemm g{(const bf16*)(ws + WS_H), (const bf16*)(ws + WS_WIN), 1024}; pg8::DenseOrder S; S.init(NTOK, INW, F.G, (int)blockIdx.x, P1_CPERM);
        EpiProj E{(bf16*)(ws + WS_PROJ), args.in[13], (bf16*)(ws + WS_QC), (bf16*)(ws + WS_KV), F.lds + EPI_SCR};
        pg8::gemm_phase<EpiProj, pg8::DenseOrder>(F.lds, g, S, E, F.tid);
    }
    GRID_BAR();
    { REFRAME(); LOAD_ARGS(args); p2_mixers(F, args); }
    GRID_BAR();
    {
        REFRAME(); LOAD_ARGS(args); unsigned char* ws = args.ws;
        pg8::Gemm g{(const bf16*)(ws + WS_Y), (const bf16*)(ws + WS_WOUT), 1024}; pg8::DenseOrder S; S.init(NTOK, D, F.G, (int)blockIdx.x);
        EpiRes1 E{args.in[0], (bf16*)(ws + WS_X1B), (const float*)(ws + WS_MOD), F.lds + EPI_SCR};
        pg8::gemm_phase<EpiRes1, pg8::DenseOrder>(F.lds, g, S, E, F.tid);
    }
    GRID_BAR();
    { REFRAME(); LOAD_ARGS(args); p4_router(F, args); }
    GRID_BAR();
    {
        LAS int* pre = (LAS int*)(F.lds + MISC_OFF);
        { LOAD_ARGS(args);
          const unsigned* cnt = (const unsigned*)(args.ws + WS_CTL) + CW_CNT;
          if (F.tid < 64) {
              const int lane = F.tid; const int cv_ = (int)__hip_atomic_load(cnt + (lane & 31), __ATOMIC_RELAXED, __HIP_MEMORY_SCOPE_AGENT); const int tl = lane < 32 ? ((cv_ + 255) >> 8) : 0;
              if (lane < 32) ((LAS int*)(F.lds + MOE_CNTL))[lane] = cv_;
              int inc = tl;
#pragma unroll
              for (int o = 1; o < 32; o <<= 1) { const int t = __shfl_up(inc, o); if (lane >= o) inc += t; }
              if (lane < 32) pre[lane] = inc - tl;
              if (lane == 31) pre[32] = inc; } }
        __syncthreads();
        {
            REFRAME(); LOAD_ARGS(args); unsigned char* ws = args.ws;
            pg8::Gemm g{(const bf16*)(ws + WS_H), (const bf16*)(ws + WS_W13), 1024};
            MoeOrder S{pre, (const LAS int*)(F.lds + MOE_CNTL), (const LAS int*)(F.lds + MOE_LTOK), (const int*)(ws + WS_LIST), F.G, (int)blockIdx.x, F.lane, true};
            {
                const int* list = (const int*)(ws + WS_LIST); int tv[MOE_MAXU];
#pragma unroll
                for (int i = 0; i < MOE_MAXU; ++i) { pg8::Unit u; tv[i] = 0;
                    if (F.tid < 256 && S.next(i, u) && F.tid < u.nrows) tv[i] = list[(size_t)u.e * NTOK + u.r0 + F.tid] >> 1; }
#pragma unroll
                for (int i = 0; i < MOE_MAXU; ++i) if (F.tid < 256) ((LAS int*)(F.lds + MOE_LTOK))[i * 256 + F.tid] = tv[i];
                __syncthreads();
            }
            EpiSwiGLU E{(bf16*)(ws + WS_ACT), F.lds + EPI_SCR};
            pg8::gemm_phase<EpiSwiGLU, MoeOrder>(F.lds, g, S, E, F.tid);
        }
        GRID_BAR();
        {
            REFRAME(); LOAD_ARGS(args); unsigned char* ws = args.ws;
            pg8::Gemm g{(const bf16*)(ws + WS_ACT), (const bf16*)(ws + WS_W2), 512};
            MoeOrder S{pre, (const LAS int*)(F.lds + MOE_CNTL), (const LAS int*)(F.lds + MOE_LTOK), (const int*)(ws + WS_LIST), F.G, (int)blockIdx.x, F.lane, false};
            EpiScatter E{(bf16*)(ws + WS_YBUF), F.lds + EPI_SCR};
            pg8::gemm_phase<EpiScatter, MoeOrder>(F.lds, g, S, E, F.tid);
        }
    }
    GRID_BAR();
    { REFRAME(); LOAD_ARGS(args); p7_final(F, args); }
}

extern "C" void kernel_launch(void* const* d_in, const int* in_sizes, int n_in, void* d_out, int out_size, void* d_ws, size_t ws_size, hipStream_t stream) {
    static int grid = 0;
    if (grid == 0) {
        if (n_in != 24 || out_size != NTOK * D || ws_size < WS_END) { fprintf(stderr, "kernel_launch: unexpected problem (n_in %d out %d ws %zu)\n", n_in, out_size, ws_size); grid = -1; return; }
        int dev = 0, cus = 0, per_cu = 0;
        hipGetDevice(&dev);
        hipDeviceGetAttribute(&cus, hipDeviceAttributeMultiprocessorCount, dev);
        hipFuncSetAttribute((const void*)fwd_megakernel, hipFuncAttributeMaxDynamicSharedMemorySize, LDS_BYTES);
        hipOccupancyMaxActiveBlocksPerMultiprocessor(&per_cu, (const void*)fwd_megakernel, NTHREADS, LDS_BYTES);
        if (per_cu < 1) { fprintf(stderr, "kernel_launch: occupancy query says %d blocks per CU\n", per_cu); per_cu = 1; }
        grid = cus;
        (void)hipGetLastError();
    }
    if (grid < 0) return;
    hipMemsetAsync((char*)d_ws + WS_CTL, 0, CTL_ZERO_BYTES, stream);
    Args a{};
    for (int i = 0; i < 24; ++i) a.in[i] = (const float*)d_in[i];
    a.out = (float*)d_out; a.ws = (unsigned char*)d_ws;
    void* kargs[] = {&a};
    hipError_t e = hipLaunchCooperativeKernel((const void*)fwd_megakernel, dim3(grid), dim3(NTHREADS), kargs, LDS_BYTES, stream);
    if (e != hipSuccess) fprintf(stderr, "cooperative launch failed: %s (grid %d)\n", hipGetErrorString(e), grid);
}
```

```cpp
#include <hip/hip_runtime.h>
#include <hip/hip_cooperative_groups.h>
#include <cstdint>
#include <cstdio>
namespace cg = cooperative_groups;

#define LAS __attribute__((address_space(3)))
#define GAS __attribute__((address_space(1)))
typedef unsigned short bf16;
typedef short bf16x8 __attribute__((ext_vector_type(8)));
typedef short s16x4 __attribute__((ext_vector_type(4)));
typedef float f32x2 __attribute__((ext_vector_type(2)));
typedef float f32x4 __attribute__((ext_vector_type(4)));
typedef float f32x16 __attribute__((ext_vector_type(16)));
typedef unsigned u32x2 __attribute__((ext_vector_type(2)));
typedef unsigned u32x4 __attribute__((ext_vector_type(4)));
typedef __bf16 bf16x2_t __attribute__((ext_vector_type(2)));

constexpr int D = 1024, BATCH = 8, SEQ = 8192, NTOK = BATCH * SEQ;
constexpr int INW = 3584;
constexpr int COL_QA = 0, COL_KA = 512, COL_VA = 1024, COL_QR = 1536, COL_FR = 2048, COL_IR = 2560, COL_GR = 3072;
constexpr int NEXP = 32, FF = 512;
constexpr float EPS = 1e-6f;
constexpr float LOG2E = 1.4426950408889634f;
constexpr float QSCALE = 0.125f * LOG2E;
constexpr int NWAVES = 8, NTHREADS = 512;

constexpr size_t MiB = 1u << 20;
constexpr size_t WS_CTL = 0, CTL_ZERO_BYTES = 64 * 1024;
constexpr size_t WS_MOD = 1 * MiB;
constexpr size_t WS_WIN = 2 * MiB;
constexpr size_t WS_WOUT = 9 * MiB;
constexpr size_t WS_W13 = 11 * MiB;
constexpr size_t WS_W2 = 75 * MiB;
constexpr size_t WS_LIST = 107 * MiB;
constexpr size_t WS_TOKW = 115 * MiB;
constexpr size_t WS_TOKS = 115 * MiB + 512 * 1024;
constexpr size_t WS_H = 116 * MiB;
constexpr size_t WS_Y = 244 * MiB;
constexpr size_t WS_PROJ = 372 * MiB;
constexpr size_t WS_ACT = 372 * MiB;
constexpr size_t WS_YBUF = 508 * MiB;
constexpr size_t WS_QC = 820 * MiB;
constexpr size_t WS_KV = 884 * MiB;
constexpr size_t WS_X1B = 884 * MiB;
constexpr size_t WS_END = 1012 * MiB;
constexpr int CW_CNT = 0;
constexpr int CW_Q = 64;
constexpr int CW_BAR = 8192;

constexpr int RING_BYTES = 131072;
constexpr int MISC_OFF = RING_BYTES;
constexpr int EPI_SCR = MISC_OFF + 16384;
constexpr int LDS_BYTES = 163840;

__device__ __forceinline__ unsigned cvtpk(float lo, float hi) { f32x2 v = {lo, hi}; bf16x2_t b = __builtin_convertvector(v, bf16x2_t); return __builtin_bit_cast(unsigned, b); }
__device__ __forceinline__ float dot2bf(unsigned a, unsigned b, float acc) {
    asm("" : "+v"(a));
    return __builtin_amdgcn_fdot2_f32_bf16(__builtin_bit_cast(bf16x2_t, a), __builtin_bit_cast(bf16x2_t, b), acc, false); }
__device__ __forceinline__ float bf2f(unsigned short x) { return __uint_as_float(((unsigned)x) << 16); }
__device__ __forceinline__ float bflo(unsigned x) { return __uint_as_float(x << 16); }
__device__ __forceinline__ float bfhi(unsigned x) { return __uint_as_float(x & 0xffff0000u); }
template <int CTRL> __device__ __forceinline__ float dppf(float x) { return __builtin_bit_cast(float, __builtin_amdgcn_update_dpp(0, __builtin_bit_cast(int, x), CTRL, 0xf, 0xf, false)); }
__device__ __forceinline__ void swap32(float a, float b, float& r0, float& r1) { auto r = __builtin_amdgcn_permlane32_swap(__builtin_bit_cast(unsigned, a), __builtin_bit_cast(unsigned, b), false, false);
    unsigned u0 = r[0], u1 = r[1]; asm("" : "+v"(u0), "+v"(u1)); r0 = __builtin_bit_cast(float, u0); r1 = __builtin_bit_cast(float, u1); }
__device__ __forceinline__ void swap16(float a, float b, float& r0, float& r1) { auto r = __builtin_amdgcn_permlane16_swap(__builtin_bit_cast(unsigned, a), __builtin_bit_cast(unsigned, b), false, false);
    unsigned u0 = r[0], u1 = r[1]; asm("" : "+v"(u0), "+v"(u1)); r0 = __builtin_bit_cast(float, u0); r1 = __builtin_bit_cast(float, u1); }
__device__ __forceinline__ float sum_x32(float a, float b) { float r0, r1; swap32(a, b, r0, r1); return r0 + r1; }
__device__ __forceinline__ float sum_x16(float a, float b) { float r0, r1; swap16(a, b, r0, r1); return r0 + r1; }
__device__ __forceinline__ float row_sum(float v) { v += dppf<0xB1>(v); v += dppf<0x4E>(v); v += dppf<0x141>(v); v += dppf<0x140>(v); return v; }
__device__ __forceinline__ float wave_sum(float v) { v = row_sum(v); v = sum_x16(v, v); return sum_x32(v, v); }
__device__ __forceinline__ float fast_exp2(float x) { return __builtin_amdgcn_exp2f(x); }
__device__ __forceinline__ float fast_rcp(float x) { return __builtin_amdgcn_rcpf(x); }
__device__ __forceinline__ float sigmoidf_(float x) { return fast_rcp(1.f + fast_exp2(-x * LOG2E)); }
__device__ __forceinline__ float siluf_(float x) { return x * sigmoidf_(x); }

namespace pg8 {
constexpr int BM = 256, BK = 64, HALF = 128, HTB = HALF * BK * 2, STAGE_BYTES = 8 * HTB;
__host__ __device__ __forceinline__ int lds_byte(int r, int c) { const int st = (r >> 4) * 2 + (c >> 5), rr = r & 15, cc = c & 31, ob = rr * 64 + cc * 2; return st * 1024 + (ob ^ (((ob >> 9) & 1) << 5)); }
__host__ __device__ __forceinline__ void stage_rc(int b, int& R, int& C) { const int st = b / 1024, sb = b % 1024, swz = sb ^ (((sb >> 9) & 1) << 5); R = (st >> 1) * 16 + swz / 64; C = (st & 1) * 32 + (swz % 64) / 2; }
__host__ __device__ __forceinline__ int perm32(int rho) { const int n = rho >> 4, i = rho & 15; return 8 * (i >> 2) + 4 * n + (i & 3); }

template <int STRICT, int LAX> __device__ __forceinline__ void wait_v_sel(int sel) {
    asm volatile("s_cmp_lg_u32 %0, 0\n\ts_cbranch_scc1 1f\n\ts_waitcnt vmcnt(%1)\n1:\n\ts_waitcnt vmcnt(%2)" :: "s"(sel), "n"(STRICT), "n"(LAX) : "scc", "memory"); }
template <int N> __device__ __forceinline__ void wait_v() { asm volatile("s_waitcnt vmcnt(%0)" :: "n"(N) : "memory"); }
struct Unit { int pm, pn, e, r0, nrows, slot; };
struct Gemm { const bf16* A; const bf16* Bt; int K; };

template <class Epi, class Sched>
__device__ __forceinline__ void gemm_phase(LAS unsigned char* lds, const Gemm g, const Sched& S, const Epi& E, const int tid) {
    const int  wid = __builtin_amdgcn_readfirstlane(tid >> 6), lane = tid & 63, wr = wid >> 2, wc = wid & 3, fr = lane & 15, fq = lane >> 4;
    const int K = g.K, nt = K / BK;
    int RA[2], CA[2]; unsigned voffB[2];
#pragma unroll
    for (int i = 0; i < 2; ++i) { int R, C; stage_rc(tid * 16 + i * 8192, R, C); const int Rb = Epi::PERM ? (64 * (R >> 5) + perm32(R & 31)) : R;
        RA[i] = R; CA[i] = C; voffB[i] = (unsigned)(Rb * K + C) * 2u; }
    const size_t kstep = (size_t)(BK * 2);
    const size_t hstep = (size_t)(Epi::PERM ? 32 : HALF) * K * 2;
    const size_t tstep = (size_t)BM * K * 2;
    const unsigned ldsw = (unsigned)wid * 1024u;
    const int aoff = lds_byte(wr * 64 + fr, fq * 8), boff = lds_byte(wc * 32 + fr, fq * 8);
#define PG8_SA(b, h) (((b) * 2 + (h)) * HTB)
#define PG8_SB(b, h) ((4 + (b) * 2 + (h)) * HTB)
#define PG8_STAGE(bufoff, gbase, voff) do { _Pragma("unroll") for (int _i = 0; _i < 2; ++_i) \
        __builtin_amdgcn_global_load_lds((const unsigned*)((const char*)(gbase) + (voff)[_i]), (LAS unsigned*)(lds + (bufoff) + ldsw + _i * 8192), 16, 0, 0); } while (0)
#define PG8_LDA(dst, b, h) do { _Pragma("unroll") for (int m = 0; m < 4; ++m) _Pragma("unroll") for (int k = 0; k < 2; ++k) dst[m][k] = *(const LAS bf16x8*)(lds + PG8_SA(b, h) + aoff + m * 2048 + k * 1024); } while (0)
#define PG8_LDB(dst, b, h) do { _Pragma("unroll") for (int n = 0; n < 2; ++n) _Pragma("unroll") for (int k = 0; k < 2; ++k) dst[n][k] = *(const LAS bf16x8*)(lds + PG8_SB(b, h) + boff + n * 2048 + k * 1024); } while (0)
#define PG8_MMA(ai, bj, At, Bt) do { __builtin_amdgcn_s_setprio(1); _Pragma("unroll") for (int m = 0; m < 4; ++m) _Pragma("unroll") for (int n = 0; n < 2; ++n) _Pragma("unroll") for (int k = 0; k < 2; ++k) \
        acc[ai][bj][m][n] = __builtin_amdgcn_mfma_f32_16x16x32_bf16(Bt[n][k], At[m][k], acc[ai][bj][m][n], 0, 0, 0); __builtin_amdgcn_s_setprio(0); } while (0)
#define PG8_WAIT_V(n) asm volatile("s_waitcnt vmcnt(" #n ")" ::: "memory")
#define PG8_WAIT_L(n) asm volatile("s_waitcnt lgkmcnt(" #n ")" ::: "memory")
#define PG8_BAR __builtin_amdgcn_s_barrier()
#define PG8_SCHED __builtin_amdgcn_sched_barrier(0)
#define PG8_AOFF(dst, u) do { _Pragma("unroll") for (int _h = 0; _h < 2; ++_h) _Pragma("unroll") for (int _i = 0; _i < 2; ++_i) \
        dst[_h][_i] = ((unsigned)S.arow(u, _h * HALF + RA[_i]) * (unsigned)K + (unsigned)CA[_i]) * 2u; } while (0)
    Unit cur, nxt; int ui = 0;
    if (!S.next(0, cur)) return;
    f32x4 acc[2][2][4][2];
#pragma unroll
    for (int a = 0; a < 2; ++a)
#pragma unroll
        for (int b = 0; b < 2; ++b)
#pragma unroll
            for (int m = 0; m < 4; ++m)
#pragma unroll
                for (int n = 0; n < 2; ++n) acc[a][b][m][n] = (f32x4){0.f, 0.f, 0.f, 0.f};
    bf16x8 At[4][2], B0[2][2], B1[2][2];
    unsigned cv[2][2], nv[2][2];
    PG8_AOFF(cv, cur);
    const char* Ab = (const char*)g.A;
    const char* cB = (const char*)g.Bt + (size_t)cur.pn * tstep;
    {
        PG8_STAGE(PG8_SB(0, 0), cB, voffB); PG8_STAGE(PG8_SB(0, 1), cB + hstep, voffB); PG8_STAGE(PG8_SA(0, 0), Ab, cv[0]); PG8_STAGE(PG8_SA(0, 1), Ab, cv[1]);
        if (wr == 1) PG8_BAR;
        PG8_WAIT_V(2); PG8_BAR;
        PG8_STAGE(PG8_SB(1, 0), cB + kstep, voffB); PG8_STAGE(PG8_SA(1, 0), Ab + kstep, cv[0]); PG8_STAGE(PG8_SB(1, 1), cB + hstep + kstep, voffB);
        PG8_WAIT_V(6); PG8_BAR;
    }
    for (;;) {
        const bool has_next = S.next(ui + 1, nxt);
        if (has_next) { PG8_AOFF(nv, nxt); } else {
#pragma unroll
            for (int _h = 0; _h < 2; ++_h)
#pragma unroll
                for (int _i = 0; _i < 2; ++_i) nv[_h][_i] = cv[_h][_i]; }
        const char* nB = has_next ? (const char*)g.Bt + (size_t)nxt.pn * tstep : cB;
        for (int t = 0; t < nt; t += 2) {
            const bool last = (t == nt - 2);
            const int relax = __builtin_amdgcn_readfirstlane(((t == 0) && (ui > 0)) ? 1 : 0);
            const char* a1 = Ab + (size_t)(t + 1) * kstep;
            const char* a2 = last ? Ab : Ab + (size_t)(t + 2) * kstep; const char* b2 = last ? nB : cB + (size_t)(t + 2) * kstep;
            const char* a3 = a2 + kstep; const char* b3 = b2 + kstep;
            unsigned o2[2][2];
#pragma unroll
            for (int _h = 0; _h < 2; ++_h)
#pragma unroll
                for (int _i = 0; _i < 2; ++_i) o2[_h][_i] = last ? nv[_h][_i] : cv[_h][_i];
            PG8_LDB(B0, 0, 0); PG8_LDB(B1, 0, 1); PG8_SCHED; PG8_LDA(At, 0, 0); PG8_STAGE(PG8_SA(1, 1), a1, cv[1]);
            wait_v_sel<8, 8 + Epi::NST>(relax);
            PG8_WAIT_L(0); PG8_BAR; PG8_MMA(0, 0, At, B0); PG8_MMA(0, 1, At, B1); PG8_BAR; PG8_SCHED;
            PG8_LDA(At, 0, 1); PG8_STAGE(PG8_SB(0, 0), b2, voffB); PG8_STAGE(PG8_SB(0, 1), b2 + hstep, voffB); PG8_STAGE(PG8_SA(0, 0), a2, o2[0]);
            wait_v_sel<8, 8 + Epi::NST>(relax);
            PG8_WAIT_L(0); PG8_BAR; PG8_MMA(1, 0, At, B0); PG8_MMA(1, 1, At, B1); PG8_BAR; PG8_SCHED;
            PG8_LDB(B0, 1, 0); PG8_LDB(B1, 1, 1); PG8_SCHED; PG8_LDA(At, 1, 0); PG8_STAGE(PG8_SA(0, 1), a2, o2[1]);
            PG8_WAIT_V(8); PG8_WAIT_L(0); PG8_BAR; PG8_MMA(0, 0, At, B0); PG8_MMA(0, 1, At, B1); PG8_BAR; PG8_SCHED;
            PG8_LDA(At, 1, 1); PG8_STAGE(PG8_SB(1, 0), b3, voffB); PG8_STAGE(PG8_SB(1, 1), b3 + hstep, voffB); PG8_STAGE(PG8_SA(1, 0), a3, o2[0]);
            PG8_WAIT_V(8); PG8_WAIT_L(0); PG8_BAR; PG8_MMA(1, 0, At, B0); PG8_MMA(1, 1, At, B1); PG8_BAR; PG8_SCHED;
        }
        if (wr == 0) PG8_BAR;
        { int le; asm volatile("v_mbcnt_lo_u32_b32 %0, -1, 0\n\tv_mbcnt_hi_u32_b32 %0, -1, %0" : "=v"(le));
          E(acc, cur, wr, wc, le & 15, le >> 4); }
        if (!has_next) break;
#pragma unroll
        for (int a = 0; a < 2; ++a)
#pragma unroll
            for (int b = 0; b < 2; ++b)
#pragma unroll
                for (int m = 0; m < 4; ++m)
#pragma unroll
                    for (int n = 0; n < 2; ++n) acc[a][b][m][n] = (f32x4){0.f, 0.f, 0.f, 0.f};
        cur = nxt; cB = nB; ++ui;
#pragma unroll
        for (int _h = 0; _h < 2; ++_h)
#pragma unroll
            for (int _i = 0; _i < 2; ++_i) cv[_h][_i] = nv[_h][_i];
        if (wr == 1) PG8_BAR;
    }
    PG8_WAIT_V(0);
    PG8_BAR;
#undef PG8_SA
#undef PG8_SB
#undef PG8_STAGE
#undef PG8_LDA
#undef PG8_LDB
#undef PG8_MMA
#undef PG8_WAIT_V
#undef PG8_WAIT_L
#undef PG8_BAR
#undef PG8_SCHED
#undef PG8_AOFF
}

struct DenseOrder {
    int nM, nN, nwg, G, c; unsigned long long cperm;
    __device__ void init(int M, int N, int G_, int c_, unsigned long long cperm_ = 0ull) { nM = M / BM; nN = N / BM; nwg = nM * nN; G = G_; c = c_; cperm = cperm_; }
    __device__ __forceinline__ bool next(int i, Unit& u) const {
        const long L = (long)i * G + c; if (L >= nwg) return false;
        int wgid = (int)L; { const int q = nwg / 8, r = nwg % 8, xcd = wgid % 8, off = wgid / 8; wgid = (xcd < r ? xcd * (q + 1) : r * (q + 1) + (xcd - r) * q) + off; }
        const int nig = 8 * nN, gid = wgid / nig, fm = gid * 8, gsz = (nM - fm) < 8 ? (nM - fm) : 8;
        u.pm = fm + ((wgid % nig) % gsz); u.pn = (wgid % nig) / gsz; if (cperm) u.pn = (int)((cperm >> (4 * u.pn)) & 15ull);
        u.e = 0; u.r0 = 0; u.nrows = BM; u.slot = 0; return true;
    }
    __device__ __forceinline__ int arow(const Unit& u, int r) const { return u.pm * BM + r; }
};
__device__ __forceinline__ void xpose128(LAS unsigned char* scr, int fr, int fq, const u32x4& w0, const u32x4& w1, u32x4& rA, u32x4& rB) {
    const int sw = fr & 7;
    *(LAS u32x4*)(scr + fr * 128 + ((fq ^ sw) << 4)) = w0;
    *(LAS u32x4*)(scr + fr * 128 + (((4 + fq) ^ sw) << 4)) = w1;
    asm volatile("" ::: "memory");
    const int l = fr + 16 * fq, r = l >> 3, c = l & 7;
    rA = *(const LAS u32x4*)(scr + r * 128 + ((c ^ r) << 4));
    rB = *(const LAS u32x4*)(scr + 1024 + r * 128 + ((c ^ r) << 4));
    asm volatile("" ::: "memory");
}
}

#define XB_TMO      128
#define XB_XCNT(j)  (256  + 64 * (j))
#define XB_XSUB(j)  (1280 + 64 * (j))
#define XB_XGEN(j)  (2304 + 64 * (j))
#define XB_TOP      3328
#define XB_TOPGEN   3392
#define XCD_BAR_WORDS 3456
#define XB_SPIN_CAP (1u << 18)
__device__ __forceinline__ unsigned xb_ld(unsigned* p)              { return __hip_atomic_load(p, __ATOMIC_RELAXED, __HIP_MEMORY_SCOPE_AGENT); }
__device__ __forceinline__ unsigned xb_add(unsigned* p, unsigned v) { return __hip_atomic_fetch_add(p, v, __ATOMIC_RELAXED, __HIP_MEMORY_SCOPE_AGENT); }
__device__ __forceinline__ unsigned xb_xcc_id() { return (unsigned)__builtin_amdgcn_s_getreg((3 << 11) | 20) & 0xFu; }
#define XB_SPIN(cond, bar) do { unsigned _sp = 0; while (cond) { __builtin_amdgcn_s_sleep(1); \
    if ((++_sp & 255u) == 0u) { if (xb_ld(&(bar)[XB_TMO])) break; if (_sp > XB_SPIN_CAP) { atomicAdd(&(bar)[XB_TMO], 1u); break; } } } } while (0)
struct XcdBarrier { unsigned* bar; unsigned x; volatile LAS unsigned* st; };
__device__ __forceinline__ XcdBarrier xcd_barrier_post(unsigned* bar, volatile LAS unsigned* st) {
    XcdBarrier b; b.bar = bar; b.x = xb_xcc_id(); b.st = st;
    if (threadIdx.x == 0) (void)xb_add(&bar[XB_XCNT(b.x)], 1u);
    return b;
}
__device__ __forceinline__ void xcd_barrier_complete(unsigned* bar, unsigned x, unsigned& nloc, unsigned& nx) {
    const unsigned G = gridDim.x * gridDim.y * gridDim.z;
    unsigned sum, cnt, mine, sp = 0u;
    for (;;) {
        sum = 0u; cnt = 0u; mine = 0u;
#pragma unroll
        for (unsigned j = 0; j < 16; ++j) { const unsigned c = xb_ld(&bar[XB_XCNT(j)]); sum += c; cnt += (c > 0u) ? 1u : 0u; mine = (j == x) ? c : mine; }
        if (sum == G) break;
        __builtin_amdgcn_s_sleep(1);
        if ((++sp & 255u) == 0u) { if (xb_ld(&bar[XB_TMO])) break; if (sp > XB_SPIN_CAP) { atomicAdd(&bar[XB_TMO], 1u); break; } }
    }
    nloc = mine > 0u ? mine : 1u; nx = cnt > 0u ? cnt : 1u;
}
__device__ __forceinline__ void xcd_barrier(const XcdBarrier& b) {
    asm volatile("s_waitcnt vmcnt(0)" ::: "memory");
    __syncthreads();
    if (threadIdx.x == 0) {
        unsigned* bar = b.bar;
        __builtin_amdgcn_s_waitcnt(0);
        unsigned nloc = b.st[0], nx = b.st[1];
        if (nloc == 0u) { xcd_barrier_complete(bar, b.x, nloc, nx); b.st[0] = nloc; b.st[1] = nx; }
        const unsigned old = xb_add(&bar[XB_XSUB(b.x)], 1u);
        const unsigned gen = old / nloc;
        if (old + 1u == (gen + 1u) * nloc) {
            __builtin_amdgcn_fence(__ATOMIC_RELEASE, "agent");
            asm volatile("s_waitcnt vmcnt(0)" ::: "memory");
            const unsigned og = xb_add(&bar[XB_TOP], 1u);
            const unsigned tg = og / nx;
            if (og + 1u == (tg + 1u) * nx) xb_add(&bar[XB_TOPGEN], 1u);
            else XB_SPIN(xb_ld(&bar[XB_TOPGEN]) == tg, bar);
            __builtin_amdgcn_fence(__ATOMIC_ACQUIRE, "agent");
            asm volatile("s_waitcnt vmcnt(0)" ::: "memory");
        } else {
            XB_SPIN(xb_ld(&bar[XB_TOPGEN]) == gen, bar);
            __builtin_amdgcn_fence(__ATOMIC_ACQUIRE, "agent");
            asm volatile("s_waitcnt vmcnt(0)" ::: "memory");
        }
    }
    __syncthreads();
}

struct Args { const float* in[24]; float* out; unsigned char* ws; };
struct Frame {
    LAS unsigned char* lds;
    int tid, lane, wave, vcu, G;
};

template <int MODE>
__device__ __forceinline__ void p0_transpose_item(const float* W, int K, int N, bf16* WT, LAS float* scr, int item, int lane) {
    const int nblk = N / 32, kb = item / nblk, nb = item % nblk, k0 = 64 * kb, n0 = 32 * nb;
    f32x4 v[8];
#pragma unroll
    for (int i = 0; i < 8; ++i) v[i] = *(const f32x4*)(W + (size_t)(k0 + 8 * i + (lane >> 3)) * N + n0 + 4 * (lane & 7));
#pragma unroll
    for (int i = 0; i < 8; ++i) { LAS float* d = scr + (8 * i + (lane >> 3)) * 33 + 4 * (lane & 7); d[0] = v[i].x; d[1] = v[i].y; d[2] = v[i].z; d[3] = v[i].w; }
    asm volatile("s_waitcnt lgkmcnt(0)" ::: "memory");
    const int c = lane & 7;
#pragma unroll
    for (int j = 0; j < 4; ++j) { const int n = (lane >> 3) + 8 * j; const LAS float* s = scr + (8 * c) * 33 + n;
        u32x4 o; o.x = cvtpk(s[0 * 33], s[1 * 33]); o.y = cvtpk(s[2 * 33], s[3 * 33]); o.z = cvtpk(s[4 * 33], s[5 * 33]); o.w = cvtpk(s[6 * 33], s[7 * 33]);
        const int f = n0 + n; int row = f;
        if (MODE == 1) row = ((f >> 7) << 8) + (((f >> 5) & 3) << 6) + (f & 31);
        if (MODE == 2) row = ((f >> 7) << 8) + (((f >> 5) & 3) << 6) + 32 + (f & 31);
        *(u32x4*)(WT + (size_t)row * K + k0 + 8 * c) = o; }
    asm volatile("s_waitcnt lgkmcnt(0)" ::: "memory");
}

__device__ __forceinline__ void p0_prologue(const Frame& F, const Args& a) {
    unsigned char* ws = a.ws;
    if (F.vcu < 96) {
        LAS float* cact = (LAS float*)F.lds;
        LAS float* red = (LAS float*)(F.lds + 32768);
        const float* c = a.in[1];
        for (int i = F.tid; i < 8192; i += NTHREADS) { const int b = i >> 10, k = i & 1023; cact[k * 8 + b] = siluf_(c[i]); }
        __syncthreads();
        const int j = F.vcu * 64 + F.lane;
        const float* w = a.in[2] + (size_t)(128 * F.wave) * 6144 + j;
        float acc[8];
#pragma unroll
        for (int b = 0; b < 8; ++b) acc[b] = 0.f;
#pragma unroll 64
        for (int k = 0; k < 128; ++k) { const float wv = w[(size_t)k * 6144]; const LAS float* cp = cact + (128 * F.wave + k) * 8; const f32x4 c0 = *(const LAS f32x4*)cp, c1 = *(const LAS f32x4*)(cp + 4);
            acc[0] += c0.x * wv; acc[1] += c0.y * wv; acc[2] += c0.z * wv; acc[3] += c0.w * wv; acc[4] += c1.x * wv; acc[5] += c1.y * wv; acc[6] += c1.z * wv; acc[7] += c1.w * wv; }
#pragma unroll
        for (int b = 0; b < 8; ++b) red[(F.wave * 8 + b) * 64 + F.lane] = acc[b];
        __syncthreads();
        { const int b = F.tid >> 6; float s = 0.f;
#pragma unroll
          for (int ww = 0; ww < 8; ++ww) s += red[(ww * 8 + b) * 64 + F.lane];
          ((float*)(ws + WS_MOD))[b * 6144 + j] = s + a.in[3][j]; }
        __syncthreads();
    }
    LAS float* scr = (LAS float*)(F.lds + F.wave * 16384);
    const int gw = F.vcu * NWAVES + F.wave, NGW = F.G * NWAVES;
    constexpr int I_IN = 16 * 112, I_OUT = 16 * 32;
    constexpr int NITEMS = I_IN + I_OUT;
    bf16* win = (bf16*)(ws + WS_WIN); bf16* wout = (bf16*)(ws + WS_WOUT);
    for (int it = NITEMS - 1 - gw; it >= 0; it -= NGW) {
        int r = it;
        if (r < I_IN) { p0_transpose_item<0>(a.in[6], 1024, INW, win, scr, r, F.lane); continue; } r -= I_IN;
        p0_transpose_item<0>(a.in[15], 1024, 1024, wout, scr, r, F.lane);
    }
}

__device__ __forceinline__ void p0b_norm1(const Frame& F, const Args& a) {
    const float* x = a.in[0]; const float* ng = a.in[4]; const float* mod = (const float*)(a.ws + WS_MOD);
    bf16* H = (bf16*)(a.ws + WS_H);
    LAS unsigned char* lds = F.lds;
    constexpr int DEP = 8;
    const int rpb = (NTOK + F.G - 1) / F.G;
    const int r0 = F.vcu * rpb, r1 = (r0 + rpb < NTOK) ? r0 + rpb : NTOK;
    const int pair = F.wave & 3, niter = (rpb + 3) >> 2;
    LAS unsigned char* ring = lds + pair * (DEP * 4096);
    if (r0 >= NTOK) return;
    if (F.wave < 4) {
#define P0B_DMA(i_) do { int row_ = r0 + pair + 4 * (i_); if (row_ >= r1) row_ = r1 - 1; const float* src_ = x + (size_t)row_ * D + 4 * F.lane; \
        LAS unsigned char* dst_ = ring + ((i_) & (DEP - 1)) * 4096; \
        _Pragma("unroll") for (int j = 0; j < 4; ++j) __builtin_amdgcn_global_load_lds((const unsigned*)(src_ + 256 * j), (LAS unsigned*)(dst_ + 1024 * j), 16, 0, 0); } while (0)
#pragma unroll
        for (int i = 0; i < DEP - 1; ++i) P0B_DMA(i);
        for (int i = 0; i < niter; ++i) {
            asm volatile("s_waitcnt vmcnt(24)" ::: "memory");
            __builtin_amdgcn_s_barrier();
            P0B_DMA(i + DEP - 1);
        }
        asm volatile("s_waitcnt vmcnt(0)" ::: "memory");
#undef P0B_DMA
    } else {
        for (int i0 = 0; i0 < niter; ) {
            const int rowb = r0 + pair + 4 * i0, rc = rowb < r1 ? rowb : r1 - 1, b = rc >> 13;
            int i1 = ((((b + 1) << 13) - (r0 + pair)) + 3) >> 2; if (i1 > niter || rowb >= r1) i1 = niter;
            f32x4 ga[4], sha[4];
            { const f32x4* gp = (const f32x4*)ng + F.lane; const f32x4* shp = (const f32x4*)(mod + b * 6144) + F.lane; const f32x4* scp = (const f32x4*)(mod + b * 6144 + 1024) + F.lane;
#pragma unroll
              for (int j = 0; j < 4; ++j) { ga[j] = gp[64 * j] * (scp[64 * j] + 1.f); sha[j] = shp[64 * j]; } }
            for (int i = i0; i < i1; ++i) {
                __builtin_amdgcn_s_barrier();
                const int row = r0 + pair + 4 * i;
                const LAS unsigned char* src = ring + (i & (DEP - 1)) * 4096 + 16 * F.lane;
                f32x4 v[4];
#pragma unroll
                for (int j = 0; j < 4; ++j) v[j] = *(const LAS f32x4*)(src + 1024 * j);
                asm volatile("s_waitcnt lgkmcnt(0)" ::: "memory");
                if (row < r1) {
                    float s = 0.f;
#pragma unroll
                    for (int j = 0; j < 4; ++j) s += (v[j].x * v[j].x + v[j].y * v[j].y) + (v[j].z * v[j].z + v[j].w * v[j].w);
                    const float r = __builtin_amdgcn_rsqf(wave_sum(s) * (1.f / D) + EPS);
                    u32x2* o8 = (u32x2*)(H + (size_t)row * D) + F.lane;
#pragma unroll
                    for (int j = 0; j < 4; ++j) { const f32x4 y = v[j] * r * ga[j] + sha[j];
                        u32x2 o; o.x = cvtpk(y.x, y.y); o.y = cvtpk(y.z, y.w); o8[64 * j] = o; }
                }
            }
            i0 = i1;
        }
    }
}

struct EpiProj {
    static constexpr bool PERM = true;
    static constexpr int NST = 16;
    bf16* O; const float* lbraw;
    bf16* QC; bf16* KV;
    LAS unsigned char* scr;
    __device__ __forceinline__ void operator()(const f32x4 (&acc)[2][2][4][2], const pg8::Unit& u, int wr, int wc, int fr, int fq) const {
        const int seg = u.pn >> 1;
        const int col0 = u.pn * 256 + wc * 64 + 8 * fq;
        float lb[2][8];
        if (seg == 4) {
#pragma unroll
            for (int bj = 0; bj < 2; ++bj)
#pragma unroll
                for (int i = 0; i < 8; ++i) { const int k = col0 + bj * 32 + i - COL_FR; const float r0 = lbraw[k], r1 = lbraw[512 + k]; lb[bj][i] = fast_rcp(1.f + fast_exp2((r1 - r0) * LOG2E)); }
        }
        LAS unsigned char* ws_ = scr + (wr * 4 + wc) * 2048;
        const int l = fr + 16 * fq, r8 = l >> 3, c8 = l & 7;
        const int colT = u.pn * 256 + wc * 64 + 8 * c8, rowT = u.pm * 256 + wr * 64 + r8;
        u32x4 rq[2][2];
#pragma unroll
        for (int it = 0; it <= 8; ++it) {
            if (it < 8) { const int ai = it >> 2, m = it & 3; u32x4 w[2];
#pragma unroll
                for (int bj = 0; bj < 2; ++bj) { float v[8];
#pragma unroll
                    for (int i = 0; i < 4; ++i) { v[i] = acc[ai][bj][m][0][i]; v[4 + i] = acc[ai][bj][m][1][i]; }
                    if (seg == 0) {
#pragma unroll
                        for (int i = 0; i < 8; ++i) v[i] *= QSCALE;
                    } else if (seg == 3 || seg == 6) {
#pragma unroll
                        for (int i = 0; i < 8; ++i) v[i] = siluf_(v[i]);
                    } else if (seg == 4) {
#pragma unroll
                        for (int i = 0; i < 8; ++i) { const float lw = lb[bj][i]; v[i] = __builtin_amdgcn_logf(lw + (1.f - lw) * sigmoidf_(v[i])) * 0.6931471805599453f; }
                    }
                    w[bj].x = cvtpk(v[0], v[1]); w[bj].y = cvtpk(v[2], v[3]); w[bj].z = cvtpk(v[4], v[5]); w[bj].w = cvtpk(v[6], v[7]); }
                pg8::xpose128(ws_, fr, fq, w[0], w[1], rq[it & 1][0], rq[it & 1][1]); }
            if (it > 0) { const int ai = (it - 1) >> 2, m = (it - 1) & 3; const u32x4 rA = rq[(it - 1) & 1][0], rB = rq[(it - 1) & 1][1];
                const int row = rowT + ai * 128 + m * 16;
                if (seg < 3) {
                    const int c = colT & 511, hh = c >> 7, e = c & 127; const size_t tokrow = (size_t)((row >> 13) * 4 + hh) * SEQ + (row & (SEQ - 1));
                    if (seg == 0) { bf16* dst = QC + tokrow * 128 + e; *(u32x4*)dst = rA; *(u32x4*)(dst + 8 * 128) = rB; }
                    else { bf16* dst = KV + tokrow * 256 + (seg == 2 ? 128 : 0) + e; *(u32x4*)dst = rA; *(u32x4*)(dst + 8 * 256) = rB; }
                } else { bf16* rowp = O + (size_t)row * INW + colT; *(u32x4*)rowp = rA; *(u32x4*)(rowp + (size_t)8 * INW) = rB; } } }
    }
};

struct EpiRes1 {
    static constexpr bool PERM = true;
    static constexpr int NST = 16;
    const float* x; bf16* x1b; const float* mod;
    LAS unsigned char* scr;
    __device__ __forceinline__ void operator()(const f32x4 (&acc)[2][2][4][2], const pg8::Unit& u, int wr, int wc, int fr, int fq) const {
        const int b = (u.pm * 256) >> 13;
        const int col0 = u.pn * 256 + wc * 64 + 8 * fq;
        f32x4 gv[2][2];
#pragma unroll
        for (int bj = 0; bj < 2; ++bj)
#pragma unroll
            for (int n = 0; n < 2; ++n) gv[bj][n] = *(const f32x4*)(mod + b * 6144 + 2048 + col0 + bj * 32 + n * 4);
        LAS unsigned char* ws_ = scr + (wr * 4 + wc) * 2048;
        const int l = fr + 16 * fq, r8 = l >> 3, c8 = l & 7;
        const int colT = u.pn * 256 + wc * 64 + 8 * c8, rowT = u.pm * 256 + wr * 64 + r8;
        f32x4 xb[3][4];
#define RES1_LOAD(it) do { const size_t o_ = (size_t)(rowT + ((it) >> 2) * 128 + ((it) & 3) * 16) * D + colT; \
            xb[(it) % 3][0] = *(const f32x4*)(x + o_); xb[(it) % 3][1] = *(const f32x4*)(x + o_ + 4); xb[(it) % 3][2] = *(const f32x4*)(x + o_ + 8 * D); xb[(it) % 3][3] = *(const f32x4*)(x + o_ + 8 * D + 4); } while (0)
        RES1_LOAD(0); RES1_LOAD(1);
#pragma unroll
        for (int it = 0; it < 8; ++it) { const int ai = it >> 2, m = it & 3; const size_t off = (size_t)(rowT + ai * 128 + m * 16) * D + colT;
            if (it + 2 < 8) RES1_LOAD(it + 2);
            u32x4 w[2];
#pragma unroll
            for (int bj = 0; bj < 2; ++bj) { const f32x4 t0 = gv[bj][0] * acc[ai][bj][m][0], t1 = gv[bj][1] * acc[ai][bj][m][1];
                w[bj].x = cvtpk(t0.x, t0.y); w[bj].y = cvtpk(t0.z, t0.w); w[bj].z = cvtpk(t1.x, t1.y); w[bj].w = cvtpk(t1.z, t1.w); }
            u32x4 rA, rB; pg8::xpose128(ws_, fr, fq, w[0], w[1], rA, rB);
            const f32x4 xa0 = xb[it % 3][0], xa1 = xb[it % 3][1], xb0 = xb[it % 3][2], xb1 = xb[it % 3][3];
            u32x4 o;
            o.x = cvtpk(xa0.x + bflo(rA.x), xa0.y + bfhi(rA.x)); o.y = cvtpk(xa0.z + bflo(rA.y), xa0.w + bfhi(rA.y));
            o.z = cvtpk(xa1.x + bflo(rA.z), xa1.y + bfhi(rA.z)); o.w = cvtpk(xa1.z + bflo(rA.w), xa1.w + bfhi(rA.w));
            *(u32x4*)(x1b + off) = o;
            o.x = cvtpk(xb0.x + bflo(rB.x), xb0.y + bfhi(rB.x)); o.y = cvtpk(xb0.z + bflo(rB.y), xb0.w + bfhi(rB.y));
            o.z = cvtpk(xb1.x + bflo(rB.z), xb1.y + bfhi(rB.z)); o.w = cvtpk(xb1.z + bflo(rB.w), xb1.w + bfhi(rB.w));
            *(u32x4*)(x1b + off + 8 * D) = o; }
#undef RES1_LOAD
    }
};

constexpr int WC_ITEMS = 3 * 32 * 256, WC_CHUNKS = WC_ITEMS / (32 * 8);
typedef const __attribute__((address_space(1))) f32x4* gcf4p;
typedef __attribute__((address_space(1))) u32x4* gu4p;
__device__ __forceinline__ void wconv_load(const Args& a, f32x4 (&v)[8], int it, int lane) {
    const int m = it >> 13, r = it & 8191, e = r >> 8, blk = r & 255;
    const int N = m < 2 ? 512 : 1024, nb = m < 2 ? (blk & 15) : (blk & 31), kb = m < 2 ? (blk >> 4) : (blk >> 5);
    const float* p1 = a.in[20]; const float* p3 = a.in[21]; const float* p2 = a.in[22]; asm volatile("" : "+s"(p1), "+s"(p3), "+s"(p2));
    const float* W = (m == 0 ? p1 : m == 1 ? p3 : p2) + (size_t)e * (1024 * 512) + (size_t)(64 * kb + 8 * (lane >> 3)) * N + 32 * nb + 4 * (lane & 7);
#pragma unroll
    for (int i = 0; i < 8; ++i) v[i] = *(gcf4p)(W + (size_t)i * N);
}
__device__ __forceinline__ void wconv_store(const Args& a, const f32x4 (&v)[8], int it, int lane, LAS unsigned char* scr) {
    const int m = it >> 13, r = it & 8191, e = r >> 8, blk = r & 255;
    const int K = m < 2 ? 1024 : 512, nb = m < 2 ? (blk & 15) : (blk & 31), kb = m < 2 ? (blk >> 4) : (blk >> 5);
    bf16* q13 = (bf16*)(a.ws + WS_W13); bf16* q2 = (bf16*)(a.ws + WS_W2); asm volatile("" : "+s"(q13), "+s"(q2));
    bf16* WT = (m < 2 ? q13 + (size_t)e * (1024 * 1024) : q2 + (size_t)e * (1024 * 512)) + 64 * kb;
    const int kk = lane >> 3, nn = lane & 7;
#pragma unroll
    for (int h = 0; h < 2; ++h) {
#pragma unroll
        for (int jj = 0; jj < 2; ++jj) { const int j = 2 * h + jj;
            u32x4 o; o.x = cvtpk(v[0][j], v[1][j]); o.y = cvtpk(v[2][j], v[3][j]); o.z = cvtpk(v[4][j], v[5][j]); o.w = cvtpk(v[6][j], v[7][j]);
            *(LAS u32x4*)(scr + (8 * jj + nn) * 128 + ((kk ^ nn) << 4)) = o; }
        asm volatile("" ::: "memory");
#pragma unroll
        for (int p = 0; p < 2; ++p) { const int f = 32 * nb + 4 * kk + 2 * h + p;
            const u32x4 o = *(const LAS u32x4*)(scr + (8 * p + kk) * 128 + ((nn ^ kk) << 4));
            const int row = m < 2 ? ((f >> 7) << 8) + (((f >> 5) & 3) << 6) + (m == 1 ? 32 : 0) + (f & 31) : f;
            *(gu4p)(WT + (size_t)row * K + 8 * nn) = o; }
        asm volatile("" ::: "memory");
    }
}

constexpr int HG_RS_ = 272, HG_SCS = 144, HG_ARR = 64 * HG_RS_;
constexpr int HG_RAW = 0, HG_QT = 3 * HG_ARR, HG_KT = HG_QT + HG_ARR, HG_SC = HG_KT + HG_ARR, HG_SEG = HG_SC + 64 * HG_SCS, HG_EL = HG_SEG + 4096, HG_OUT = HG_EL + 512, HG_END = HG_OUT + HG_ARR;
static_assert(HG_END <= RING_BYTES, "hgrn LDS map");
__device__ __forceinline__ s16x4 tr16(const LAS unsigned char* p) { return __builtin_bit_cast(s16x4, __builtin_amdgcn_ds_read_tr16_b64_v4i16((LAS s16x4*)p)); }

__device__ __forceinline__ void hgrn_stream(const Frame& F, const Args& a, int bh) {
    const int b = bh >> 2, h = bh & 3;
    const bf16* P = (const bf16*)(a.ws + WS_PROJ) + (size_t)b * SEQ * INW;
    bf16* Y = (bf16*)(a.ws + WS_Y) + (size_t)b * SEQ * D + 512 + h * 128;
    LAS unsigned char* lds = F.lds;
    const int tid = F.tid, lane = F.lane, w = F.wave, l15 = lane & 15, g = lane >> 4;
    u32x4 pre[2][4][2], gsr[2];
    const __amdgpu_buffer_rsrc_t prs = __builtin_amdgcn_make_buffer_rsrc((void*)P, (short)0, SEQ * INW * 2, 0x00020000);
    const unsigned hg_voff = (unsigned)((tid >> 4) * INW + COL_QR + h * 128 + (tid & 15) * 8) * 2u;
#define HG_LOAD(st, c) do { _Pragma("unroll") for (int ar = 0; ar < 4; ++ar) _Pragma("unroll") for (int i = 0; i < 2; ++i) { \
        const char* bp_ = (const char*)P + ((size_t)((c) * 64 + 32 * i) * INW + 512 * ar) * 2; \
        asm volatile("global_load_dwordx4 %0, %1, %2" : "=v"(pre[st][ar][i]) : "v"(hg_voff), "s"(bp_) : "memory"); } } while (0)
#define HG_WAIT(st, N) asm volatile("s_waitcnt vmcnt(" #N ")" : "+v"(pre[st][0][0]), "+v"(pre[st][0][1]), "+v"(pre[st][1][0]), "+v"(pre[st][1][1]), \
        "+v"(pre[st][2][0]), "+v"(pre[st][2][1]), "+v"(pre[st][3][0]), "+v"(pre[st][3][1]) :: "memory")
#define HG_STORE(st) do { _Pragma("unroll") for (int ar = 0; ar < 3; ++ar) _Pragma("unroll") for (int i = 0; i < 2; ++i) { const int q = tid + 512 * i, row = q >> 4, ch = q & 15; \
        *(LAS u32x4*)(lds + HG_RAW + ar * HG_ARR + row * HG_RS_ + ch * 16) = pre[st][ar][i]; } gsr[0] = pre[st][3][0]; gsr[1] = pre[st][3][1]; } while (0)
    f32x4 S[8];
#pragma unroll
    for (int kb = 0; kb < 8; ++kb) S[kb] = (f32x4){0.f, 0.f, 0.f, 0.f};
    float ngc[8];
    { const float* ngp = a.in[14] + h * 128 + (tid & 15) * 8;
#pragma unroll
      for (int i = 0; i < 8; ++i) ngc[i] = ngp[i];
#pragma unroll
      for (int i = 0; i < 8; ++i) asm volatile("" : "+v"(ngc[i])); }
    HG_LOAD(0, 0);
    HG_WAIT(0, 0);
    HG_STORE(0);
    HG_LOAD(1, 1);
    static_assert((SEQ / 64) % 2 == 0, "chunk pairs");
    for (int c2 = 0; c2 < SEQ / 64; c2 += 2)
#pragma unroll
    for (int u = 0; u < 2; ++u) { const int c = c2 + u;
        __syncthreads();
        if (c + 2 < SEQ / 64) HG_LOAD(u, c + 2);
        float bl[8][2];
        {
            float run0 = 0.f, run1 = 0.f;
#pragma unroll
            for (int i = 0; i < 8; ++i) { const unsigned v = *(const LAS unsigned*)(lds + HG_RAW + HG_ARR + (8 * w + i) * HG_RS_ + 4 * lane);
                run0 += bflo(v); run1 += bfhi(v); bl[i][0] = run0; bl[i][1] = run1; }
            *(LAS f32x2*)(lds + HG_SEG + (w * 128 + 2 * lane) * 4) = (f32x2){run0, run1};
        }
        __syncthreads();
        {
            float off0 = 0.f, off1 = 0.f, tot0 = 0.f, tot1 = 0.f;
#pragma unroll
            for (int s = 0; s < 8; ++s) { const f32x2 v = *(const LAS f32x2*)(lds + HG_SEG + (s * 128 + 2 * lane) * 4); if (s < w) { off0 += v.x; off1 += v.y; } tot0 += v.x; tot1 += v.y; }
            if (w == 0) *(LAS f32x2*)(lds + HG_EL + 2 * lane * 4) = (f32x2){fast_exp2(tot0 * LOG2E), fast_exp2(tot1 * LOG2E)};
#pragma unroll
            for (int i = 0; i < 8; ++i) { const int t = 8 * w + i;
                const unsigned lfv = *(const LAS unsigned*)(lds + HG_RAW + HG_ARR + t * HG_RS_ + 4 * lane);
                const unsigned qv = *(const LAS unsigned*)(lds + HG_RAW + t * HG_RS_ + 4 * lane);
                const float b0 = bl[i][0] + off0, b1 = bl[i][1] + off1;
                const float e0 = fast_exp2(b0 * LOG2E), e1 = fast_exp2(b1 * LOG2E);
                const float k0 = 1.f - fast_exp2(bflo(lfv) * LOG2E), k1 = 1.f - fast_exp2(bfhi(lfv) * LOG2E);
                *(LAS unsigned*)(lds + HG_QT + t * HG_RS_ + 4 * lane) = cvtpk(bflo(qv) * e0, bfhi(qv) * e1);
                *(LAS unsigned*)(lds + HG_KT + t * HG_RS_ + 4 * lane) = cvtpk(k0 * fast_rcp(e0), k1 * fast_rcp(e1)); }
        }
        __syncthreads();
#pragma unroll
        for (int i = 0; i < 2; ++i) { const int tile = 2 * w + i, tb = tile >> 2, sb = tile & 3;
            f32x4 sc = (f32x4){0.f, 0.f, 0.f, 0.f};
#pragma unroll
            for (int ks = 0; ks < 4; ++ks) { const bf16x8 af = *(const LAS bf16x8*)(lds + HG_QT + (16 * tb + l15) * HG_RS_ + (32 * ks + 8 * g) * 2);
                const bf16x8 bfr = *(const LAS bf16x8*)(lds + HG_KT + (16 * sb + l15) * HG_RS_ + (32 * ks + 8 * g) * 2);
                sc = __builtin_amdgcn_mfma_f32_16x16x32_bf16(af, bfr, sc, 0, 0, 0); }
#pragma unroll
            for (int r = 0; r < 4; ++r) { const int t = 16 * tb + 4 * g + r, s = 16 * sb + l15; const float v = (s <= t) ? sc[r] : 0.f;
                *(LAS unsigned short*)(lds + HG_SC + t * HG_SCS + s * 2) = (unsigned short)(cvtpk(v, 0.f) & 0xffffu); } }
        __syncthreads();
        bf16x8 vf[2];
#pragma unroll
        for (int ss = 0; ss < 2; ++ss) { const LAS unsigned char* vp = lds + HG_RAW + 2 * HG_ARR + (32 * ss + 8 * g + (l15 >> 2)) * HG_RS_ + (16 * w + 4 * (l15 & 3)) * 2;
            const s16x4 lo = tr16(vp), hi = tr16(vp + 4 * HG_RS_); vf[ss] = (bf16x8){lo[0], lo[1], lo[2], lo[3], hi[0], hi[1], hi[2], hi[3]}; }
        f32x4 o[4];
        {
            bf16x8 sf[4];
#pragma unroll
            for (int ks = 0; ks < 4; ++ks) { u32x4 t4; t4.x = cvtpk(S[2 * ks][0], S[2 * ks][1]); t4.y = cvtpk(S[2 * ks][2], S[2 * ks][3]); t4.z = cvtpk(S[2 * ks + 1][0], S[2 * ks + 1][1]); t4.w = cvtpk(S[2 * ks + 1][2], S[2 * ks + 1][3]);
                sf[ks] = __builtin_bit_cast(bf16x8, t4); }
#pragma unroll
            for (int tb = 0; tb < 4; ++tb) { f32x4 acc = (f32x4){0.f, 0.f, 0.f, 0.f};
#pragma unroll
                for (int ks = 0; ks < 4; ++ks) { const LAS unsigned char* qp = lds + HG_QT + (16 * tb + l15) * HG_RS_ + (32 * ks + 4 * g) * 2;
                    const u32x2 q0 = *(const LAS u32x2*)qp, q1 = *(const LAS u32x2*)(qp + 32);
                    const u32x4 q4 = (u32x4){q0.x, q0.y, q1.x, q1.y};
                    acc = __builtin_amdgcn_mfma_f32_16x16x32_bf16(__builtin_bit_cast(bf16x8, q4), sf[ks], acc, 0, 0, 0); }
#pragma unroll
                for (int ss = 0; ss < 2; ++ss) { const bf16x8 af = *(const LAS bf16x8*)(lds + HG_SC + (16 * tb + l15) * HG_SCS + (32 * ss + 8 * g) * 2);
                    acc = __builtin_amdgcn_mfma_f32_16x16x32_bf16(af, vf[ss], acc, 0, 0, 0); }
                o[tb] = acc; }
        }
#pragma unroll
        for (int kb = 0; kb < 8; ++kb) {
#pragma unroll
            for (int ss = 0; ss < 2; ++ss) { const LAS unsigned char* kp = lds + HG_KT + (32 * ss + 8 * g + (l15 >> 2)) * HG_RS_ + (16 * kb + 4 * (l15 & 3)) * 2;
                const s16x4 lo = tr16(kp), hi = tr16(kp + 4 * HG_RS_); const bf16x8 af = (bf16x8){lo[0], lo[1], lo[2], lo[3], hi[0], hi[1], hi[2], hi[3]};
                S[kb] = __builtin_amdgcn_mfma_f32_16x16x32_bf16(af, vf[ss], S[kb], 0, 0, 0); }
            const f32x4 el = *(const LAS f32x4*)(lds + HG_EL + (16 * kb + 4 * g) * 4);
            S[kb] = S[kb] * el; }
#pragma unroll
        for (int tb = 0; tb < 4; ++tb)
#pragma unroll
            for (int r = 0; r < 4; ++r) *(LAS unsigned short*)(lds + HG_OUT + (16 * tb + 4 * g + r) * HG_RS_ + (16 * w + l15) * 2) = (unsigned short)(cvtpk(o[tb][r], 0.f) & 0xffffu);
        __syncthreads();
#pragma unroll
        for (int i = 0; i < 2; ++i) { const int q = tid + 512 * i, row = q >> 4, ch = q & 15;
            const u32x4 ov = *(const LAS u32x4*)(lds + HG_OUT + row * HG_RS_ + ch * 16);
            float x[8]; x[0] = bflo(ov.x); x[1] = bfhi(ov.x); x[2] = bflo(ov.y); x[3] = bfhi(ov.y); x[4] = bflo(ov.z); x[5] = bfhi(ov.z); x[6] = bflo(ov.w); x[7] = bfhi(ov.w);
            float ss = 0.f;
#pragma unroll
            for (int j = 0; j < 8; ++j) ss += x[j] * x[j];
            ss = row_sum(ss);
            const float rr = __builtin_amdgcn_rsqf(ss * (1.f / 128.f) + EPS);
            const u32x4 gv = gsr[i];
            u32x4 yo;
            yo.x = cvtpk(x[0] * rr * ngc[0] * bflo(gv.x), x[1] * rr * ngc[1] * bfhi(gv.x)); yo.y = cvtpk(x[2] * rr * ngc[2] * bflo(gv.y), x[3] * rr * ngc[3] * bfhi(gv.y));
            yo.z = cvtpk(x[4] * rr * ngc[4] * bflo(gv.z), x[5] * rr * ngc[5] * bfhi(gv.z)); yo.w = cvtpk(x[6] * rr * ngc[6] * bflo(gv.w), x[7] * rr * ngc[7] * bfhi(gv.w));
            *(u32x4*)(Y + (size_t)(c * 64 + row) * D + ch * 8) = yo; }
        if (c + 1 < SEQ / 64) { if (c + 2 < SEQ / 64) HG_WAIT(u ^ 1, 10); else HG_WAIT(u ^ 1, 0); HG_STORE(u ^ 1); }
    }
    __syncthreads();
#undef HG_LOAD
#undef HG_WAIT
#undef HG_STORE
}

constexpr int AT_BUF = 32768, AT_LUT = MISC_OFF + 4096, AT_WS = MISC_OFF + 6144, AT_TKT = MISC_OFF + 8192;
__device__ __forceinline__ int crow(int r, int hi) { return (r & 3) + 8 * (r >> 2) + 4 * hi; }
__device__ __forceinline__ int t5_bucket(int n) {
    if (n < 16) return n;
    int b = 16;
    b += (n >= 19); b += (n >= 21); b += (n >= 24); b += (n >= 27); b += (n >= 31); b += (n >= 35); b += (n >= 40); b += (n >= 46);
    b += (n >= 52); b += (n >= 59); b += (n >= 67); b += (n >= 77); b += (n >= 87); b += (n >= 99); b += (n >= 113);
    return b;
}
__device__ __forceinline__ float fmax_nc(float x, float y) { return __builtin_amdgcn_fmed3f(x, y, INFINITY); }
#define AT_SB() __builtin_amdgcn_sched_barrier(0)

__device__ __forceinline__ void at_qk(f32x16& p0, f32x16& p1, const LAS unsigned char* kb, const bf16x8 (&qf)[4]) {
    bf16x8 kf[8];
#pragma unroll
    for (int d0 = 0; d0 < 4; ++d0) { kf[2 * d0] = *(const LAS bf16x8*)(kb + d0 * 2048); kf[2 * d0 + 1] = *(const LAS bf16x8*)(kb + d0 * 2048 + 512); }
#pragma unroll
    for (int r = 0; r < 16; ++r) { p0[r] = 0.f; p1[r] = 0.f; }
#pragma unroll
    for (int d0 = 0; d0 < 4; ++d0) { p0 = __builtin_amdgcn_mfma_f32_32x32x16_bf16(kf[2 * d0], qf[d0], p0, 0, 0, 0); p1 = __builtin_amdgcn_mfma_f32_32x32x16_bf16(kf[2 * d0 + 1], qf[d0], p1, 0, 0, 0); }
}
__device__ __forceinline__ bf16x8 at_vfrag(const LAS unsigned char* vb, int db, int ks) {
    const s16x4 lo = tr16(vb + db * 4096 + ks * 1024), hh = tr16(vb + db * 4096 + ks * 1024 + 512);
    return (bf16x8){lo[0], lo[1], lo[2], lo[3], hh[0], hh[1], hh[2], hh[3]};
}
__device__ __forceinline__ bf16x8 at_kfrag(const LAS unsigned char* kb, int i) { return *(const LAS bf16x8*)(kb + (i >> 1) * 2048 + (i & 1) * 512); }
__device__ __forceinline__ float at_rowmax(const f32x16& c0, const f32x16& c1) {
    float a, b2;
    asm volatile("s_nop 15\n\ts_nop 7\n\tv_max3_f32 %0, %1, %2, %3" : "=v"(a) : "v"(c0[0]), "v"(c0[1]), "v"(c1[0]));
    asm volatile("v_max3_f32 %0, %1, %2, %3" : "=v"(b2) : "v"(c0[2]), "v"(c0[3]), "v"(c1[1]));
    asm volatile("v_max3_f32 %0, %1, %2, %3" : "=v"(a) : "v"(a), "v"(c1[2]), "v"(c1[3]));
#pragma unroll
    for (int r = 4; r < 16; r += 4) {
        asm volatile("v_max3_f32 %0, %1, %2, %3" : "=v"(a) : "v"(a), "v"(c0[r]), "v"(c0[r + 1]));
        asm volatile("v_max3_f32 %0, %1, %2, %3" : "=v"(b2) : "v"(b2), "v"(c0[r + 2]), "v"(c0[r + 3]));
        asm volatile("v_max3_f32 %0, %1, %2, %3" : "=v"(a) : "v"(a), "v"(c1[r]), "v"(c1[r + 1]));
        asm volatile("v_max3_f32 %0, %1, %2, %3" : "=v"(b2) : "v"(b2), "v"(c1[r + 2]), "v"(c1[r + 3]));
    }
    float m;
    asm volatile("v_max_f32_e32 %0, %1, %2" : "=v"(m) : "v"(a), "v"(b2));
    float r0, r1; swap32(m, m, r0, r1);
    return fmaxf(r0, r1);
}
constexpr float AT_THR = 6.0f;
#define AT_PK2(P, i) cvtpk(P[i], P[i + 1])

__device__ __forceinline__ void at_step(f32x16& C0, f32x16& C1, const f32x16& P0, const f32x16& P1, f32x16 (&O)[4], const bf16x8 (&qf)[4],
                                        const __amdgpu_buffer_rsrc_t prs, const unsigned k_voff, const unsigned v_voff, const unsigned so0, u32x4 (&pk)[2], u32x4 (&pv)[2],
                                        const LAS unsigned char* kb, const LAS unsigned char* vbp, const LAS unsigned char* kbn,
                                        float& mhat, f32x4& Lacc, const bf16x8 lsel, bool& resc, const LAS float* lut, bool band, LAS float* wsf, int r32, int hi) {
    bf16x8 va[4], vb[4];
    u32x4 pw0, pw1, pw2, pw3;
#define AT_GAPA(P, i, d0, d1) do { unsigned a_ = AT_PK2(P, i), b_ = AT_PK2(P, (i) + 2); asm volatile("" : "+v"(a_), "+v"(b_)); d0 = a_; d1 = b_; } while (0)
    f32x16 z16;
#pragma unroll
    for (int r = 0; r < 16; ++r) z16[r] = 0.f;
    pk[0] = __builtin_bit_cast(u32x4, __builtin_amdgcn_raw_buffer_load_b128(prs, k_voff, so0, 0)); pv[0] = __builtin_bit_cast(u32x4, __builtin_amdgcn_raw_buffer_load_b128(prs, v_voff, so0, 0));
    pk[1] = __builtin_bit_cast(u32x4, __builtin_amdgcn_raw_buffer_load_b128(prs, k_voff, so0 + 32u * 512u, 0)); pv[1] = __builtin_bit_cast(u32x4, __builtin_amdgcn_raw_buffer_load_b128(prs, v_voff, so0 + 32u * 512u, 0));
    bf16x8 k0 = at_kfrag(kb, 0), k1 = at_kfrag(kb, 1);
    __builtin_amdgcn_s_setprio(1);
    C0 = __builtin_amdgcn_mfma_f32_32x32x16_bf16(k0, qf[0], z16, 0, 0, 0); k0 = at_kfrag(kb, 2); va[0] = at_vfrag(vbp, 0, 0);
    AT_GAPA(P0, 0, pw0.x, pw0.y); AT_SB();
    C1 = __builtin_amdgcn_mfma_f32_32x32x16_bf16(k1, qf[0], z16, 0, 0, 0); k1 = at_kfrag(kb, 3); va[1] = at_vfrag(vbp, 0, 1);
    AT_GAPA(P0, 4, pw0.z, pw0.w); AT_SB();
    C0 = __builtin_amdgcn_mfma_f32_32x32x16_bf16(k0, qf[1], C0, 0, 0, 0); k0 = at_kfrag(kb, 4); va[2] = at_vfrag(vbp, 0, 2);
    AT_GAPA(P0, 8, pw1.x, pw1.y); AT_SB();
    C1 = __builtin_amdgcn_mfma_f32_32x32x16_bf16(k1, qf[1], C1, 0, 0, 0); k1 = at_kfrag(kb, 5); va[3] = at_vfrag(vbp, 0, 3);
    AT_GAPA(P0, 12, pw1.z, pw1.w); AT_SB();
    C0 = __builtin_amdgcn_mfma_f32_32x32x16_bf16(k0, qf[2], C0, 0, 0, 0); k0 = at_kfrag(kb, 6);
    AT_GAPA(P1, 0, pw2.x, pw2.y); AT_SB();
    C1 = __builtin_amdgcn_mfma_f32_32x32x16_bf16(k1, qf[2], C1, 0, 0, 0); k1 = at_kfrag(kb, 7);
    AT_GAPA(P1, 4, pw2.z, pw2.w); AT_SB();
    C0 = __builtin_amdgcn_mfma_f32_32x32x16_bf16(k0, qf[3], C0, 0, 0, 0);
    AT_GAPA(P1, 8, pw3.x, pw3.y); AT_SB();
    C1 = __builtin_amdgcn_mfma_f32_32x32x16_bf16(k1, qf[3], C1, 0, 0, 0);
    AT_GAPA(P1, 12, pw3.z, pw3.w); AT_SB();
    { bf16x8 kone, qneg;
      { u32x4 t4 = (u32x4){0u, 0u, 0u, 0u}; if (hi == 0) t4.x = 0x3F80u; kone = __builtin_bit_cast(bf16x8, t4);
        t4.x = 0u; if (hi == 0) t4.x = cvtpk(-mhat, 0.f) & 0xffffu; qneg = __builtin_bit_cast(bf16x8, t4); }
      C0 = __builtin_amdgcn_mfma_f32_32x32x16_bf16(kone, qneg, C0, 0, 0, 0);
      C1 = __builtin_amdgcn_mfma_f32_32x32x16_bf16(kone, qneg, C1, 0, 0, 0); } AT_SB();
    __builtin_amdgcn_s_setprio(0);
    if (band) {
#pragma unroll
        for (int r = 0; r < 16; ++r) { const int ko = (r & 3) + 8 * (r >> 2); float t0_ = C0[r], t1_ = C1[r];
            asm("v_add_f32 %0, %0, %1" : "+v"(t0_) : "v"(lut[-ko])); asm("v_add_f32 %0, %0, %1" : "+v"(t1_) : "v"(lut[-ko - 32])); C0[r] = t0_; C1[r] = t1_; }
    }
    const float rm = at_rowmax(C0, C1);
    resc = false;
    if (__any(rm > AT_THR)) {
        const float m_new = bf2f((unsigned short)(cvtpk(mhat + fmaxf(rm, 0.f), 0.f) & 0xffffu));
        const float dl = m_new - mhat;
        const float f = fast_exp2(-dl);
        if (hi == 0) wsf[r32] = f; mhat = m_new; resc = true;
#pragma unroll
        for (int r = 0; r < 16; ++r) { C0[r] -= dl; C1[r] -= dl; }
    }
    AT_SB();
    __builtin_amdgcn_s_setprio(1);
    const bf16x8 pa0 = __builtin_bit_cast(bf16x8, pw0), pa1 = __builtin_bit_cast(bf16x8, pw1), pa2 = __builtin_bit_cast(bf16x8, pw2), pa3 = __builtin_bit_cast(bf16x8, pw3);
#define AT_EX2(X, i) do { float e0_ = fast_exp2(X[i]), e1_ = fast_exp2(X[(i) + 1]); asm volatile("" : "+v"(e0_), "+v"(e1_)); X[i] = e0_; X[(i) + 1] = e1_; } while (0)
    O[0] = __builtin_amdgcn_mfma_f32_32x32x16_bf16(pa0, va[0], O[0], 0, 0, 0); vb[0] = at_vfrag(vbp, 1, 0); AT_EX2(C0, 0); AT_SB();
    O[0] = __builtin_amdgcn_mfma_f32_32x32x16_bf16(pa1, va[1], O[0], 0, 0, 0); vb[1] = at_vfrag(vbp, 1, 1); AT_EX2(C0, 2); AT_SB();
    O[0] = __builtin_amdgcn_mfma_f32_32x32x16_bf16(pa2, va[2], O[0], 0, 0, 0); vb[2] = at_vfrag(vbp, 1, 2); AT_EX2(C0, 4); AT_SB();
    O[0] = __builtin_amdgcn_mfma_f32_32x32x16_bf16(pa3, va[3], O[0], 0, 0, 0); Lacc = __builtin_amdgcn_mfma_f32_16x16x32_bf16(lsel, pa0, Lacc, 0, 0, 0); vb[3] = at_vfrag(vbp, 1, 3); AT_EX2(C0, 6); AT_SB();
    O[1] = __builtin_amdgcn_mfma_f32_32x32x16_bf16(pa0, vb[0], O[1], 0, 0, 0); va[0] = at_vfrag(vbp, 2, 0); AT_EX2(C0, 8); AT_SB();
    O[1] = __builtin_amdgcn_mfma_f32_32x32x16_bf16(pa1, vb[1], O[1], 0, 0, 0); va[1] = at_vfrag(vbp, 2, 1); AT_EX2(C0, 10); AT_SB();
    O[1] = __builtin_amdgcn_mfma_f32_32x32x16_bf16(pa2, vb[2], O[1], 0, 0, 0); va[2] = at_vfrag(vbp, 2, 2); AT_EX2(C0, 12); AT_SB();
    O[1] = __builtin_amdgcn_mfma_f32_32x32x16_bf16(pa3, vb[3], O[1], 0, 0, 0); Lacc = __builtin_amdgcn_mfma_f32_16x16x32_bf16(lsel, pa1, Lacc, 0, 0, 0); va[3] = at_vfrag(vbp, 2, 3); AT_EX2(C0, 14); AT_SB();
    O[2] = __builtin_amdgcn_mfma_f32_32x32x16_bf16(pa0, va[0], O[2], 0, 0, 0); vb[0] = at_vfrag(vbp, 3, 0); AT_EX2(C1, 0); AT_SB();
    O[2] = __builtin_amdgcn_mfma_f32_32x32x16_bf16(pa1, va[1], O[2], 0, 0, 0); vb[1] = at_vfrag(vbp, 3, 1); AT_EX2(C1, 2); AT_SB();
    O[2] = __builtin_amdgcn_mfma_f32_32x32x16_bf16(pa2, va[2], O[2], 0, 0, 0); vb[2] = at_vfrag(vbp, 3, 2); AT_EX2(C1, 4); AT_SB();
    O[2] = __builtin_amdgcn_mfma_f32_32x32x16_bf16(pa3, va[3], O[2], 0, 0, 0); Lacc = __builtin_amdgcn_mfma_f32_16x16x32_bf16(lsel, pa2, Lacc, 0, 0, 0); vb[3] = at_vfrag(vbp, 3, 3); AT_EX2(C1, 6); AT_SB();
    O[3] = __builtin_amdgcn_mfma_f32_32x32x16_bf16(pa0, vb[0], O[3], 0, 0, 0); AT_EX2(C1, 8); AT_SB();
    O[3] = __builtin_amdgcn_mfma_f32_32x32x16_bf16(pa1, vb[1], O[3], 0, 0, 0); AT_EX2(C1, 10); AT_SB();
    O[3] = __builtin_amdgcn_mfma_f32_32x32x16_bf16(pa2, vb[2], O[3], 0, 0, 0); AT_EX2(C1, 12); AT_SB();
    O[3] = __builtin_amdgcn_mfma_f32_32x32x16_bf16(pa3, vb[3], O[3], 0, 0, 0); Lacc = __builtin_amdgcn_mfma_f32_16x16x32_bf16(lsel, pa3, Lacc, 0, 0, 0); AT_EX2(C1, 14); AT_SB();
    __builtin_amdgcn_s_setprio(0);
#undef AT_EX2
#undef AT_GAPA
}
__device__ __forceinline__ void at_rescale(f32x16 (&O)[4], const LAS float* wsf, int hi) {
#pragma unroll
    for (int gq = 0; gq < 4; ++gq) { const f32x4 al = *(const LAS f32x4*)(wsf + 8 * gq + 4 * hi);
#pragma unroll
        for (int db = 0; db < 4; ++db) { O[db][4 * gq + 0] *= al.x; O[db][4 * gq + 1] *= al.y; O[db][4 * gq + 2] *= al.z; O[db][4 * gq + 3] *= al.w; } }
}

__device__ __forceinline__ void attn_unit(const Frame& F, const Args& a, int bh, int qb, float lam, int wc0 = 0, int wc1 = 0, int wcs = 0) {
    const int b = bh >> 2, h = bh & 3;
    f32x4 wva[8], wvb[8]; const bool wi1 = wc0 < wc1, wi2 = wc0 + wcs < wc1;
    if (wi1) wconv_load(a, wva, wc0, F.lane);
    if (wi2) wconv_load(a, wvb, wc0 + wcs, F.lane);
    const bf16* KVb = (const bf16*)(a.ws + WS_KV) + (size_t)bh * SEQ * 256;
    const bf16* QCb = (const bf16*)(a.ws + WS_QC) + (size_t)bh * SEQ * 128;
    LAS unsigned char* lds = F.lds;
    int tid = F.tid; asm volatile("" : "+v"(tid));
    const int lane = tid & 63, w = F.wave, wq = w & 3, mc = w >> 2, r32 = lane & 31, hi = lane >> 5;
    const int q0 = qb * 128, NT = 2 * qb + 2;
    LAS float* wsf = (LAS float*)(lds + AT_WS + 256 * w);
    const int k_kv = ((tid >> 7) << 3) + (tid & 7), k_ch = (tid >> 3) & 15;
    const int k_lds = (k_ch >> 3) * 8192 + (k_ch & 7) * 1024 + k_kv * 16;
    const unsigned k_voff = (unsigned)(k_kv * 256 + k_ch * 8) * 2u;
    const int v_kv = (((tid >> 5) & 15) << 1) + ((tid >> 2) & 1), v_ch = (((tid >> 3) & 3) << 2) + (tid & 3);
    const int v_lds = 16384 + (v_ch >> 2) * 4096 + v_kv * 64 + (v_ch & 3) * 16;
    const unsigned v_voff = (unsigned)(v_kv * 256 + 128 + v_ch * 8) * 2u;
    const __amdgpu_buffer_rsrc_t prs = __builtin_amdgcn_make_buffer_rsrc((void*)KVb, (short)0, SEQ * 512, 0x00020000);
    u32x4 pk[2], pv[2];
#define AT_LOAD(j) do { _Pragma("unroll") for (int i = 0; i < 2; ++i) { const unsigned so = (unsigned)(((j) * 64 + 32 * i) * 512); \
        pk[i] = __builtin_bit_cast(u32x4, __builtin_amdgcn_raw_buffer_load_b128(prs, k_voff, so, 0)); pv[i] = __builtin_bit_cast(u32x4, __builtin_amdgcn_raw_buffer_load_b128(prs, v_voff, so, 0)); } } while (0)
#define AT_STORE(bufo) do { _Pragma("unroll") for (int i = 0; i < 2; ++i) { *(LAS u32x4*)(lds + (bufo) + k_lds + 32 * 16 * i) = pk[i]; *(LAS u32x4*)(lds + (bufo) + v_lds + 32 * 64 * i) = pv[i]; } } while (0)
    bf16x8 qf[4];
    { const bf16* qp = QCb + (size_t)(q0 + 32 * wq + r32) * 128 + mc * 64 + 8 * hi;
#pragma unroll
      for (int d0 = 0; d0 < 4; ++d0) qf[d0] = *(const bf16x8*)(qp + 16 * d0); }
    f32x16 O[4];
#pragma unroll
    for (int db = 0; db < 4; ++db)
#pragma unroll
        for (int r = 0; r < 16; ++r) O[db][r] = 0.f;
    float mhat = -INFINITY;
    f32x4 Lacc = (f32x4){0.f, 0.f, 0.f, 0.f};
    bf16x8 lsel;
    { const int m_ = lane & 15, g_ = lane >> 4; const unsigned v_ = ((m_ == 0 && (g_ & 1) == 0) || (m_ == 1 && (g_ & 1) == 1)) ? 0x3F803F80u : 0u;
      lsel = __builtin_bit_cast(bf16x8, (u32x4){v_, v_, v_, v_}); }
    {
        u32x4 qk[3][2], qv[3][2]; const int j2 = NT > 2 ? 2 : 1;
#pragma unroll
        for (int tl = 0; tl < 3; ++tl) { const int jt = tl < 2 ? tl : j2;
#pragma unroll
            for (int i = 0; i < 2; ++i) { const unsigned so = (unsigned)((jt * 64 + 32 * i) * 512);
                qk[tl][i] = __builtin_bit_cast(u32x4, __builtin_amdgcn_raw_buffer_load_b128(prs, k_voff, so, 0)); qv[tl][i] = __builtin_bit_cast(u32x4, __builtin_amdgcn_raw_buffer_load_b128(prs, v_voff, so, 0)); } }
        if (wi1) wconv_store(a, wva, wc0, F.lane, lds + EPI_SCR + F.wave * 2048);
        if (wi2) wconv_store(a, wvb, wc0 + wcs, F.lane, lds + EPI_SCR + F.wave * 2048);
        for (int it = wc0 + 2 * wcs; it < wc1; it += wcs) { f32x4 wv[8]; wconv_load(a, wv, it, F.lane); wconv_store(a, wv, it, F.lane, lds + EPI_SCR + F.wave * 2048); }
#pragma unroll
        for (int tl = 0; tl < 3; ++tl)
#pragma unroll
            for (int i = 0; i < 2; ++i) { *(LAS u32x4*)(lds + tl * AT_BUF + k_lds + 32 * 16 * i) = qk[tl][i]; *(LAS u32x4*)(lds + tl * AT_BUF + v_lds + 32 * 64 * i) = qv[tl][i]; }
    }
    __syncthreads();
    const int koff = mc * 8192 + hi * 1024 + r32 * 16;
    const int voff = 16384 + ((lane >> 4) & 1) * 32 + (lane & 3) * 8 + (4 * hi + ((lane & 15) >> 2)) * 64;
    const LAS float* lutp = (const LAS float*)(lds + AT_LUT) + (q0 + 32 * wq + r32 + 127 - 4 * hi);
    f32x16 pA0, pA1, pB0, pB1;
    at_qk(pA0, pA1, lds + koff, qf);
    if (0 >= NT - 4) {
#pragma unroll
        for (int r = 0; r < 16; ++r) { const int ko = (r & 3) + 8 * (r >> 2); pA0[r] += lutp[-ko]; pA1[r] += lutp[-ko - 32]; }
    }
    mhat = bf2f((unsigned short)(cvtpk(at_rowmax(pA0, pA1), 0.f) & 0xffffu));
#pragma unroll
    for (int r = 0; r < 16; ++r) { pA0[r] = fast_exp2(pA0[r] - mhat); pA1[r] = fast_exp2(pA1[r] - mhat); }
    bool resc = false;
#define AT_SLOT(t) (((t) & 3) * AT_BUF)
#define AT_STEP(CA, CB, PA, PB, t) do { const int jl_ = ((t) + 2 < NT) ? (t) + 2 : NT - 1; \
        at_step(CA, CB, PA, PB, O, qf, prs, k_voff, v_voff, (unsigned)(jl_ * 64 * 512), pk, pv, lds + AT_SLOT(t) + koff, lds + AT_SLOT((t) - 1) + voff, lds + AT_SLOT((t) + 1) + koff, mhat, Lacc, lsel, resc, lutp - 64 * (t), (t) >= NT - 4, wsf, r32, hi); \
        AT_STORE(AT_SLOT((t) + 2)); __syncthreads(); if (resc) { at_rescale(O, wsf, hi); Lacc[0] *= wsf[lane & 15]; Lacc[1] *= wsf[16 + (lane & 15)]; } } while (0)
    int t = 1;
    for (; t + 1 < NT; t += 2) { AT_STEP(pB0, pB1, pA0, pA1, t); AT_STEP(pA0, pA1, pB0, pB1, t + 1); }
    AT_STEP(pB0, pB1, pA0, pA1, t);
    {
        u32x4 q4; bf16x8 pa[4];
        q4.x = AT_PK2(pB0, 0); q4.y = AT_PK2(pB0, 2); q4.z = AT_PK2(pB0, 4); q4.w = AT_PK2(pB0, 6); pa[0] = __builtin_bit_cast(bf16x8, q4);
        q4.x = AT_PK2(pB0, 8); q4.y = AT_PK2(pB0, 10); q4.z = AT_PK2(pB0, 12); q4.w = AT_PK2(pB0, 14); pa[1] = __builtin_bit_cast(bf16x8, q4);
        q4.x = AT_PK2(pB1, 0); q4.y = AT_PK2(pB1, 2); q4.z = AT_PK2(pB1, 4); q4.w = AT_PK2(pB1, 6); pa[2] = __builtin_bit_cast(bf16x8, q4);
        q4.x = AT_PK2(pB1, 8); q4.y = AT_PK2(pB1, 10); q4.z = AT_PK2(pB1, 12); q4.w = AT_PK2(pB1, 14); pa[3] = __builtin_bit_cast(bf16x8, q4);
        const LAS unsigned char* vbp = lds + AT_SLOT(NT - 1) + voff;
#pragma unroll
        for (int db = 0; db < 4; ++db)
#pragma unroll
            for (int ks = 0; ks < 4; ++ks) O[db] = __builtin_amdgcn_mfma_f32_32x32x16_bf16(pa[ks], at_vfrag(vbp, db, ks), O[db], 0, 0, 0);
#pragma unroll
        for (int ks = 0; ks < 4; ++ks) Lacc = __builtin_amdgcn_mfma_f32_16x16x32_bf16(lsel, pa[ks], Lacc, 0, 0, 0);
    }
    __syncthreads();
    { const float scm = (mc == 0 ? 1.f : lam);
      if (lane < 16) { wsf[lane] = scm * fast_rcp(Lacc[0]); wsf[16 + lane] = scm * fast_rcp(Lacc[1]); }
      at_rescale(O, wsf, hi); }
    LAS float* ex = (LAS float*)lds + (mc * 4 + wq) * 4096;
#pragma unroll
    for (int db = 0; db < 4; ++db)
#pragma unroll
        for (int r = 0; r < 16; ++r) ex[crow(r, hi) * 128 + 32 * db + r32] = O[db][r];
    __syncthreads();
    {
        const int l15 = lane & 15, lr = lane >> 4;
        float gv[8];
        { const float* sg = a.in[11] + 8 * l15;
#pragma unroll
          for (int i = 0; i < 8; ++i) gv[i] = sg[i] * 0.8f; }
        bf16* Y = (bf16*)(a.ws + WS_Y) + (size_t)(b * SEQ + q0) * D + h * 128 + 8 * l15;
#pragma unroll
        for (int p = 0; p < 4; ++p) { const int R = 16 * w + 4 * p + lr;
            const LAS float* pa = (const LAS float*)lds + (R >> 5) * 4096 + (R & 31) * 128 + 8 * l15; const LAS float* pb = pa + 4 * 4096;
            const f32x4 a0 = *(const LAS f32x4*)pa, a1 = *(const LAS f32x4*)(pa + 4), b0 = *(const LAS f32x4*)pb, b1 = *(const LAS f32x4*)(pb + 4);
            const f32x4 o0 = a0 - b0, o1 = a1 - b1;
            float ss = (o0.x * o0.x + o0.y * o0.y) + (o0.z * o0.z + o0.w * o0.w) + (o1.x * o1.x + o1.y * o1.y) + (o1.z * o1.z + o1.w * o1.w);
            ss = row_sum(ss);
            const float rr = __builtin_amdgcn_rsqf(ss * (1.f / 128.f) + EPS);
            u32x4 yo;
            yo.x = cvtpk(o0.x * rr * gv[0], o0.y * rr * gv[1]); yo.y = cvtpk(o0.z * rr * gv[2], o0.w * rr * gv[3]);
            yo.z = cvtpk(o1.x * rr * gv[4], o1.y * rr * gv[5]); yo.w = cvtpk(o1.z * rr * gv[6], o1.w * rr * gv[7]);
            *(u32x4*)(Y + (size_t)R * D) = yo; }
    }
    __syncthreads();
#undef AT_LOAD
#undef AT_STORE
#undef AT_SLOT
#undef AT_STEP
}

__device__ __forceinline__ void p2_mixers(const Frame& F, const Args& a) {
    float lam;
    { const float v1 = a.in[7][F.lane] * a.in[8][F.lane], v2 = a.in[9][F.lane] * a.in[10][F.lane];
      lam = __expf(wave_sum(v1)) - __expf(wave_sum(v2)) + 0.2f; }
    const int per = F.G / 32;
    if (per < 1) return;
    const int bh = F.vcu / per, s = F.vcu % per;
    if (bh >= 32) return;
    { const int h = bh & 3; const float* tab = a.in[12]; const float t31 = tab[31 * 4 + h];
      for (int i = F.tid; i < 384; i += NTHREADS) { const int dist = i - 127; ((LAS float*)(F.lds + AT_LUT))[i] = dist < 0 ? -INFINITY : (tab[t5_bucket(dist) * 4 + h] - t31) * LOG2E; } }
    if (s == 0) hgrn_stream(F, a, bh);
    constexpr int NDYN = 10;
    if (s >= 1) {
        const int na = per - 1;
        const int natt = 32 * na, am = bh * na + (s - 1), nslots = (WC_ITEMS + natt * 8 - 1) / (natt * 8), full = (64 - NDYN) / na, spu = (nslots + full - 1) / full;
        int slot = 0;
        for (int k = 0; k * na < 64 - NDYN; ++k) {
            const int idx = k * na + ((k & 1) ? (na - s) : (s - 1));
            const int s1 = (slot + spu < nslots) ? slot + spu : nslots;
            const int i0 = (slot * natt + am) * 8 + F.wave, i1 = (s1 * natt + am) * 8 + F.wave;
            if (idx < 64 - NDYN) { attn_unit(F, a, bh, 63 - idx, lam, i0, i1 < WC_ITEMS ? i1 : WC_ITEMS, natt * 8); slot = s1; }
        }
        for (; slot < nslots; ++slot) { const int it = (slot * natt + am) * 8 + F.wave;
            if (it < WC_ITEMS) { f32x4 wv[8]; wconv_load(a, wv, it, F.lane); wconv_store(a, wv, it, F.lane, F.lds + EPI_SCR + F.wave * 2048); } }
    }
    {
        unsigned* qhead = (unsigned*)(a.ws + WS_CTL) + CW_Q + 64 * bh;
        LAS unsigned* tk = (LAS unsigned*)(F.lds + AT_TKT);
        for (;;) {
            if (F.tid == 0) *tk = __hip_atomic_fetch_add(qhead, 1u, __ATOMIC_RELAXED, __HIP_MEMORY_SCOPE_AGENT);
            __syncthreads();
            const unsigned t = *tk;
            __syncthreads();
            if (t >= (unsigned)NDYN) break;
            attn_unit(F, a, bh, NDYN - 1 - (int)t, lam);
        }
    }
}

constexpr int RT_W = 0, RT_HIST = 73728, RT_BASE = 73856;
__device__ __forceinline__ void p4_router(const Frame& F, const Args& a) {
    LAS unsigned char* lds = F.lds;
    const float* wg = a.in[16]; const float* bg = a.in[17]; const float* we = a.in[18]; const float* be = a.in[19];
    for (int i = F.tid; i < 4 * 1024; i += NTHREADS) { const int d = i >> 2, e = i & 3;
        ((LAS unsigned short*)(lds + RT_W))[e * 1024 + d] = (unsigned short)(cvtpk(wg[i], 0.f) & 0xffffu); }
    for (int i = F.tid; i < 32 * 1024; i += NTHREADS) { const int d = i >> 5, e = i & 31;
        ((LAS unsigned short*)(lds + RT_W))[(4 + e) * 1024 + d] = (unsigned short)(cvtpk(we[i], 0.f) & 0xffffu); }
    if (F.tid < 32) ((LAS unsigned*)(lds + RT_HIST))[F.tid] = 0u;
    __syncthreads();
    const bf16* x1 = (const bf16*)(a.ws + WS_X1B); const float* ng = a.in[5]; const float* mod = (const float*)(a.ws + WS_MOD);
    bf16* H = (bf16*)(a.ws + WS_H);
    const int gw = F.vcu * NWAVES + F.wave, NGW = F.G * NWAVES, lane = F.lane;
    int my_tok = -1, my_e0 = 0, my_e1 = 0; float my_w0 = 0.f, my_w1 = 0.f;
    const int per = (NTOK + NGW - 1) / NGW;
    const int m0 = gw * per, m1 = (m0 + per < NTOK) ? m0 + per : NTOK;
    int it = 0;
    for (int s0 = m0; s0 < m1; ) {
      const int b = s0 >> 13, e1 = ((b + 1) << 13) < m1 ? ((b + 1) << 13) : m1;
      f32x4 ga[4], sha[4];
      { const f32x4* gp = (const f32x4*)ng + lane; const f32x4* shp = (const f32x4*)(mod + b * 6144 + 3072) + lane; const f32x4* scp = (const f32x4*)(mod + b * 6144 + 4096) + lane;
#pragma unroll
        for (int j = 0; j < 4; ++j) { ga[j] = gp[64 * j] * (scp[64 * j] + 1.f); sha[j] = shp[64 * j]; } }
      u32x2 nxv[4];
      { const u32x2* xr = (const u32x2*)(x1 + (size_t)s0 * D) + lane;
#pragma unroll
        for (int j = 0; j < 4; ++j) nxv[j] = xr[64 * j]; }
      for (int m = s0; m < e1; ++m, ++it) {
        f32x4 v[4]; float s = 0.f;
#pragma unroll
        for (int j = 0; j < 4; ++j) { const u32x2 xv = nxv[j]; v[j] = (f32x4){bflo(xv.x), bfhi(xv.x), bflo(xv.y), bfhi(xv.y)}; s += (v[j].x * v[j].x + v[j].y * v[j].y) + (v[j].z * v[j].z + v[j].w * v[j].w); }
        { const int mn = (m + 1 < e1) ? m + 1 : m; const u32x2* xr = (const u32x2*)(x1 + (size_t)mn * D) + lane;
#pragma unroll
          for (int j = 0; j < 4; ++j) nxv[j] = xr[64 * j]; }
        const float r = __builtin_amdgcn_rsqf(wave_sum(s) * (1.f / D) + EPS);
        u32x2* o8 = (u32x2*)(H + (size_t)m * D) + lane;
        u32x2 hp[4];
#pragma unroll
        for (int j = 0; j < 4; ++j) {
            v[j] = v[j] * r * ga[j] + sha[j];
            u32x2 o; o.x = cvtpk(v[j].x, v[j].y); o.y = cvtpk(v[j].z, v[j].w); o8[64 * j] = o; asm("" : "+v"(o.x), "+v"(o.y)); hp[j] = o; }
        asm volatile("" ::: "memory");
        float lg[4];
#pragma unroll
        for (int e = 0; e < 4; ++e) { float acc = 0.f;
#pragma unroll
            for (int j = 0; j < 4; ++j) { const u32x2 wv = *(const LAS u32x2*)(lds + RT_W + (e * 1024 + 256 * j + 4 * lane) * 2);
                acc = dot2bf(wv.x, hp[j].x, acc); acc = dot2bf(wv.y, hp[j].y, acc); }
            lg[e] = wave_sum(acc) + bg[e]; }
        int gi = 0; float gm = lg[0];
#pragma unroll
        for (int i = 1; i < 4; ++i) if (lg[i] > gm) { gm = lg[i]; gi = i; }
        gi = __builtin_amdgcn_readfirstlane(gi);
        float gs = 0.f;
#pragma unroll
        for (int i = 0; i < 4; ++i) gs += __expf(lg[i] - gm);
        const float gate = 1.f / gs;
        float pe[8];
        { const LAS unsigned char* wb_ = lds + RT_W + (size_t)(4 + gi * 8) * 2048;
#pragma unroll
          for (int e = 0; e < 8; ++e) { float acc = 0.f;
#pragma unroll
              for (int j = 0; j < 4; ++j) { const u32x2 wv = *(const LAS u32x2*)(wb_ + (e * 1024 + 256 * j + 4 * lane) * 2);
                  acc = dot2bf(wv.x, hp[j].x, acc); acc = dot2bf(wv.y, hp[j].y, acc); }
              pe[e] = acc; } }
        float t4[4], t2[2], t1;
#pragma unroll
        for (int i = 0; i < 4; ++i) t4[i] = sum_x32(pe[i], pe[i + 4]);
#pragma unroll
        for (int i = 0; i < 2; ++i) t2[i] = sum_x16(t4[i], t4[i + 2]);
        { const bool up = (lane & 8) != 0; const float keep = up ? t2[1] : t2[0], send = up ? t2[0] : t2[1]; t1 = keep + dppf<0x128>(send); }
        t1 += dppf<0xB1>(t1); t1 += dppf<0x4E>(t1); t1 += dppf<0x141>(t1);
        float el[8];
#pragma unroll
        for (int i = 0; i < 8; ++i) el[i] = __builtin_bit_cast(float, __builtin_amdgcn_readlane(__builtin_bit_cast(int, t1), 8 * ((i & 1) + 2 * ((i >> 1) & 1) + 4 * ((i >> 2) & 1)))) + be[gi * 8 + i];
        int ia = 0; float va = el[0];
#pragma unroll
        for (int i = 1; i < 8; ++i) if (el[i] > va) { va = el[i]; ia = i; }
        int ib = -1; float vb = -INFINITY;
#pragma unroll
        for (int i = 0; i < 8; ++i) if (i != ia && el[i] > vb) { vb = el[i]; ib = i; }
        const float wa = gate / (1.f + __expf(vb - va)), wb = gate - wa;
        if (lane == it) { my_tok = m; my_e0 = gi * 8 + ia; my_e1 = gi * 8 + ib; my_w0 = wa; my_w1 = wb; }
      }
      s0 = e1;
    }
    LAS unsigned* hist = (LAS unsigned*)(lds + RT_HIST); LAS unsigned* base = (LAS unsigned*)(lds + RT_BASE);
    unsigned r0 = 0, r1 = 0;
    if (my_tok >= 0) { r0 = atomicAdd((unsigned*)hist + my_e0, 1u); r1 = atomicAdd((unsigned*)hist + my_e1, 1u); }
    __syncthreads();
    unsigned* cnt = (unsigned*)(a.ws + WS_CTL) + CW_CNT;
    if (F.tid < 32) { const unsigned hv = hist[F.tid]; base[F.tid] = hv ? __hip_atomic_fetch_add(cnt + F.tid, hv, __ATOMIC_RELAXED, __HIP_MEMORY_SCOPE_AGENT) : 0u; }
    __syncthreads();
    if (my_tok >= 0) {
        int* list = (int*)(a.ws + WS_LIST); float* tw = (float*)(a.ws + WS_TOKW);
        const int p0_ = (int)(base[my_e0] + r0), p1_ = (int)(base[my_e1] + r1);
        list[(size_t)my_e0 * NTOK + p0_] = my_tok * 2;
        list[(size_t)my_e1 * NTOK + p1_] = my_tok * 2 + 1;
        tw[my_tok * 2] = my_w0; tw[my_tok * 2 + 1] = my_w1;
        int* toks = (int*)(a.ws + WS_TOKS);
        toks[my_tok * 2] = (my_e0 << 20) | p0_; toks[my_tok * 2 + 1] = (my_e1 << 20) | p1_;
    }
}

constexpr int MOE_CNTL = MISC_OFF + 256, MOE_LTOK = MISC_OFF + 4096, MOE_MAXU = 12;
struct MoeOrder {
    const LAS int* pre; const LAS int* cntl; const LAS int* ltok; const int* list; int G, c, lane; bool gather;
    __device__ __forceinline__ bool next(int i, pg8::Unit& u) const {
        const int total = pre[32];
        int rt, pn;
        if (G == 256) {
            rt = (i * 8 + (c & 7)) * 8 + ((c >> 3) & 7); pn = c >> 6;
            if (rt >= total) return false;
        } else { const long L = (long)i * G + c; if (L >= (long)total * 4) return false; rt = (int)(L >> 2); pn = (int)(L & 3); }
        const int e = __builtin_popcountll(__ballot(pre[(lane & 31) + 1] <= rt) & 0xffffffffull);
        u.e = e; u.pm = rt; u.pn = e * 4 + pn; u.r0 = (rt - pre[e]) * 256; const int n = cntl[e] - u.r0; u.nrows = n < 256 ? n : 256; u.slot = i; return true;
    }
    __device__ __forceinline__ int arow(const pg8::Unit& u, int r) const {
        if (!gather) return u.pm * 256 + r;
        if (u.slot < MOE_MAXU) return ltok[u.slot * 256 + r];
        return r < u.nrows ? (list[(size_t)u.e * NTOK + u.r0 + r] >> 1) : 0;
    }
};
struct EpiSwiGLU {
    static constexpr bool PERM = true;
    static constexpr int NST = 8;
    bf16* act;
    LAS unsigned char* scr;
    __device__ __forceinline__ void operator()(const f32x4 (&acc)[2][2][4][2], const pg8::Unit& u, int wr, int wc, int fr, int fq) const {
        LAS unsigned char* ws_ = scr + (wr * 4 + wc) * 2048;
        const int l = fr + 16 * fq, r8 = l >> 3, c8 = l & 7;
        bf16* base = act + (size_t)(u.pm * 256 + wr * 64 + (c8 >> 2) * 16 + r8) * FF + (u.pn & 3) * 128 + wc * 32 + 8 * (c8 & 3);
        u32x4 rq[2][2];
#pragma unroll
        for (int it = 0; it <= 4; ++it) {
            if (it < 4) { const int ai = it >> 1, m2 = it & 1; u32x4 w[2];
#pragma unroll
                for (int q = 0; q < 2; ++q) { const int m = 2 * m2 + q; const f32x4 a0 = acc[ai][0][m][0], a1 = acc[ai][0][m][1], b0 = acc[ai][1][m][0], b1 = acc[ai][1][m][1];
                    w[q].x = cvtpk(siluf_(a0.x) * b0.x, siluf_(a0.y) * b0.y); w[q].y = cvtpk(siluf_(a0.z) * b0.z, siluf_(a0.w) * b0.w);
                    w[q].z = cvtpk(siluf_(a1.x) * b1.x, siluf_(a1.y) * b1.y); w[q].w = cvtpk(siluf_(a1.z) * b1.z, siluf_(a1.w) * b1.w); }
                pg8::xpose128(ws_, fr, fq, w[0], w[1], rq[it & 1][0], rq[it & 1][1]); }
            if (it > 0) { const int ai = (it - 1) >> 1, m2 = (it - 1) & 1;
                bf16* rowp = base + (size_t)(ai * 128 + m2 * 32) * FF;
                *(u32x4*)rowp = rq[(it - 1) & 1][0]; *(u32x4*)(rowp + (size_t)8 * FF) = rq[(it - 1) & 1][1]; } }
    }
};
struct EpiScatter {
    static constexpr bool PERM = true;
    static constexpr int NST = 16;
    bf16* ybuf;
    LAS unsigned char* scr;
    __device__ __forceinline__ void operator()(const f32x4 (&acc)[2][2][4][2], const pg8::Unit& u, int wr, int wc, int fr, int fq) const {
        LAS unsigned char* ws_ = scr + (wr * 4 + wc) * 2048;
        const int l = fr + 16 * fq, r8 = l >> 3, c8 = l & 7;
        bf16* base = ybuf + (size_t)(u.pm * 256 + wr * 64 + r8) * D + (u.pn & 3) * 256 + wc * 64 + 8 * c8;
        u32x4 rq[2][2];
#pragma unroll
        for (int it = 0; it <= 8; ++it) {
            if (it < 8) { const int ai = it >> 2, m = it & 3; u32x4 w[2];
#pragma unroll
                for (int bj = 0; bj < 2; ++bj) { const f32x4 v0 = acc[ai][bj][m][0], v1 = acc[ai][bj][m][1];
                    w[bj].x = cvtpk(v0.x, v0.y); w[bj].y = cvtpk(v0.z, v0.w); w[bj].z = cvtpk(v1.x, v1.y); w[bj].w = cvtpk(v1.z, v1.w); }
                pg8::xpose128(ws_, fr, fq, w[0], w[1], rq[it & 1][0], rq[it & 1][1]); }
            if (it > 0) { const int ai = (it - 1) >> 2, m = (it - 1) & 3;
                bf16* rowp = base + (size_t)(ai * 128 + m * 16) * D;
                *(u32x4*)rowp = rq[(it - 1) & 1][0]; *(u32x4*)(rowp + (size_t)8 * D) = rq[(it - 1) & 1][1]; } }
    }
};

__device__ __forceinline__ void p7_final(const Frame& F, const Args& a) {
    float* out = a.out; const float* fg = a.in[23]; const float* mod = (const float*)(a.ws + WS_MOD);
    const bf16* yb = (const bf16*)(a.ws + WS_YBUF); const float* tw = (const float*)(a.ws + WS_TOKW); const int* toks = (const int*)(a.ws + WS_TOKS); const bf16* x1b = (const bf16*)(a.ws + WS_X1B);
    const int gw = F.vcu * NWAVES + F.wave, NGW = F.G * NWAVES, lane = F.lane;
    const int per = (NTOK + NGW - 1) / NGW;
    const int m0 = gw * per, m1 = (m0 + per < NTOK) ? m0 + per : NTOK;
    if (m0 >= NTOK) return;
    const int prev = ((const LAS int*)(F.lds + MISC_OFF))[lane & 31];
    u32x4 nx[2], ny0[2], ny1[2];
#define P7_ROW(sv) (__builtin_amdgcn_readlane(prev, (sv) >> 20) * 256 + ((sv) & 0xFFFFF))
#define P7_LOAD(mm, ra, rb) do { _Pragma("unroll") for (int j = 0; j < 2; ++j) { nx[j] = *((const u32x4*)(x1b + (size_t)(mm) * D) + lane + 64 * j); \
        ny0[j] = *((const u32x4*)(yb + (size_t)(ra) * D) + lane + 64 * j); ny1[j] = *((const u32x4*)(yb + (size_t)(rb) * D) + lane + 64 * j); } } while (0)
    f32x4 fgr[2][2];
#pragma unroll
    for (int j = 0; j < 2; ++j) { const f32x4* gp = (const f32x4*)(fg + 512 * j) + 2 * lane; fgr[j][0] = gp[0]; fgr[j][1] = gp[1]; }
    for (int s0 = m0; s0 < m1; ) {
        const int b = s0 >> 13; int e1 = ((b + 1) << 13) < m1 ? ((b + 1) << 13) : m1; if (e1 > s0 + 32) e1 = s0 + 32;
        const int nrow = e1 - s0;
        const int tv = (lane < 2 * nrow) ? toks[2 * s0 + lane] : 0; const float wv = (lane < 2 * nrow) ? tw[2 * s0 + lane] : 0.f;
        f32x4 g2r[2][2];
#pragma unroll
        for (int j = 0; j < 2; ++j) { const f32x4* g2p = (const f32x4*)(mod + b * 6144 + 5120 + 512 * j) + 2 * lane; g2r[j][0] = g2p[0]; g2r[j][1] = g2p[1]; }
        { const int sa = __builtin_amdgcn_readlane(tv, 0), sb = __builtin_amdgcn_readlane(tv, 1); P7_LOAD(s0, P7_ROW(sa), P7_ROW(sb)); }
        for (int i = 0; i < nrow; ++i) { const int m = s0 + i;
            u32x4 cx[2], cy0[2], cy1[2];
#pragma unroll
            for (int j = 0; j < 2; ++j) { cx[j] = nx[j]; cy0[j] = ny0[j]; cy1[j] = ny1[j]; }
            { const int in_ = (i + 1 < nrow) ? i + 1 : i; const int sa = __builtin_amdgcn_readlane(tv, 2 * in_), sb = __builtin_amdgcn_readlane(tv, 2 * in_ + 1); P7_LOAD(s0 + in_, P7_ROW(sa), P7_ROW(sb)); }
            const float w0 = __builtin_bit_cast(float, __builtin_amdgcn_readlane(__builtin_bit_cast(int, wv), 2 * i)), w1 = __builtin_bit_cast(float, __builtin_amdgcn_readlane(__builtin_bit_cast(int, wv), 2 * i + 1));
            float v[2][8]; float s = 0.f;
#pragma unroll
            for (int j = 0; j < 2; ++j) { const f32x4 ga = g2r[j][0], gb = g2r[j][1];
                const float g2[8] = {ga.x, ga.y, ga.z, ga.w, gb.x, gb.y, gb.z, gb.w};
                const unsigned xw[4] = {cx[j].x, cx[j].y, cx[j].z, cx[j].w}, aw[4] = {cy0[j].x, cy0[j].y, cy0[j].z, cy0[j].w}, bw[4] = {cy1[j].x, cy1[j].y, cy1[j].z, cy1[j].w};
#pragma unroll
                for (int k = 0; k < 4; ++k) { const float mm0 = w0 * bflo(aw[k]) + w1 * bflo(bw[k]), mm1 = w0 * bfhi(aw[k]) + w1 * bfhi(bw[k]);
                    v[j][2 * k] = bflo(xw[k]) + g2[2 * k] * mm0; v[j][2 * k + 1] = bfhi(xw[k]) + g2[2 * k + 1] * mm1;
                    s += v[j][2 * k] * v[j][2 * k] + v[j][2 * k + 1] * v[j][2 * k + 1]; } }
            const float r = __builtin_amdgcn_rsqf(wave_sum(s) * (1.f / D) + EPS);
#pragma unroll
            for (int j = 0; j < 2; ++j) { const f32x4 ga = fgr[j][0], gb = fgr[j][1];
                f32x4* op = (f32x4*)(out + (size_t)m * D + 512 * j) + 2 * lane;
                op[0] = (f32x4){v[j][0] * r * ga.x, v[j][1] * r * ga.y, v[j][2] * r * ga.z, v[j][3] * r * ga.w};
                op[1] = (f32x4){v[j][4] * r * gb.x, v[j][5] * r * gb.y, v[j][6] * r * gb.z, v[j][7] * r * gb.w}; }
        }
        s0 = e1;
    }
#undef P7_LOAD
#undef P7_ROW
}

constexpr unsigned long long P1_CPERM = 0x0ull | (0ull << 0) | (1ull << 4) | (2ull << 8) | (3ull << 12) | (4ull << 16) | (5ull << 20) | (10ull << 24) | (11ull << 28)
                                       | (6ull << 32) | (7ull << 36) | (12ull << 40) | (13ull << 44) | (8ull << 48) | (9ull << 52) | (15ull << 60);
#define LOAD_ARGS(la) Args la; { const __attribute__((address_space(4))) Args* ap_ = (const __attribute__((address_space(4))) Args*)__builtin_amdgcn_kernarg_segment_ptr(); asm volatile("" : "+s"(ap_)); la = *(const Args*)ap_; }
__global__ void __launch_bounds__(NTHREADS, 2) fwd_megakernel(Args args_unused) {
    extern __shared__ __attribute__((aligned(16))) unsigned char lds_raw[];
    cg::grid_group grid = cg::this_grid();
    Frame F;
    F.lds = (LAS unsigned char*)lds_raw;
    F.tid = threadIdx.x; F.lane = F.tid & 63; F.wave = __builtin_amdgcn_readfirstlane(F.tid >> 6);
    F.G = gridDim.x; { const int bx = blockIdx.x; F.vcu = (F.G % 8 == 0) ? (bx % 8) * (F.G / 8) + bx / 8 : bx; }
#define REFRAME() do { int l_; asm volatile("v_mbcnt_lo_u32_b32 %0, -1, 0\n\tv_mbcnt_hi_u32_b32 %0, -1, %0" : "=v"(l_)); F.lane = l_; F.tid = F.wave * 64 + l_; } while (0)
    for (int u = F.tid; u < (LDS_BYTES - MISC_OFF) / 4; u += NTHREADS) ((LAS unsigned*)(F.lds + MISC_OFF))[u] = 0u;
    __syncthreads();
    XcdBarrier xbar;
    { LOAD_ARGS(args0); xbar = xcd_barrier_post((unsigned*)(args0.ws + WS_CTL) + CW_BAR, (volatile LAS unsigned*)(F.lds + MISC_OFF + 1024)); }
#define GRID_BAR() xcd_barrier(xbar)

    { REFRAME(); LOAD_ARGS(args); p0_prologue(F, args); }
    grid.sync();
    { REFRAME(); LOAD_ARGS(args); p0b_norm1(F, args); }
    GRID_BAR();
    {
        REFRAME(); LOAD_ARGS(args); unsigned char* ws = args.ws;
        pg8::Gemm g{(const bf16*)(ws + WS_H), (const bf16*)(ws + WS_WIN), 1024}; pg8::DenseOrder S; S.init(NTOK, INW, F.G, (int)blockIdx.x, P1_CPERM);
        EpiProj E{(bf16*)(ws + WS_PROJ), args.in[13], (bf16*)(ws + WS_QC), (bf16*)(ws + WS_KV), F.lds + EPI_SCR};
        pg8::gemm_phase<EpiProj, pg8::DenseOrder>(F.lds, g, S, E, F.tid);
    }
    GRID_BAR();
    { REFRAME(); LOAD_ARGS(args); p2_mixers(F, args); }
    GRID_BAR();
    {
        REFRAME(); LOAD_ARGS(args); unsigned char* ws = args.ws;
        pg8::Gemm g{(const bf16*)(ws + WS_Y), (const bf16*)(ws + WS_WOUT), 1024}; pg8::DenseOrder S; S.init(NTOK, D, F.G, (int)blockIdx.x);
        EpiRes1 E{args.in[0], (bf16*)(ws + WS_X1B), (const float*)(ws + WS_MOD), F.lds + EPI_SCR};
        pg8::gemm_phase<EpiRes1, pg8::DenseOrder>(F.lds, g, S, E, F.tid);
    }
    GRID_BAR();
    { REFRAME(); LOAD_ARGS(args); p4_router(F, args); }
    GRID_BAR();
    {
        LAS int* pre = (LAS int*)(F.lds + MISC_OFF);
        { LOAD_ARGS(args);
          const unsigned* cnt = (const unsigned*)(args.ws + WS_CTL) + CW_CNT;
          if (F.tid < 64) {
              const int lane = F.tid; const int cv_ = (int)__hip_atomic_load(cnt + (lane & 31), __ATOMIC_RELAXED, __HIP_MEMORY_SCOPE_AGENT); const int tl = lane < 32 ? ((cv_ + 255) >> 8) : 0;
              if (lane < 32) ((LAS int*)(F.lds + MOE_CNTL))[lane] = cv_;
              int inc = tl;
#pragma unroll
              for (int o = 1; o < 32; o <<= 1) { const int t = __shfl_up(inc, o); if (lane >= o) inc += t; }
              if (lane < 32) pre[lane] = inc - tl;
              if (lane == 31) pre[32] = inc; } }
        __syncthreads();
        {
            REFRAME(); LOAD_ARGS(args); unsigned char* ws = args.ws;
            pg8::Gemm g{(const bf16*)(ws + WS_H), (const bf16*)(ws + WS_W13), 1024};
            MoeOrder S{pre, (const LAS int*)(F.lds + MOE_CNTL), (const LAS int*)(F.lds + MOE_LTOK), (const int*)(ws + WS_LIST), F.G, (int)blockIdx.x, F.lane, true};
            {
                const int* list = (const int*)(ws + WS_LIST); int tv[MOE_MAXU];
#pragma unroll
                for (int i = 0; i < MOE_MAXU; ++i) { pg8::Unit u; tv[i] = 0;
                    if (F.tid < 256 && S.next(i, u) && F.tid < u.nrows) tv[i] = list[(size_t)u.e * NTOK + u.r0 + F.tid] >> 1; }
#pragma unroll
                for (int i = 0; i < MOE_MAXU; ++i) if (F.tid < 256) ((LAS int*)(F.lds + MOE_LTOK))[i * 256 + F.tid] = tv[i];
                __syncthreads();
            }
            EpiSwiGLU E{(bf16*)(ws + WS_ACT), F.lds + EPI_SCR};
            pg8::gemm_phase<EpiSwiGLU, MoeOrder>(F.lds, g, S, E, F.tid);
        }
        GRID_BAR();
        {
            REFRAME(); LOAD_ARGS(args); unsigned char* ws = args.ws;
            pg8::Gemm g{(const bf16*)(ws + WS_ACT), (const bf16*)(ws + WS_W2), 512};
            MoeOrder S{pre, (const LAS int*)(F.lds + MOE_CNTL), (const LAS int*)(F.lds + MOE_LTOK), (const int*)(ws + WS_LIST), F.G, (int)blockIdx.x, F.lane, false};
            EpiScatter E{(bf16*)(ws + WS_YBUF), F.lds + EPI_SCR};
            pg8::gemm_phase<EpiScatter, MoeOrder>(F.lds, g, S, E, F.tid);
        }
    }
    GRID_BAR();
    { REFRAME(); LOAD_ARGS(args); p7_final(F, args); }
}

extern "C" void kernel_launch(void* const* d_in, const int* in_sizes, int n_in, void* d_out, int out_size, void* d_ws, size_t ws_size, hipStream_t stream) {
    static int grid = 0;
    if (grid == 0) {
        if (n_in != 24 || out_size != NTOK * D || ws_size < WS_END) { fprintf(stderr, "kernel_launch: unexpected problem (n_in %d out %d ws %zu)\n", n_in, out_size, ws_size); grid = -1; return; }
        int dev = 0, cus = 0, per_cu = 0;
        hipGetDevice(&dev);
        hipDeviceGetAttribute(&cus, hipDeviceAttributeMultiprocessorCount, dev);
        hipFuncSetAttribute((const void*)fwd_megakernel, hipFuncAttributeMaxDynamicSharedMemorySize, LDS_BYTES);
        hipOccupancyMaxActiveBlocksPerMultiprocessor(&per_cu, (const void*)fwd_megakernel, NTHREADS, LDS_BYTES);
        if (per_cu < 1) { fprintf(stderr, "kernel_launch: occupancy query says %d blocks per CU\n", per_cu); per_cu = 1; }
        grid = cus;
        (void)hipGetLastError();
    }
    if (grid < 0) return;
    hipMemsetAsync((char*)d_ws + WS_CTL, 0, CTL_ZERO_BYTES, stream);
    Args a{};
    for (int i = 0; i < 24; ++i) a.in[i] = (const float*)d_in[i];
    a.out = (float*)d_out; a.ws = (unsigned char*)d_ws;
    void* kargs[] = {&a};
    hipError_t e = hipLaunchCooperativeKernel((const void*)fwd_megakernel, dim3(grid), dim3(NTHREADS), kargs, LDS_BYTES, stream);
    if (e != hipSuccess) fprintf(stderr, "cooperative launch failed: %s (grid %d)\n", hipGetErrorString(e), grid);
}
```
